# Optimizing an MI355X kernel written in HIP

```python
import math
import jax
import jax.numpy as jnp
from jax import lax
import numpy as np

D_MODEL = 1024
BATCH = 8
SEQ = 4096
DEPTH = 4

CTX_LEN = 256
GRID_W = 64
MIX_WIDTH = D_MODEL
ATTN_WIDTH = MIX_WIDTH // 2
SGU_WIDTH = MIX_WIDTH - ATTN_WIDTH
DIFF_HEAD_DIM = 64
DIFF_HEADS = ATTN_WIDTH // (2 * DIFF_HEAD_DIM)
SGU_HEADS = 8
SGU_HEAD_DIM = SGU_WIDTH // SGU_HEADS
CHUNK = 128
Q_BLOCK = 128
N_EXPERTS = 16
CAPACITY_FACTOR = 2
EXPERT_FF = 2 * D_MODEL
ROPE_THETA = 10000.0
EPS = 1e-6
PROJ_WIDTH = 3 * ATTN_WIDTH + 2 * SGU_WIDTH
SPLITS = (ATTN_WIDTH, 2 * ATTN_WIDTH, 3 * ATTN_WIDTH, 3 * ATTN_WIDTH + SGU_WIDTH)

kernel_name = 'hybrid_diffattn_sgu_ecmoe_dit'


def rmsnorm(x, g):
    xf = x.astype(jnp.float32)
    y = xf * lax.rsqrt(jnp.mean(xf * xf, axis=-1, keepdims=True) + EPS)
    return (y * g.astype(jnp.float32)).astype(x.dtype)


def modulate(h, shift, scale):
    return h * (1 + scale) + shift


def axial_rope_tables(n_tokens):
    rows = n_tokens // GRID_W
    row = jnp.repeat(jnp.arange(rows), GRID_W).astype(jnp.float32)
    col = jnp.tile(jnp.arange(GRID_W), rows).astype(jnp.float32)
    n_freq = DIFF_HEAD_DIM // 4
    freqs = ROPE_THETA ** (-jnp.arange(n_freq, dtype=jnp.float32) / n_freq)
    ang_r = row[:, None] * freqs
    ang_c = col[:, None] * freqs
    ang = jnp.concatenate([ang_r, ang_r, ang_c, ang_c], axis=-1)
    return jnp.cos(ang), jnp.sin(ang)


def apply_axial_rope(t, cos, sin):
    tr = t.reshape(t.shape[:-1] + (2, 2, DIFF_HEAD_DIM // 4))
    rot = jnp.concatenate([-tr[..., 1:2, :], tr[..., 0:1, :]], axis=-2).reshape(t.shape)
    cos = cos.astype(t.dtype)[:, None, None, :]
    sin = sin.astype(t.dtype)[:, None, None, :]
    return t * cos + rot * sin


def diff_attn_core(q, k, v, lam):
    s = jnp.einsum('bqchd,bkchd->bchqk', q, k).astype(jnp.float32)
    p = jax.nn.softmax(s, axis=-1)
    a = p[:, 0] - lam * p[:, 1]
    return jnp.einsum('bhqk,bkhe->bqhe', a.astype(v.dtype), v)


def spatial_gating(u, gv, norm_g, w_s, b_s):
    b_, n, _ = u.shape
    u = jax.nn.gelu(u, approximate=False)
    gv = jax.nn.gelu(gv, approximate=False).reshape(b_, n, SGU_HEADS, SGU_HEAD_DIM)
    gv = rmsnorm(gv, norm_g.reshape(SGU_HEADS, SGU_HEAD_DIM))
    gv = gv.reshape(b_, n // CHUNK, CHUNK, SGU_HEADS, SGU_HEAD_DIM)
    s = jnp.einsum('hpq,bnqhe->bnphe', w_s, gv) + b_s.T[:, :, None]
    return u * s.reshape(b_, n, SGU_WIDTH)


def ec_moe(h, w_router, w_gate, w_up, w_down):
    b_, n, d = h.shape
    cap = CAPACITY_FACTOR * n // N_EXPERTS
    aff = jax.nn.softmax(jnp.einsum('bnd,de->bne', h, w_router).astype(jnp.float32), axis=-1)
    g, idx = lax.top_k(jnp.swapaxes(aff, 1, 2), cap)
    xs = jax.vmap(lambda hb, ib: hb[ib])(h, idx)
    hid = jax.nn.silu(jnp.einsum('becd,edf->becf', xs, w_gate)) * jnp.einsum('becd,edf->becf', xs, w_up)
    y = jnp.einsum('becf,efd->becd', hid, w_down) * g[..., None].astype(h.dtype)
    return jax.vmap(lambda yb, ib: jnp.zeros((n, d), yb.dtype).at[ib.reshape(-1)].add(yb.reshape(-1, d)))(y, idx)


def hybrid_mixer(h_lat, h_ctx, w_in, w_out, lq1, lk1, lq2, lk2, subln_g, sgu_norm_g, sgu_w, sgu_b, cos, sin, lam_init, ctx_out):
    b_, n, _ = h_lat.shape
    m = h_ctx.shape[1]
    hd = DIFF_HEAD_DIM
    scale = hd ** -0.5
    lam = (jnp.exp(jnp.sum(lq1 * lk1).astype(jnp.float32))
           - jnp.exp(jnp.sum(lq2 * lk2).astype(jnp.float32)) + lam_init)
    q, k, v, u, gv = jnp.split(h_lat @ w_in, SPLITS, axis=-1)
    q = apply_axial_rope(q.reshape(b_, n, 2, DIFF_HEADS, hd), cos, sin) * scale
    k = apply_axial_rope(k.reshape(b_, n, 2, DIFF_HEADS, hd), cos, sin)
    v = v.reshape(b_, n, DIFF_HEADS, 2 * hd)
    if ctx_out:
        qc, kc, vc, uc, gvc = jnp.split(h_ctx @ w_in, SPLITS, axis=-1)
    else:
        kc, vc = jnp.split(h_ctx @ w_in[:, ATTN_WIDTH:3 * ATTN_WIDTH], 2, axis=-1)
    kc = kc.reshape(b_, m, 2, DIFF_HEADS, hd)
    vc = vc.reshape(b_, m, DIFF_HEADS, 2 * hd)
    k_all = jnp.concatenate([kc, k], axis=1)
    v_all = jnp.concatenate([vc, v], axis=1)
    qb = q.reshape(b_, n // Q_BLOCK, Q_BLOCK, 2, DIFF_HEADS, hd).transpose(1, 0, 2, 3, 4, 5)
    o = lax.map(lambda qblk: diff_attn_core(qblk, k_all, v_all, lam), qb)
    o = o.transpose(1, 0, 2, 3, 4).reshape(b_, n, DIFF_HEADS, 2 * hd)
    o = rmsnorm(o, subln_g) * (1 - lam_init)
    y_lat = jnp.concatenate([o.reshape(b_, n, ATTN_WIDTH),
                             spatial_gating(u, gv, sgu_norm_g, sgu_w, sgu_b)], axis=-1) @ w_out
    if not ctx_out:
        return y_lat, None
    qc = qc.reshape(b_, m, 2, DIFF_HEADS, hd) * scale
    oc = rmsnorm(diff_attn_core(qc, kc, vc, lam), subln_g) * (1 - lam_init)
    y_ctx = jnp.concatenate([oc.reshape(b_, m, ATTN_WIDTH),
                             spatial_gating(uc, gvc, sgu_norm_g, sgu_w, sgu_b)], axis=-1) @ w_out
    return y_lat, y_ctx


def setup_inputs(seed: int = 0) -> dict:
    key = jax.random.key(seed)
    ks = jax.random.split(key, 24)
    f32 = jnp.float32
    d = D_MODEL

    def nrm(k, shape, s):
        return jax.random.normal(k, shape, f32) * s

    return {
        'x': nrm(ks[0], (BATCH, SEQ, d), 1.0),
        'c': nrm(ks[1], (BATCH, d), 1.0),
        'ctx': nrm(ks[2], (BATCH, CTX_LEN, d), 1.0),
        'c_ctx': nrm(ks[3], (d,), 1.0),
        'w_ada': nrm(ks[4], (DEPTH, d, 6 * d), 0.5 * d ** -0.5),
        'b_ada': nrm(ks[5], (DEPTH, 6 * d), 0.02),
        'norm1_g': 1.0 + nrm(ks[6], (DEPTH, d), 0.02),
        'norm2_g': 1.0 + nrm(ks[7], (DEPTH, d), 0.02),
        'w_in': nrm(ks[8], (DEPTH, d, PROJ_WIDTH), d ** -0.5),
        'w_out': nrm(ks[9], (DEPTH, MIX_WIDTH, d), MIX_WIDTH ** -0.5),
        'lambda_q1': nrm(ks[10], (DEPTH, DIFF_HEAD_DIM), 0.1),
        'lambda_k1': nrm(ks[11], (DEPTH, DIFF_HEAD_DIM), 0.1),
        'lambda_q2': nrm(ks[12], (DEPTH, DIFF_HEAD_DIM), 0.1),
        'lambda_k2': nrm(ks[13], (DEPTH, DIFF_HEAD_DIM), 0.1),
        'subln_g': 1.0 + nrm(ks[14], (DEPTH, 2 * DIFF_HEAD_DIM), 0.02),
        'sgu_norm_g': 1.0 + nrm(ks[15], (DEPTH, SGU_WIDTH), 0.02),
        'sgu_w': nrm(ks[16], (DEPTH, SGU_HEADS, CHUNK, CHUNK), CHUNK ** -0.5),
        'sgu_b': 1.0 + nrm(ks[17], (DEPTH, SGU_HEADS, CHUNK), 0.02),
        'w_router': nrm(ks[18], (DEPTH, d, N_EXPERTS), d ** -0.5),
        'w_gate': nrm(ks[19], (DEPTH, N_EXPERTS, d, EXPERT_FF), d ** -0.5),
        'w_up': nrm(ks[20], (DEPTH, N_EXPERTS, d, EXPERT_FF), d ** -0.5),
        'w_down': nrm(ks[21], (DEPTH, N_EXPERTS, EXPERT_FF, d), EXPERT_FF ** -0.5),
        'norm_f_g': 1.0 + nrm(ks[22], (d,), 0.02),
    }


def reference(x, c, ctx, c_ctx, w_ada, b_ada, norm1_g, norm2_g, w_in, w_out, lambda_q1, lambda_k1, lambda_q2, lambda_k2, subln_g, sgu_norm_g, sgu_w, sgu_b, w_router, w_gate, w_up, w_down, norm_f_g):
    n = x.shape[1]
    cos, sin = axial_rope_tables(n)
    silu_c = jax.nn.silu(c)
    silu_cc = jax.nn.silu(c_ctx)
    cx = ctx
    for l in range(DEPTH):
        last = l == DEPTH - 1
        lam_init = 0.8 - 0.6 * math.exp(-0.3 * l)
        mod = silu_c @ w_ada[l] + b_ada[l]
        sh1, sc1, g1, sh2, sc2, g2 = [t[:, None, :] for t in jnp.split(mod, 6, axis=-1)]
        cmod = silu_cc @ w_ada[l] + b_ada[l]
        csh1, csc1, cg1, csh2, csc2, cg2 = jnp.split(cmod, 6, axis=-1)
        h_lat = modulate(rmsnorm(x, norm1_g[l]), sh1, sc1)
        h_ctx = modulate(rmsnorm(cx, norm1_g[l]), csh1, csc1)
        y_lat, y_ctx = hybrid_mixer(h_lat, h_ctx, w_in[l], w_out[l], lambda_q1[l], lambda_k1[l],
                                    lambda_q2[l], lambda_k2[l], subln_g[l], sgu_norm_g[l], sgu_w[l],
                                    sgu_b[l], cos, sin, lam_init, not last)
        x = x + g1 * y_lat
        x = x + g2 * ec_moe(modulate(rmsnorm(x, norm2_g[l]), sh2, sc2),
                            w_router[l], w_gate[l], w_up[l], w_down[l])
        if not last:
            cx = cx + cg1 * y_ctx
            cx = cx + cg2 * ec_moe(modulate(rmsnorm(cx, norm2_g[l]), csh2, csc2),
                                   w_router[l], w_gate[l], w_up[l], w_down[l])
    return rmsnorm(x, norm_f_g)
```

```cpp
#include <hip/hip_runtime.h>
#include <cstdio>
#include <cstdint>
namespace pg8 {
#define PG8_LAS __attribute__((address_space(3)))
typedef unsigned short bf16_t;
typedef short bf16x8 __attribute__((ext_vector_type(8)));
typedef float f32x4 __attribute__((ext_vector_type(4)));
typedef float f32x2 __attribute__((ext_vector_type(2)));
typedef unsigned u32x4 __attribute__((ext_vector_type(4)));
typedef unsigned u32x2 __attribute__((ext_vector_type(2)));
constexpr int BM = 256, BK = 64, HALF = 128, HTB = HALF * BK * 2  , STAGE_BYTES = 8 * HTB, NXCD = 8, WGM = 8;

__host__ __device__ __forceinline__ int lds_byte(int r, int c) { const int st = (r >> 4) * 2 + (c >> 5), rr = r & 15, cc = c & 31, ob = rr * 64 + cc * 2; return st * 1024 + (ob ^ (((ob >> 9) & 1) << 5)); }
__host__ __device__ __forceinline__ void stage_rc(int b, int& R, int& C) { const int st = b / 1024, sb = b % 1024, swz = sb ^ (((sb >> 9) & 1) << 5); R = (st >> 1) * 16 + swz / 64; C = (st & 1) * 32 + (swz % 64) / 2; }
__host__ __device__ __forceinline__ int perm32(int rho) { const int n = rho >> 4, i = rho & 15; return 8 * (i >> 2) + 4 * n + (i & 3); }

struct Unit { int pm, pn; };
struct Gemm { const bf16_t* A; const bf16_t* Bt; int M, N, K; };

struct StaticOrder {
    int nM, nN, nwg, G, c;
    __host__ __device__ void init(int M, int N, int G_, int c_) { nM = M / BM; nN = N / BM; nwg = nM * nN; G = G_; c = c_; }
    __host__ __device__ bool next(int i, Unit& u) const {
        const long L = (long)i * G + c; if (L >= nwg) return false;
        int wgid = (int)L; { const int q = nwg / NXCD, r = nwg % NXCD, xcd = wgid % NXCD, off = wgid / NXCD; wgid = (xcd < r ? xcd * (q + 1) : r * (q + 1) + (xcd - r) * q) + off; }
        const int nig = WGM * nN, gid = wgid / nig, fm = gid * WGM, gsz = (nM - fm) < WGM ? (nM - fm) : WGM;
        u.pm = fm + ((wgid % nig) % gsz); u.pn = (wgid % nig) / gsz; return true;
    }
    __device__ __forceinline__ void a_ready(const Unit&) const {}
    __device__ __forceinline__ void done(const Unit&) const {}
};
struct GroupedOrder {
    int TM, TN, TMS, MOFF, BGS, nunits, G, c;
    __host__ __device__ void init(int NG, int TM_, int TMS_, int MOFF_, int TN_, int BGS_, int G_, int c_) { TM = TM_; TN = TN_; TMS = TMS_; MOFF = MOFF_; BGS = BGS_; nunits = NG * TM_ * TN_; G = G_; c = c_; }
    __host__ __device__ bool next(int i, Unit& u) const {
        const long L = (long)i * G + c; if (L >= nunits) return false;
        int wgid = (int)L; { const int q = nunits / NXCD, r = nunits % NXCD, xcd = wgid % NXCD, off = wgid / NXCD; wgid = (xcd < r ? xcd * (q + 1) : r * (q + 1) + (xcd - r) * q) + off; }
        const int per = TM * TN, e = wgid / per, w = wgid % per;
        const int nig = WGM * TN, gid = w / nig, fm = gid * WGM, gsz = (TM - fm) < WGM ? (TM - fm) : WGM;
        u.pm = e * TMS + MOFF + fm + ((w % nig) % gsz); u.pn = e * BGS + (w % nig) / gsz; return true;
    }
    __device__ __forceinline__ void a_ready(const Unit&) const {}
    __device__ __forceinline__ void done(const Unit&) const {}
};

__device__ __forceinline__ unsigned cvt_pk_bf16(float lo, float hi) { unsigned r; asm volatile("v_cvt_pk_bf16_f32 %0, %1, %2" : "=v"(r) : "v"(lo), "v"(hi)); return r; }
__device__ __forceinline__ f32x2 gelu_pk(f32x2 v) {
    f32x2 d; d.x = __builtin_fmaf(__builtin_fabsf(v.x), 0.2316418882f, 1.0f); d.y = __builtin_fmaf(__builtin_fabsf(v.y), 0.2316418882f, 1.0f);
    f32x2 t; t.x = __builtin_amdgcn_rcpf(d.x); t.y = __builtin_amdgcn_rcpf(d.y);
    f32x2 q = t * 0.5307027145f + (-0.7265760135f); q = q * t + 0.7107068705f; q = q * t + (-0.142248368f); q = q * t + 0.127414796f; q = q * t;
    const f32x2 s = (v * v) * (-0.72134752044f);
    f32x2 e; e.x = __builtin_amdgcn_exp2f(s.x); e.y = __builtin_amdgcn_exp2f(s.y);
    const f32x2 c = q * e;
    float rx, ry; asm("v_max_f32 %0, 0, %1" : "=v"(rx) : "v"(v.x)); asm("v_max_f32 %0, 0, %1" : "=v"(ry) : "v"(v.y));
    f32x2 o; o.x = __builtin_fmaf(-__builtin_fabsf(v.x), c.x, rx); o.y = __builtin_fmaf(-__builtin_fabsf(v.y), c.y, ry); return o;
}
__device__ __forceinline__ f32x4 gelu4(f32x4 v) { const f32x2 a = gelu_pk((f32x2){v[0], v[1]}), b = gelu_pk((f32x2){v[2], v[3]}); return (f32x4){a.x, a.y, b.x, b.y}; }

template <class Epi, class Sched, bool ALIGN_EPI = true, bool SP2 = true>
__device__ __forceinline__ void gemm_phase(PG8_LAS unsigned char* lds, const Gemm g, const Sched& S, const Epi& E) {
    int tid = threadIdx.x; asm volatile("" : "+v"(tid));
    const int wid = __builtin_amdgcn_readfirstlane(tid >> 6), lane = tid & 63, wr = wid >> 2, wc = wid & 3, fr = lane & 15, fq = lane >> 4;
    const int K = g.K, nt = K / BK;
    unsigned voffA[2], voffB[2];
#pragma unroll
    for (int i = 0; i < 2; ++i) { int R, C; stage_rc(tid * 16 + i * 8192, R, C); const int Rb = Epi::PERM ? ((R & ~31) + perm32(R & 31)) : R;
        voffA[i] = (unsigned)(R * K + C) * 2u; voffB[i] = (unsigned)(Rb * K + C) * 2u; }
    const size_t kstep = (size_t)(BK * 2);
    const size_t hstep = (size_t)HALF * K * 2;
    const size_t tstep = 2 * hstep;
    const unsigned ldsw = (unsigned)wid * 1024u;
    const int aoff = lds_byte(wr * 64 + fr, fq * 8), boff = lds_byte(wc * 32 + fr, fq * 8);
#define PG8_SA(b, h) (((b) * 2 + (h)) * HTB)
#define PG8_SB(b, h) ((4 + (b) * 2 + (h)) * HTB)
#define PG8_STAGE(bufoff, gbase, voff) do { _Pragma("unroll") for (int _i = 0; _i < 2; ++_i) \
        __builtin_amdgcn_global_load_lds((const unsigned*)((const char*)(gbase) + (voff)[_i]), (PG8_LAS unsigned*)(lds + (bufoff) + ldsw + _i * 8192), 16, 0, 0); } while (0)
#define PG8_LDA(dst, b, h) do { _Pragma("unroll") for (int m = 0; m < 4; ++m) _Pragma("unroll") for (int k = 0; k < 2; ++k) dst[m][k] = *(const PG8_LAS bf16x8*)(lds + PG8_SA(b, h) + aoff + m * 2048 + k * 1024); } while (0)
#define PG8_LDB(dst, b, h) do { _Pragma("unroll") for (int n = 0; n < 2; ++n) _Pragma("unroll") for (int k = 0; k < 2; ++k) dst[n][k] = *(const PG8_LAS bf16x8*)(lds + PG8_SB(b, h) + boff + n * 2048 + k * 1024); } while (0)
#define PG8_MMA(ai, bj, At, Bt) do { __builtin_amdgcn_s_setprio(1); _Pragma("unroll") for (int m = 0; m < 4; ++m) _Pragma("unroll") for (int n = 0; n < 2; ++n) _Pragma("unroll") for (int k = 0; k < 2; ++k) \
        acc[ai][bj][m][n] = __builtin_amdgcn_mfma_f32_16x16x32_bf16(Bt[n][k], At[m][k], acc[ai][bj][m][n], 0, 0, 0); __builtin_amdgcn_s_setprio(0); } while (0)
#define PG8_WAIT_V(n) asm volatile("s_waitcnt vmcnt(" #n ")" ::: "memory")
#define PG8_WAIT_L(n) asm volatile("s_waitcnt lgkmcnt(" #n ")" ::: "memory")
#define PG8_BAR __builtin_amdgcn_s_barrier()
#define PG8_SCHED __builtin_amdgcn_sched_barrier(0)
    Unit cur, nxt; int ui = 0;
    if (!S.next(0, cur)) return;
    f32x4 acc[2][2][4][2];
#pragma unroll
    for (int a = 0; a < 2; ++a)
#pragma unroll
        for (int b = 0; b < 2; ++b)
#pragma unroll
            for (int m = 0; m < 4; ++m)
#pragma unroll
                for (int n = 0; n < 2; ++n) acc[a][b][m][n] = (f32x4){0.f, 0.f, 0.f, 0.f};
    bf16x8 At[4][2], B0[2][2], B1[2][2];
    const char* cA = (const char*)g.A + (size_t)cur.pm * tstep; const char* cB = (const char*)g.Bt + (size_t)cur.pn * tstep;
    S.a_ready(cur);
    if constexpr (SP2) {
        PG8_STAGE(PG8_SB(0, 0), cB, voffB); PG8_STAGE(PG8_SB(0, 1), cB + hstep, voffB); PG8_STAGE(PG8_SA(0, 0), cA, voffA); PG8_STAGE(PG8_SA(0, 1), cA + hstep, voffA);
        if (wr == 1) PG8_BAR;
        PG8_WAIT_V(2); PG8_BAR;
        PG8_STAGE(PG8_SB(1, 0), cB + kstep, voffB); PG8_STAGE(PG8_SA(1, 0), cA + kstep, voffA); PG8_STAGE(PG8_SB(1, 1), cB + hstep + kstep, voffB);
        PG8_WAIT_V(6); PG8_BAR;
    } else {
        PG8_STAGE(PG8_SB(0, 0), cB, voffB); PG8_STAGE(PG8_SA(0, 0), cA, voffA); PG8_STAGE(PG8_SB(0, 1), cB + hstep, voffB); PG8_STAGE(PG8_SA(0, 1), cA + hstep, voffA);
        if (wr == 1) PG8_BAR;
        PG8_WAIT_V(4); PG8_BAR;
        PG8_STAGE(PG8_SB(1, 0), cB + kstep, voffB); PG8_STAGE(PG8_SA(1, 0), cA + kstep, voffA); PG8_STAGE(PG8_SB(1, 1), cB + hstep + kstep, voffB);
        PG8_WAIT_V(6); PG8_BAR;
    }
    for (;;) {
        const bool has_next = S.next(ui + 1, nxt);
        const char* nA = has_next ? (const char*)g.A + (size_t)nxt.pm * tstep : cA; const char* nB = has_next ? (const char*)g.Bt + (size_t)nxt.pn * tstep : cB;
        for (int t = 0; t < nt; t += 2) {
            const bool last = (t == nt - 2);
            const char* a1 = cA + (size_t)(t + 1) * kstep;
            const char* a2 = last ? nA : cA + (size_t)(t + 2) * kstep; const char* b2 = last ? nB : cB + (size_t)(t + 2) * kstep;
            const char* a3 = a2 + kstep; const char* b3 = b2 + kstep;
            if (last && has_next) S.a_ready(nxt);
            if constexpr (SP2) {
            PG8_LDB(B0, 0, 0); PG8_LDB(B1, 0, 1); PG8_SCHED; PG8_LDA(At, 0, 0); PG8_STAGE(PG8_SA(1, 1), a1 + hstep, voffA);
            PG8_WAIT_V(8); PG8_WAIT_L(0); PG8_BAR; PG8_MMA(0, 0, At, B0); PG8_MMA(0, 1, At, B1); PG8_BAR; PG8_SCHED;
            PG8_LDA(At, 0, 1); PG8_STAGE(PG8_SB(0, 0), b2, voffB); PG8_STAGE(PG8_SB(0, 1), b2 + hstep, voffB); PG8_STAGE(PG8_SA(0, 0), a2, voffA);
            PG8_WAIT_V(8); PG8_WAIT_L(0); PG8_BAR; PG8_MMA(1, 0, At, B0); PG8_MMA(1, 1, At, B1); PG8_BAR; PG8_SCHED;
            PG8_LDB(B0, 1, 0); PG8_LDB(B1, 1, 1); PG8_SCHED; PG8_LDA(At, 1, 0); PG8_STAGE(PG8_SA(0, 1), a2 + hstep, voffA);
            PG8_WAIT_V(8); PG8_WAIT_L(0); PG8_BAR; PG8_MMA(0, 0, At, B0); PG8_MMA(0, 1, At, B1); PG8_BAR; PG8_SCHED;
            PG8_LDA(At, 1, 1); PG8_STAGE(PG8_SB(1, 0), b3, voffB); PG8_STAGE(PG8_SB(1, 1), b3 + hstep, voffB); PG8_STAGE(PG8_SA(1, 0), a3, voffA);
            PG8_WAIT_V(8); PG8_WAIT_L(0); PG8_BAR; PG8_MMA(1, 0, At, B0); PG8_MMA(1, 1, At, B1); PG8_BAR; PG8_SCHED;
            } else {
            PG8_LDB(B0, 0, 0); PG8_SCHED; PG8_LDA(At, 0, 0); PG8_STAGE(PG8_SA(1, 1), a1 + hstep, voffA);
            PG8_WAIT_L(8); PG8_BAR; PG8_WAIT_L(0); PG8_MMA(0, 0, At, B0); PG8_BAR; PG8_SCHED;
            PG8_LDB(B1, 0, 1); PG8_STAGE(PG8_SB(0, 0), b2, voffB);
            PG8_BAR; PG8_WAIT_L(0); PG8_MMA(0, 1, At, B1); PG8_BAR;
            PG8_LDA(At, 0, 1); PG8_STAGE(PG8_SA(0, 0), a2, voffA);
            PG8_BAR; PG8_WAIT_L(0); PG8_MMA(1, 0, At, B0); PG8_BAR; PG8_SCHED;
            PG8_STAGE(PG8_SB(0, 1), b2 + hstep, voffB);
            PG8_WAIT_V(6); PG8_BAR; PG8_MMA(1, 1, At, B1); PG8_BAR;
            PG8_LDB(B0, 1, 0); PG8_SCHED; PG8_LDA(At, 1, 0); PG8_STAGE(PG8_SA(0, 1), a2 + hstep, voffA);
            PG8_WAIT_L(8); PG8_BAR; PG8_WAIT_L(0); PG8_MMA(0, 0, At, B0); PG8_BAR; PG8_SCHED;
            PG8_LDB(B1, 1, 1); PG8_STAGE(PG8_SB(1, 0), b3, voffB);
            PG8_BAR; PG8_WAIT_L(0); PG8_MMA(0, 1, At, B1); PG8_BAR;
            PG8_LDA(At, 1, 1); PG8_STAGE(PG8_SA(1, 0), a3, voffA);
            PG8_BAR; PG8_WAIT_L(0); PG8_MMA(1, 0, At, B0); PG8_BAR; PG8_SCHED;
            PG8_STAGE(PG8_SB(1, 1), b3 + hstep, voffB);
            PG8_WAIT_V(6); PG8_BAR; PG8_MMA(1, 1, At, B1); PG8_BAR;
                    }
        }
        if constexpr (ALIGN_EPI) { if (wr == 0) PG8_BAR; }
        E(acc, cur, wr, wc, fr, fq); S.done(cur);
#ifdef INPROJ_EPI2
        if constexpr (Epi::TWICE) { asm volatile("" ::: "memory"); E(acc, cur, wr, wc, fr, fq); }
#endif
        if (!has_next) break;
#pragma unroll
        for (int a = 0; a < 2; ++a)
#pragma unroll
            for (int b = 0; b < 2; ++b)
#pragma unroll
                for (int m = 0; m < 4; ++m)
#pragma unroll
                    for (int n = 0; n < 2; ++n) acc[a][b][m][n] = (f32x4){0.f, 0.f, 0.f, 0.f};
        cur = nxt; cA = nA; cB = nB; ++ui;
        if constexpr (ALIGN_EPI) { if (wr == 1) PG8_BAR; }
    }
    PG8_WAIT_V(0);
    if constexpr (!ALIGN_EPI) { if (wr == 0) PG8_BAR; }
    PG8_BAR;
#undef PG8_SA
#undef PG8_SB
#undef PG8_STAGE
#undef PG8_LDA
#undef PG8_LDB
#undef PG8_MMA
#undef PG8_WAIT_V
#undef PG8_WAIT_L
#undef PG8_BAR
#undef PG8_SCHED
}

template <class Epi, class Sched, int MAXU>
__device__ __forceinline__ void gemm_phase_gather(PG8_LAS unsigned char* lds, const Gemm g, const Sched& S, const Epi& E, const int* __restrict__ rowsrc, PG8_LAS unsigned short* gtab) {
    int tid = threadIdx.x; asm volatile("" : "+v"(tid));
    const int wid = __builtin_amdgcn_readfirstlane(tid >> 6), lane = tid & 63, wr = wid >> 2, wc = wid & 3, fr = lane & 15, fq = lane >> 4;
    const int K = g.K, nt = K / BK;
    Unit cur, nxt; int ui = 0;
    if (!S.next(0, cur)) return;
    { int idx[MAXU];
#pragma unroll
      for (int i = 0; i < MAXU; ++i) { Unit u; const bool have = S.next(i, u); idx[i] = (have && tid < 256) ? rowsrc[u.pm * 256 + tid] : 0; }
#pragma unroll
      for (int i = 0; i < MAXU; ++i) { if (tid < 256) gtab[i * 256 + tid] = (unsigned short)idx[i]; }
      asm volatile("s_waitcnt vmcnt(0) lgkmcnt(0)" ::: "memory"); __builtin_amdgcn_s_barrier(); asm volatile("" ::: "memory"); }
    unsigned voffB[2]; int RA[2], CA[2];
#pragma unroll
    for (int i = 0; i < 2; ++i) { int R, C; stage_rc(tid * 16 + i * 8192, R, C); const int Rb = Epi::PERM ? ((R & ~31) + perm32(R & 31)) : R;
        RA[i] = R; CA[i] = C * 2; voffB[i] = (unsigned)(Rb * K + C) * 2u; }
    const size_t kstep = (size_t)(BK * 2);
    const size_t hstep = (size_t)HALF * K * 2;
    const size_t tstep = 2 * hstep;
    const unsigned ldsw = (unsigned)wid * 1024u;
    const int aoff = lds_byte(wr * 64 + fr, fq * 8), boff = lds_byte(wc * 32 + fr, fq * 8);
    const unsigned rowb = (unsigned)K * 2u;
#define PG8_SA(b, h) (((b) * 2 + (h)) * HTB)
#define PG8_SB(b, h) ((4 + (b) * 2 + (h)) * HTB)
#define PG8_STAGE(bufoff, gbase, voff) do { _Pragma("unroll") for (int _i = 0; _i < 2; ++_i) \
        __builtin_amdgcn_global_load_lds((const unsigned*)((const char*)(gbase) + (voff)[_i]), (PG8_LAS unsigned*)(lds + (bufoff) + ldsw + _i * 8192), 16, 0, 0); } while (0)
#define PG8_LDA(dst, b, h) do { _Pragma("unroll") for (int m = 0; m < 4; ++m) _Pragma("unroll") for (int k = 0; k < 2; ++k) dst[m][k] = *(const PG8_LAS bf16x8*)(lds + PG8_SA(b, h) + aoff + m * 2048 + k * 1024); } while (0)
#define PG8_LDB(dst, b, h) do { _Pragma("unroll") for (int n = 0; n < 2; ++n) _Pragma("unroll") for (int k = 0; k < 2; ++k) dst[n][k] = *(const PG8_LAS bf16x8*)(lds + PG8_SB(b, h) + boff + n * 2048 + k * 1024); } while (0)
#define PG8_MMA(ai, bj, At, Bt) do { __builtin_amdgcn_s_setprio(1); _Pragma("unroll") for (int m = 0; m < 4; ++m) _Pragma("unroll") for (int n = 0; n < 2; ++n) _Pragma("unroll") for (int k = 0; k < 2; ++k) \
        acc[ai][bj][m][n] = __builtin_amdgcn_mfma_f32_16x16x32_bf16(Bt[n][k], At[m][k], acc[ai][bj][m][n], 0, 0, 0); __builtin_amdgcn_s_setprio(0); } while (0)
#define PG8_WAIT_V(n) asm volatile("s_waitcnt vmcnt(" #n ")" ::: "memory")
#define PG8_WAIT_L(n) asm volatile("s_waitcnt lgkmcnt(" #n ")" ::: "memory")
#define PG8_BAR __builtin_amdgcn_s_barrier()
#define PG8_SCHED __builtin_amdgcn_sched_barrier(0)
#define PG8_GOFF(dst, ORD) do { _Pragma("unroll") for (int _h = 0; _h < 2; ++_h) _Pragma("unroll") for (int _i = 0; _i < 2; ++_i) \
        dst[_h][_i] = (unsigned)gtab[(ORD) * 256 + _h * HALF + RA[_i]] * rowb + (unsigned)CA[_i]; } while (0)
    f32x4 acc[2][2][4][2];
#pragma unroll
    for (int a = 0; a < 2; ++a)
#pragma unroll
        for (int b = 0; b < 2; ++b)
#pragma unroll
            for (int m = 0; m < 4; ++m)
#pragma unroll
                for (int n = 0; n < 2; ++n) acc[a][b][m][n] = (f32x4){0.f, 0.f, 0.f, 0.f};
    bf16x8 At[4][2], B0[2][2], B1[2][2];
    unsigned vAc[2][2], vAn[2][2];
    PG8_GOFF(vAc, 0);
#pragma unroll
    for (int h = 0; h < 2; ++h)
#pragma unroll
        for (int i = 0; i < 2; ++i) vAn[h][i] = vAc[h][i];
    const char* gA = (const char*)g.A;
    const char* cB = (const char*)g.Bt + (size_t)cur.pn * tstep;
    PG8_STAGE(PG8_SB(0, 0), cB, voffB); PG8_STAGE(PG8_SB(0, 1), cB + hstep, voffB); PG8_STAGE(PG8_SA(0, 0), gA, vAc[0]); PG8_STAGE(PG8_SA(0, 1), gA, vAc[1]);
    if (wr == 1) PG8_BAR;
    PG8_WAIT_V(2); PG8_BAR;
    PG8_STAGE(PG8_SB(1, 0), cB + kstep, voffB); PG8_STAGE(PG8_SA(1, 0), gA + kstep, vAc[0]); PG8_STAGE(PG8_SB(1, 1), cB + hstep + kstep, voffB);
    PG8_WAIT_V(6); PG8_BAR;
    for (;;) {
        const bool has_next = S.next(ui + 1, nxt);
        const char* nB = has_next ? (const char*)g.Bt + (size_t)nxt.pn * tstep : cB;
        for (int t = 0; t < nt; t += 2) {
            const bool last = (t == nt - 2);
            if (last) { if (has_next) { PG8_GOFF(vAn, ui + 1); } }
            const char* ka1 = gA + (size_t)(t + 1) * kstep;
            const char* ka2 = last ? gA : gA + (size_t)(t + 2) * kstep; const char* b2 = last ? nB : cB + (size_t)(t + 2) * kstep;
            const char* ka3 = ka2 + kstep; const char* b3 = b2 + kstep;
            unsigned x2[2][2];
#pragma unroll
            for (int h = 0; h < 2; ++h)
#pragma unroll
                for (int i = 0; i < 2; ++i) x2[h][i] = last ? vAn[h][i] : vAc[h][i];
            PG8_LDB(B0, 0, 0); PG8_LDB(B1, 0, 1); PG8_SCHED; PG8_LDA(At, 0, 0); PG8_STAGE(PG8_SA(1, 1), ka1, vAc[1]);
            PG8_WAIT_V(8); PG8_WAIT_L(0); PG8_BAR; PG8_MMA(0, 0, At, B0); PG8_MMA(0, 1, At, B1); PG8_BAR; PG8_SCHED;
            PG8_LDA(At, 0, 1); PG8_STAGE(PG8_SB(0, 0), b2, voffB); PG8_STAGE(PG8_SB(0, 1), b2 + hstep, voffB); PG8_STAGE(PG8_SA(0, 0), ka2, x2[0]);
            PG8_WAIT_V(8); PG8_WAIT_L(0); PG8_BAR; PG8_MMA(1, 0, At, B0); PG8_MMA(1, 1, At, B1); PG8_BAR; PG8_SCHED;
            PG8_LDB(B0, 1, 0); PG8_LDB(B1, 1, 1); PG8_SCHED; PG8_LDA(At, 1, 0); PG8_STAGE(PG8_SA(0, 1), ka2, x2[1]);
            PG8_WAIT_V(8); PG8_WAIT_L(0); PG8_BAR; PG8_MMA(0, 0, At, B0); PG8_MMA(0, 1, At, B1); PG8_BAR; PG8_SCHED;
            PG8_LDA(At, 1, 1); PG8_STAGE(PG8_SB(1, 0), b3, voffB); PG8_STAGE(PG8_SB(1, 1), b3 + hstep, voffB); PG8_STAGE(PG8_SA(1, 0), ka3, x2[0]);
            PG8_WAIT_V(8); PG8_WAIT_L(0); PG8_BAR; PG8_MMA(1, 0, At, B0); PG8_MMA(1, 1, At, B1); PG8_BAR; PG8_SCHED;
        }
        if (wr == 0) PG8_BAR;
        E(acc, cur, wr, wc, fr, fq); S.done(cur);
        if (!has_next) break;
#pragma unroll
        for (int a = 0; a < 2; ++a)
#pragma unroll
            for (int b = 0; b < 2; ++b)
#pragma unroll
                for (int m = 0; m < 4; ++m)
#pragma unroll
                    for (int n = 0; n < 2; ++n) acc[a][b][m][n] = (f32x4){0.f, 0.f, 0.f, 0.f};
        cur = nxt; cB = nB; ++ui;
#pragma unroll
        for (int h = 0; h < 2; ++h)
#pragma unroll
            for (int i = 0; i < 2; ++i) vAc[h][i] = vAn[h][i];
        if (wr == 1) PG8_BAR;
    }
    PG8_WAIT_V(0);
    PG8_BAR;
#undef PG8_GOFF
#undef PG8_SA
#undef PG8_SB
#undef PG8_STAGE
#undef PG8_LDA
#undef PG8_LDB
#undef PG8_MMA
#undef PG8_WAIT_V
#undef PG8_WAIT_L
#undef PG8_BAR
#undef PG8_SCHED
}
}
#define XB_TMO      128
#define XB_XCNT(j)  (256  + 64 * (j))
#define XB_XSUB(j)  (1280 + 64 * (j))
#define XB_XGEN(j)  (2304 + 64 * (j))
#define XB_TOP      3328
#define XB_TOPGEN   3392
#define XCD_BAR_WORDS 3456
#define XB_SPIN_CAP (1u << 22)
#define LAS __attribute__((address_space(3)))

__device__ __forceinline__ unsigned xb_ld(unsigned* p)              { return __hip_atomic_load(p, __ATOMIC_RELAXED, __HIP_MEMORY_SCOPE_AGENT); }
__device__ __forceinline__ unsigned xb_add(unsigned* p, unsigned v) { return __hip_atomic_fetch_add(p, v, __ATOMIC_RELAXED, __HIP_MEMORY_SCOPE_AGENT); }
__device__ __forceinline__ unsigned xb_xcc_id() { return (unsigned)__builtin_amdgcn_s_getreg((3 << 11) | 20) & 0xFu; }
#define XB_SPIN(cond, bar) do { unsigned _sp = 0; while (cond) { __builtin_amdgcn_s_sleep(1); \
    if ((++_sp & 255u) == 0u) { if (xb_ld(&(bar)[XB_TMO])) break; if (_sp > XB_SPIN_CAP) { atomicAdd(&(bar)[XB_TMO], 1u); break; } } } } while (0)

struct XcdBarrier {
    unsigned* bar; unsigned x;
    volatile LAS unsigned* st;
};
__device__ __forceinline__ XcdBarrier xcd_barrier_post(unsigned* bar, volatile LAS unsigned* st) {
    XcdBarrier b; b.bar = bar; b.x = xb_xcc_id(); b.st = st;
    if (threadIdx.x == 0) (void)xb_add(&bar[XB_XCNT(b.x)], 1u);
    return b;
}
__device__ __forceinline__ void xcd_barrier_complete(unsigned* bar, unsigned x, unsigned& nloc, unsigned& nx) {
    const unsigned G = gridDim.x * gridDim.y * gridDim.z;
    unsigned sum, cnt, mine, sp = 0u;
    for (;;) {
        sum = 0u; cnt = 0u; mine = 0u;
#pragma unroll
        for (unsigned j = 0; j < 16; ++j) { const unsigned c = xb_ld(&bar[XB_XCNT(j)]); sum += c; cnt += (c > 0u) ? 1u : 0u; mine = (j == x) ? c : mine; }
        if (sum == G) break;
        __builtin_amdgcn_s_sleep(1);
        if ((++sp & 255u) == 0u) { if (xb_ld(&bar[XB_TMO])) break; if (sp > XB_SPIN_CAP) { atomicAdd(&bar[XB_TMO], 1u); break; } }
    }
    nloc = mine > 0u ? mine : 1u; nx = cnt > 0u ? cnt : 1u;
}
__device__ __forceinline__ void xcd_barrier(const XcdBarrier& b) {
    asm volatile("s_waitcnt vmcnt(0)" ::: "memory");
    __syncthreads();
    if (threadIdx.x == 0) {
        unsigned* bar = b.bar;
        __builtin_amdgcn_s_waitcnt(0);
        unsigned nloc = b.st[0], nx = b.st[1];
        if (nloc == 0u) { xcd_barrier_complete(bar, b.x, nloc, nx); b.st[0] = nloc; b.st[1] = nx; }
        const unsigned old = xb_add(&bar[XB_XSUB(b.x)], 1u);
        const unsigned gen = old / nloc;
        if (old + 1u == (gen + 1u) * nloc) {
            __builtin_amdgcn_fence(__ATOMIC_RELEASE, "agent");
            asm volatile("s_waitcnt vmcnt(0)" ::: "memory");
            const unsigned og = xb_add(&bar[XB_TOP], 1u);
            const unsigned tg = og / nx;
            if (og + 1u == (tg + 1u) * nx) xb_add(&bar[XB_TOPGEN], 1u);
            else XB_SPIN(xb_ld(&bar[XB_TOPGEN]) == tg, bar);
            __builtin_amdgcn_fence(__ATOMIC_ACQUIRE, "agent");
            xb_add(&bar[XB_XGEN(b.x)], 1u);
            asm volatile("s_waitcnt vmcnt(0)" ::: "memory");
        } else {
            XB_SPIN(xb_ld(&bar[XB_XGEN(b.x)]) == gen, bar);
            __builtin_amdgcn_fence(__ATOMIC_ACQUIRE, "agent");
            asm volatile("s_waitcnt vmcnt(0)" ::: "memory");
        }
    }
    __syncthreads();
}
namespace att {
typedef unsigned short bf16_t;
using bf16x8 = __attribute__((ext_vector_type(8))) short;
using s16x4  = __attribute__((ext_vector_type(4))) short;
using f32x16 = __attribute__((ext_vector_type(16))) float;
using u32x4  = __attribute__((ext_vector_type(4))) unsigned;
constexpr int NW = 8, QBLK = 32, KVBLK = 64;
constexpr int LDR = 512;
constexpr float THR = 8.f;
constexpr int SHM_V = KVBLK * 128 * 2, SHM_K = KVBLK * 64 * 2, NBUF = 3, WS_OFF = NBUF * (SHM_V + SHM_K), SHM_ATTN = WS_OFF + NW * 64 * 4;
#define KSWZ(row, colB) ((row) * 128 + ((colB) ^ ((((row) >> 1) & 7) << 4)))
#define SBAR() __builtin_amdgcn_sched_barrier(0)
__device__ __forceinline__ int crow(int r, int hi) { return (r & 3) + 8 * (r >> 2) + 4 * hi; }
__device__ __forceinline__ unsigned cvtpk(float lo, float hi) { unsigned r; asm volatile("v_cvt_pk_bf16_f32 %0, %1, %2" : "=v"(r) : "v"(lo), "v"(hi)); return r; }

__device__ __forceinline__ void partialSM(f32x16& p0, f32x16& p1, float& m_reg, float& mn, float& alpha) {
  constexpr float C = 1.4426950408889634f;
  float pmax = p0[0];
#pragma unroll
  for (int r = 1; r < 16; ++r) pmax = fmaxf(pmax, p0[r]);
#pragma unroll
  for (int r = 0; r < 16; ++r) pmax = fmaxf(pmax, p1[r]);
  { auto rr = __builtin_amdgcn_permlane32_swap(__float_as_uint(pmax), __float_as_uint(pmax), false, false);
    pmax = fmaxf(__uint_as_float(rr[0]), __uint_as_float(rr[1])); }
  if (__builtin_expect(__all(pmax - m_reg <= THR), 1)) { mn = m_reg; alpha = 1.f; }
  else { mn = fmaxf(m_reg, pmax); alpha = __builtin_amdgcn_exp2f((m_reg - mn) * C); m_reg = mn; }
  float mnC = -mn * C;
#pragma unroll
  for (int r = 0; r < 16; ++r) p0[r] = fmaf(p0[r], C, mnC);
#pragma unroll
  for (int r = 0; r < 16; ++r) p1[r] = fmaf(p1[r], C, mnC);
#pragma unroll
  for (int r = 0; r < 16; ++r) p0[r] = __builtin_amdgcn_exp2f(p0[r]);
}
__device__ __forceinline__ float psm_max0(const f32x16& p0) {
  float pmax = p0[0];
#pragma unroll
  for (int r = 1; r < 16; ++r) pmax = fmaxf(pmax, p0[r]);
  return pmax;
}
__device__ __forceinline__ void psm_max1(const f32x16& p1, float pmax, float& m_reg, float& mn, float& alpha) {
  constexpr float C = 1.4426950408889634f;
#pragma unroll
  for (int r = 0; r < 16; ++r) pmax = fmaxf(pmax, p1[r]);
  { auto rr = __builtin_amdgcn_permlane32_swap(__float_as_uint(pmax), __float_as_uint(pmax), false, false);
    pmax = fmaxf(__uint_as_float(rr[0]), __uint_as_float(rr[1])); }
  if (__builtin_expect(__all(pmax - m_reg <= THR), 1)) { mn = m_reg; alpha = 1.f; }
  else { mn = fmaxf(m_reg, pmax); alpha = __builtin_amdgcn_exp2f((m_reg - mn) * C); m_reg = mn; }
}
__device__ __forceinline__ void psm_scale(f32x16& p0, f32x16& p1, float mn) {
  constexpr float C = 1.4426950408889634f; const float mnC = -mn * C;
#pragma unroll
  for (int r = 0; r < 16; ++r) p0[r] = fmaf(p0[r], C, mnC);
#pragma unroll
  for (int r = 0; r < 16; ++r) p1[r] = fmaf(p1[r], C, mnC);
}
__device__ __forceinline__ void psm_exp0(f32x16& p0) {
#pragma unroll
  for (int r = 0; r < 16; ++r) p0[r] = __builtin_amdgcn_exp2f(p0[r]);
}
__device__ __forceinline__ void finishSM(f32x16& p0, f32x16& p1, float alpha, float& l_reg, bf16x8& pa0, bf16x8& pa1, bf16x8& pa2, bf16x8& pa3) {
#pragma unroll
  for (int r = 0; r < 16; ++r) p1[r] = __builtin_amdgcn_exp2f(p1[r]);
  float ps = 0;
#pragma unroll
  for (int r = 0; r < 16; ++r) ps += p0[r];
#pragma unroll
  for (int r = 0; r < 16; ++r) ps += p1[r];
  { auto rr = __builtin_amdgcn_permlane32_swap(__float_as_uint(ps), __float_as_uint(ps), false, false);
    ps = __uint_as_float(rr[0]) + __uint_as_float(rr[1]); }
  l_reg = l_reg * alpha + ps;
#define PK4(P, BASE, OUT) do { unsigned a0 = cvtpk(P[BASE + 0], P[BASE + 1]), a1 = cvtpk(P[BASE + 2], P[BASE + 3]);   \
    unsigned b0 = cvtpk(P[BASE + 4], P[BASE + 5]), b1 = cvtpk(P[BASE + 6], P[BASE + 7]);                              \
    auto r0 = __builtin_amdgcn_permlane32_swap(a0, b0, false, false); auto r1 = __builtin_amdgcn_permlane32_swap(a1, b1, false, false); \
    u32x4 w = {r0[0], r1[0], r0[1], r1[1]}; OUT = *reinterpret_cast<bf16x8*>(&w); } while (0)
  PK4(p0, 0, pa0); PK4(p0, 8, pa1); PK4(p1, 0, pa2); PK4(p1, 8, pa3);
#undef PK4
}
__device__ __forceinline__ void qkt(f32x16& p0, f32x16& p1, const char* Ks, const bf16x8 (&qr)[4], int r32, int hi) {
  p0 = f32x16{}; p1 = f32x16{};
#pragma unroll
  for (int d0 = 0; d0 < 4; ++d0) { const int cb = (d0 * 16 + hi * 8) * 2;
    bf16x8 b0 = *reinterpret_cast<const bf16x8*>(Ks + KSWZ(r32, cb));
    bf16x8 b1 = *reinterpret_cast<const bf16x8*>(Ks + KSWZ(32 + r32, cb));
    p0 = __builtin_amdgcn_mfma_f32_32x32x16_bf16(b0, qr[d0], p0, 0, 0, 0);
    p1 = __builtin_amdgcn_mfma_f32_32x32x16_bf16(b1, qr[d0], p1, 0, 0, 0); }
}
__device__ __forceinline__ int v_st(int k, int c) { const int kk = (k & ~0xC) | ((k & 4) << 1) | ((k & 8) >> 1); return ((kk >> 3) * 4 + (c >> 5)) * 512 + ((kk & 7) * 32 + (c & 31)) * 2; }
__device__ __forceinline__ int v_rd_base(int lane) { return ((lane & 3) << 3) | (((lane >> 2) & 3) << 6) | (((lane >> 4) & 1) << 5) | (((lane >> 5) & 1) << 8); }
constexpr int v_rd_off(int d0, int ks, int half) { return d0 * 512 + ks * 4096 + half * 2048; }
template <int OFF> __device__ __forceinline__ s16x4 tr_read(int vb) {
  s16x4 r; asm volatile("ds_read_b64_tr_b16 %0, %1 offset:%2" : "=&v"(r) : "v"(vb), "i"(OFF) : "memory"); return r;
}
template <int D0> __device__ __forceinline__ void pv_one(f32x16& od, int vb, bf16x8 pa0, bf16x8 pa1, bf16x8 pa2, bf16x8 pa3) {
  const s16x4 l0 = tr_read<v_rd_off(D0, 0, 0)>(vb), h0 = tr_read<v_rd_off(D0, 0, 1)>(vb), l1 = tr_read<v_rd_off(D0, 1, 0)>(vb), h1 = tr_read<v_rd_off(D0, 1, 1)>(vb);
  const s16x4 l2 = tr_read<v_rd_off(D0, 2, 0)>(vb), h2 = tr_read<v_rd_off(D0, 2, 1)>(vb), l3 = tr_read<v_rd_off(D0, 3, 0)>(vb), h3 = tr_read<v_rd_off(D0, 3, 1)>(vb);
  asm volatile("s_waitcnt lgkmcnt(0)" ::: "memory"); SBAR();
#define PK(L, H) (bf16x8){L[0], L[1], L[2], L[3], H[0], H[1], H[2], H[3]}
  od = __builtin_amdgcn_mfma_f32_32x32x16_bf16(pa0, PK(l0, h0), od, 0, 0, 0);
  od = __builtin_amdgcn_mfma_f32_32x32x16_bf16(pa1, PK(l1, h1), od, 0, 0, 0);
  od = __builtin_amdgcn_mfma_f32_32x32x16_bf16(pa2, PK(l2, h2), od, 0, 0, 0);
  od = __builtin_amdgcn_mfma_f32_32x32x16_bf16(pa3, PK(l3, h3), od, 0, 0, 0);
#undef PK
}
__device__ __forceinline__ void pv_d0(f32x16 (&o)[4], int vb, bf16x8 pa0, bf16x8 pa1, bf16x8 pa2, bf16x8 pa3) {
  pv_one<0>(o[0], vb, pa0, pa1, pa2, pa3); pv_one<1>(o[1], vb, pa0, pa1, pa2, pa3); pv_one<2>(o[2], vb, pa0, pa1, pa2, pa3); pv_one<3>(o[3], vb, pa0, pa1, pa2, pa3);
}

__device__ __forceinline__ void pv_psm(f32x16 (&o)[4], int vb, bf16x8 pa0, bf16x8 pa1, bf16x8 pa2, bf16x8 pa3, f32x16& p0, f32x16& p1, float& m_reg, float& mn, float& alpha) {
  pv_one<0>(o[0], vb, pa0, pa1, pa2, pa3); const float pm0 = psm_max0(p0);
  pv_one<1>(o[1], vb, pa0, pa1, pa2, pa3); psm_max1(p1, pm0, m_reg, mn, alpha);
  pv_one<2>(o[2], vb, pa0, pa1, pa2, pa3); psm_scale(p0, p1, mn);
  pv_one<3>(o[3], vb, pa0, pa1, pa2, pa3); psm_exp0(p0);
}

__device__ __forceinline__ void attn_pass(const bf16_t* __restrict__ Qb, const bf16_t* __restrict__ Kh, const bf16_t* __restrict__ Vh, int seq, char* lds, f32x16 (&o)[4], float& l_out) {
  int tid = threadIdx.x; asm volatile("" : "+v"(tid));
  const int wid = tid >> 6, lane = tid & 63, r32 = lane & 31, hi = lane >> 5;
  char* V_lds = lds; char* K_lds = lds + NBUF * SHM_V;
  float* ws = (float*)(lds + WS_OFF) + wid * 64; float* al_l = ws + 32;
  float m_reg = -1e30f, l_reg = 0; bf16x8 qr[4];
#pragma unroll
  for (int d = 0; d < 4; ++d) o[d] = f32x16{};
  const bf16_t* Qw = Qb + (long)(wid * QBLK + r32) * LDR + hi * 8;
#pragma unroll
  for (int d0 = 0; d0 < 4; ++d0) qr[d0] = *reinterpret_cast<const bf16x8*>(Qw + d0 * 16);
  const int sr = tid >> 4, sc = (tid & 15) * 8, vst0 = v_st(sr, sc), vst1 = v_st(32 + sr, sc);
  const int kr = tid >> 3, kc = (tid & 7) * 8, kst = KSWZ(kr, kc * 2);
  const int vb0 = (int)(uintptr_t)V_lds + v_rd_base(lane);
  struct { bf16x8 vs0, vs1, ks0; } sr_[2];
#define SLOAD(i, k0) do { sr_[i].vs0 = *reinterpret_cast<const bf16x8*>(&Vh[(long)((k0) + sr) * LDR + sc]); sr_[i].vs1 = *reinterpret_cast<const bf16x8*>(&Vh[(long)((k0) + 32 + sr) * LDR + sc]); \
    sr_[i].ks0 = *reinterpret_cast<const bf16x8*>(&Kh[(long)((k0) + kr) * LDR + kc]); } while (0)
#define SWRITE(b, i) do { *(bf16x8*)(V_lds + (b) * SHM_V + vst0) = sr_[i].vs0; *(bf16x8*)(V_lds + (b) * SHM_V + vst1) = sr_[i].vs1; \
    *(bf16x8*)(K_lds + (b) * SHM_K + kst) = sr_[i].ks0; } while (0)
#define SWAIT() asm volatile("s_waitcnt vmcnt(3)" ::: "memory")
#define RESC(a) do { if (__any((a) < 1.f)) { if (hi == 0) al_l[r32] = (a); asm volatile("s_waitcnt lgkmcnt(0)" ::: "memory"); \
    _Pragma("unroll") for (int d = 0; d < 4; ++d) _Pragma("unroll") for (int r = 0; r < 16; ++r) o[d][r] *= al_l[crow(r, hi)]; } } while (0)
#define ROT() do { const int t_ = bprev; bprev = bcur; bcur = bnext; bnext = t_; } while (0)
  f32x16 pA0, pA1, pB0, pB1; float mnA, mnB, alA, alB; bf16x8 pa0, pa1, pa2, pa3; const int NT = seq / KVBLK;
  constexpr int SE = 0, SO = 1;
  SLOAD(SE, 0); asm volatile("s_waitcnt vmcnt(0)" ::: "memory"); SWRITE(0, SE);
  SLOAD(SO, KVBLK); if (2 < NT) SLOAD(SE, 2 * KVBLK);
  __syncthreads();
  qkt(pA0, pA1, K_lds, qr, r32, hi); partialSM(pA0, pA1, m_reg, mnA, alA);
  SWAIT(); SWRITE(1, SO);
  int bprev = 0, bcur = 1, bnext = 2;
  for (int j = 1; j + 1 < NT; j += 2) {
    __syncthreads();
    SBAR(); qkt(pB0, pB1, K_lds + bcur * SHM_K, qr, r32, hi);
#ifdef ATT_X1
    asm volatile("" : "+v"(pB0), "+v"(pB1)); qkt(pB0, pB1, K_lds + bcur * SHM_K, qr, r32, hi);
#endif
    finishSM(pA0, pA1, alA, l_reg, pa0, pa1, pa2, pa3); SBAR();
#ifdef ATT_X2
    { bf16x8 z = {0,0,0,0,0,0,0,0}; asm volatile("" : "+v"(z)); pv_d0(o, vb0 + bprev * (int)SHM_V, z, z, z, z); }
#endif
    SLOAD(SO, (j + 2) * KVBLK); SBAR();
    pv_psm(o, vb0 + bprev * (int)SHM_V, pa0, pa1, pa2, pa3, pB0, pB1, m_reg, mnB, alB);
    SWAIT(); SWRITE(bnext, SE);
    RESC(alB); ROT();
    __syncthreads();
    SBAR(); qkt(pA0, pA1, K_lds + bcur * SHM_K, qr, r32, hi);
#ifdef ATT_X1
    asm volatile("" : "+v"(pA0), "+v"(pA1)); qkt(pA0, pA1, K_lds + bcur * SHM_K, qr, r32, hi);
#endif
    finishSM(pB0, pB1, alB, l_reg, pa0, pa1, pa2, pa3); SBAR();
#ifdef ATT_X2
    { bf16x8 z = {0,0,0,0,0,0,0,0}; asm volatile("" : "+v"(z)); pv_d0(o, vb0 + bprev * (int)SHM_V, z, z, z, z); }
#endif
    SLOAD(SE, (j + 3 < NT ? j + 3 : NT - 1) * KVBLK); SBAR();
    pv_psm(o, vb0 + bprev * (int)SHM_V, pa0, pa1, pa2, pa3, pA0, pA1, m_reg, mnA, alA);
    SWAIT(); SWRITE(bnext, SO);
    RESC(alA); ROT();
  }
  __syncthreads();
  SBAR(); qkt(pB0, pB1, K_lds + bcur * SHM_K, qr, r32, hi);
  finishSM(pA0, pA1, alA, l_reg, pa0, pa1, pa2, pa3); SBAR();
  pv_psm(o, vb0 + bprev * (int)SHM_V, pa0, pa1, pa2, pa3, pB0, pB1, m_reg, mnB, alB);
  RESC(alB);
  finishSM(pB0, pB1, alB, l_reg, pa0, pa1, pa2, pa3); SBAR();
  pv_d0(o, vb0 + bcur * (int)SHM_V, pa0, pa1, pa2, pa3);
  l_out = l_reg;
#undef SLOAD
#undef SWRITE
#undef SWAIT
#undef RESC
#undef ROT
}

__device__ __forceinline__ void attn_unit(const bf16_t* QB, const bf16_t* KB, const bf16_t* VB, float* OS, bf16_t* CAT, const float* subg, float lam, float outscale,
                                          int h, long row_q0, long row_k0, int nkeys, char* lds) {
  int tid = threadIdx.x; asm volatile("" : "+v"(tid));
  const int wid = tid >> 6, lane = tid & 63, r32 = lane & 31, hi = lane >> 5;
  float* li_l = (float*)(lds + WS_OFF) + wid * 64;
  float* OSu = OS + row_q0 * 512 + h * 128;
  bf16_t* CATu = CAT + row_q0 * 1024 + h * 128;
  {
    f32x16 o[4]; float l_reg;
    attn_pass(QB + row_q0 * LDR + h * 64, KB + row_k0 * LDR + h * 64, VB + row_k0 * LDR + h * 128, nkeys, lds, o, l_reg);
    if (hi == 0) li_l[r32] = l_reg;
    asm volatile("s_waitcnt lgkmcnt(0)" ::: "memory");
    int ob = (wid * QBLK + 4 * hi) * 512 + r32; asm volatile("" : "+v"(ob));
#pragma unroll
    for (int r = 0; r < 16; ++r) { const int oo = ob + ((r & 3) + 8 * (r >> 2)) * 512; const float rl = __builtin_amdgcn_rcpf(li_l[crow(r, hi)]);
#pragma unroll
      for (int d0 = 0; d0 < 4; ++d0) OSu[oo + d0 * 32] = o[d0][r] * rl; }
    asm volatile("s_waitcnt vmcnt(0)" ::: "memory");
    __syncthreads();
  }
  {
    f32x16 o[4]; float l_reg;
    attn_pass(QB + row_q0 * LDR + 256 + h * 64, KB + row_k0 * LDR + 256 + h * 64, VB + row_k0 * LDR + h * 128, nkeys, lds, o, l_reg);
    if (hi == 0) li_l[r32] = l_reg;
    asm volatile("s_waitcnt lgkmcnt(0)" ::: "memory");
    float ss[16];
    int ob = (wid * QBLK + 4 * hi) * 512 + r32; asm volatile("" : "+v"(ob));
#pragma unroll
    for (int r = 0; r < 16; ++r) { const int oo = ob + ((r & 3) + 8 * (r >> 2)) * 512; float s = 0.f; const float rl = lam * __builtin_amdgcn_rcpf(li_l[crow(r, hi)]);
#pragma unroll
      for (int d0 = 0; d0 < 4; ++d0) { const float v = OSu[oo + d0 * 32] - o[d0][r] * rl; o[d0][r] = v; s += v * v; }
      s += __shfl_xor(s, 1); s += __shfl_xor(s, 2); s += __shfl_xor(s, 4); s += __shfl_xor(s, 8); s += __shfl_xor(s, 16);
      ss[r] = (1.0f / sqrtf(s * (1.0f / 128.0f) + 1e-6f)) * outscale; asm volatile("" ::: "memory"); }
    float gs[4];
#pragma unroll
    for (int d0 = 0; d0 < 4; ++d0) gs[d0] = subg[d0 * 32 + r32];
    int cbo = (wid * QBLK + 4 * hi) * 1024 + r32; asm volatile("" : "+v"(cbo));
#pragma unroll
    for (int r = 0; r < 16; ++r) { const int co = cbo + ((r & 3) + 8 * (r >> 2)) * 1024;
#pragma unroll
      for (int d0 = 0; d0 < 4; ++d0) CATu[co + d0 * 32] = (bf16_t)(cvtpk(o[d0][r] * ss[r] * gs[d0], 0.f) & 0xffffu); }
    asm volatile("s_waitcnt vmcnt(0)" ::: "memory");
    __syncthreads();
  }
}
#undef KSWZ
#undef SBAR
}
typedef unsigned short bf16_t;
typedef float f32x4 __attribute__((ext_vector_type(4)));
typedef float f32x2 __attribute__((ext_vector_type(2)));
typedef unsigned u32x4 __attribute__((ext_vector_type(4)));
typedef unsigned u32x2 __attribute__((ext_vector_type(2)));
typedef short bf16x8 __attribute__((ext_vector_type(8)));

constexpr int D = 1024, NB = 8, SEQ = 4096, DEPTH = 4, CTXL = 256;
constexpr int RPB = CTXL + SEQ;
constexpr int RT = NB * RPB;
constexpr int PROJ = 2560, NE = 16, FF = 2048;
constexpr int CAP_L = 512, CAP_C = 32;
constexpr int ER = NB * CAP_L + NB * CAP_C;
constexpr int NWAVES = 8, NTHR = 512;
constexpr float EPS = 1e-6f;

constexpr size_t al256(size_t x) { return (x + 255) / 256 * 256; }
constexpr size_t WS_CTL   = 0;
constexpr size_t CTL_BYTES = 1u << 16;
constexpr size_t WS_MOD   = WS_CTL + CTL_BYTES;
constexpr size_t WS_ROPEC = al256(WS_MOD + (size_t)DEPTH * 9 * 6 * D * 4);
constexpr size_t WS_ROPES = WS_ROPEC + 64 * 16 * 4;
constexpr size_t WS_LAM   = WS_ROPES + 64 * 16 * 4;
constexpr size_t WS_SGUW  = al256(WS_LAM + 256);
constexpr size_t WS_XR    = al256(WS_SGUW + (size_t)DEPTH * 8 * 128 * 128 * 2);
constexpr size_t WS_HA    = al256(WS_XR + (size_t)RT * D * 4);
constexpr size_t WS_QB    = al256(WS_HA + (size_t)RT * D * 2);
constexpr size_t WS_KB    = al256(WS_QB + (size_t)RT * 512 * 2);
constexpr size_t WS_VB    = al256(WS_KB + (size_t)RT * 512 * 2);
constexpr size_t WS_UB    = al256(WS_VB + (size_t)RT * 512 * 2);
constexpr size_t WS_GVB   = al256(WS_UB + (size_t)RT * 512 * 2);
constexpr size_t WS_CAT   = al256(WS_GVB + (size_t)RT * 512 * 2);
constexpr size_t WS_OS    = al256(WS_CAT + (size_t)RT * D * 2);
constexpr size_t WS_AFF   = al256(WS_OS + (size_t)RT * 512 * 4);
constexpr size_t WS_INV   = al256(WS_AFF + (size_t)RT * 16 * 4);
constexpr size_t WS_RSRC  = al256(WS_INV + (size_t)RT * 16 * 4);
constexpr size_t WS_XS    = al256(WS_RSRC + (size_t)NE * ER * 4);
constexpr size_t WS_HID   = al256(WS_XS + (size_t)NE * ER * D * 2);
constexpr size_t WS_Y     = al256(WS_HID + (size_t)NE * ER * FF * 2);
constexpr size_t WS_WIN   = al256(WS_Y + (size_t)NE * ER * D * 2);
constexpr size_t WS_WOUT  = al256(WS_WIN + (size_t)DEPTH * PROJ * D * 2);
constexpr size_t WS_WGU   = al256(WS_WOUT + (size_t)DEPTH * D * D * 2);
constexpr size_t WS_WD    = al256(WS_WGU + (size_t)DEPTH * NE * 2 * FF * D * 2);
constexpr size_t WS_END   = al256(WS_WD + (size_t)DEPTH * NE * D * FF * 2);

constexpr int LDS_MISC = 147456 - 256;
constexpr int LDS_BYTES = 147456;

__device__ __forceinline__ unsigned f2bf(float f) { unsigned u = __builtin_bit_cast(unsigned, f); return (u + 0x7fffu + ((u >> 16) & 1u)) >> 16; }
__device__ __forceinline__ unsigned pk2(float lo, float hi) { return pg8::cvt_pk_bf16(lo, hi); }
__device__ __forceinline__ float bf2f(unsigned h) { return __builtin_bit_cast(float, h << 16); }
template <int CTRL> __device__ __forceinline__ float dpp(float x) { return __builtin_bit_cast(float, __builtin_amdgcn_mov_dpp(__builtin_bit_cast(int, x), CTRL, 0xf, 0xf, true)); }
constexpr int DPP_XOR1 = 0xB1, DPP_XOR2 = 0x4E, DPP_HMIR = 0x141, DPP_XOR8 = 0x128;
__device__ __forceinline__ float xrow16_sum(float x) {
    auto s = __builtin_amdgcn_permlane16_swap(__float_as_uint(x), __float_as_uint(x), false, false); x = __uint_as_float(s[0]) + __uint_as_float(s[1]);
    auto t = __builtin_amdgcn_permlane32_swap(__float_as_uint(x), __float_as_uint(x), false, false); return __uint_as_float(t[0]) + __uint_as_float(t[1]);
}
__device__ __forceinline__ float xrow16_max(float x) {
    auto s = __builtin_amdgcn_permlane16_swap(__float_as_uint(x), __float_as_uint(x), false, false); x = fmaxf(__uint_as_float(s[0]), __uint_as_float(s[1]));
    auto t = __builtin_amdgcn_permlane32_swap(__float_as_uint(x), __float_as_uint(x), false, false); return fmaxf(__uint_as_float(t[0]), __uint_as_float(t[1]));
}
__device__ __forceinline__ float wave_sum(float v) {
    v += dpp<DPP_XOR1>(v); v += dpp<DPP_XOR2>(v); v += dpp<DPP_HMIR>(v); v += dpp<DPP_XOR8>(v);
    return xrow16_sum(v);
}
#define LDS_WAIT() asm volatile("s_waitcnt lgkmcnt(0)" ::: "memory")

__constant__ double kFreq[16] = {1.0, 0.56234132519034908, 0.31622776601683794, 0.17782794100389228,
                                 0.1, 0.056234132519034908, 0.031622776601683794, 0.017782794100389228,
                                 0.01, 0.0056234132519034908, 0.0031622776601683794, 0.0017782794100389228,
                                 0.001, 0.00056234132519034908, 0.00031622776601683794, 0.00017782794100389228};
__constant__ float kLamInit[4] = {0.2f, 0.35550906759096926f, 0.47071301834358416f, 0.5560582041556405f};

__device__ __forceinline__ void sincos_d(double a, double& s, double& c) {
    const double TWO_OVER_PI = 0.63661977236758134308, PIO2_HI = 1.57079632679489655800e+00, PIO2_LO = 6.12323399573676603587e-17;
    const double kf = __builtin_rint(a * TWO_OVER_PI); const int k = (int)kf;
    const double r = (a - kf * PIO2_HI) - kf * PIO2_LO, r2 = r * r;
    double sp = -1.0 / 1307674368000.0; sp = sp * r2 + 1.0 / 6227020800.0; sp = sp * r2 - 1.0 / 39916800.0; sp = sp * r2 + 1.0 / 362880.0; sp = sp * r2 - 1.0 / 5040.0; sp = sp * r2 + 1.0 / 120.0; sp = sp * r2 - 1.0 / 6.0; sp = sp * r2 + 1.0;
    const double sr = sp * r;
    double cp = 1.0 / 20922789888000.0; cp = cp * r2 - 1.0 / 87178291200.0; cp = cp * r2 + 1.0 / 479001600.0; cp = cp * r2 - 1.0 / 3628800.0; cp = cp * r2 + 1.0 / 40320.0; cp = cp * r2 - 1.0 / 720.0; cp = cp * r2 + 1.0 / 24.0; cp = cp * r2 - 0.5; cp = cp * r2 + 1.0;
    const int q = k & 3;
    s = (q == 0) ? sr : (q == 1) ? cp : (q == 2) ? -sr : -cp;
    c = (q == 0) ? cp : (q == 1) ? -sr : (q == 2) ? -cp : sr;
}


__device__ __forceinline__ unsigned long long lds_ptr(LAS unsigned long long* tab, int i) {
    const unsigned long long v = tab[i];
    const unsigned lo = __builtin_amdgcn_readfirstlane((unsigned)v), hi = __builtin_amdgcn_readfirstlane((unsigned)(v >> 32));
    return ((unsigned long long)hi << 32) | lo;
}
struct Args { const float* in[23]; float* out; unsigned char* ws; int ph_lo, ph_hi; };
enum { I_X = 0, I_C, I_CTX, I_CCTX, I_WADA, I_BADA, I_N1G, I_N2G, I_WIN, I_WOUT, I_LQ1, I_LK1, I_LQ2, I_LK2, I_SUBG, I_SGUNG, I_SGUW, I_SGUB, I_WR, I_WG, I_WU, I_WDN, I_NFG };

__device__ __forceinline__ void transpose_item(const float* __restrict__ W, int N, int k0, int n0, bf16_t* __restrict__ WT, int K, int drow0, LAS float* scr, int lane) {
    float t[32];
#pragma unroll
    for (int i = 0; i < 32; ++i) { const int kk = 2 * i + (lane >> 5); t[i] = __builtin_nontemporal_load(&W[(size_t)(k0 + kk) * N + n0 + (lane & 31)]); }
#pragma unroll
    for (int i = 0; i < 32; ++i) { const int kk = 2 * i + (lane >> 5); scr[kk * 33 + (lane & 31)] = t[i]; }
    LDS_WAIT(); asm volatile("" ::: "memory");
    const int c = lane & 7;
#pragma unroll
    for (int j = 0; j < 4; ++j) { const int n = (lane >> 3) + 8 * j; const LAS float* s = scr + (8 * c) * 33 + n;
        u32x4 o; o.x = pk2(s[0 * 33], s[1 * 33]); o.y = pk2(s[2 * 33], s[3 * 33]); o.z = pk2(s[4 * 33], s[5 * 33]); o.w = pk2(s[6 * 33], s[7 * 33]);
        __builtin_nontemporal_store(o, (u32x4*)(WT + (size_t)(drow0 + n) * K + k0 + 8 * c)); }
    LDS_WAIT(); asm volatile("" ::: "memory");
}

__device__ __forceinline__ void row_load(const float* p, int lane, f32x4 (&v)[4]) {
    const f32x4* xr = (const f32x4*)p + lane;
#pragma unroll
    for (int j = 0; j < 4; ++j) v[j] = xr[64 * j];
}
__device__ __forceinline__ void row_store(float* p, int lane, const f32x4 (&v)[4]) {
    f32x4* xr = (f32x4*)p + lane;
#pragma unroll
    for (int j = 0; j < 4; ++j) xr[64 * j] = v[j];
}
__device__ __forceinline__ void row_load_bf(const bf16_t* p, int lane, f32x4 (&v)[4]) {
    const u32x2* xr = (const u32x2*)p + lane; u32x2 t[4];
#pragma unroll
    for (int j = 0; j < 4; ++j) t[j] = xr[64 * j];
#pragma unroll
    for (int j = 0; j < 4; ++j) v[j] = (f32x4){bf2f(t[j].x & 0xffffu), bf2f(t[j].x >> 16), bf2f(t[j].y & 0xffffu), bf2f(t[j].y >> 16)};
}
__device__ __forceinline__ void row_store_bf(bf16_t* p, int lane, const f32x4 (&v)[4]) {
    u32x2* xr = (u32x2*)p + lane;
#pragma unroll
    for (int j = 0; j < 4; ++j) { u32x2 w; w.x = pk2(v[j].x, v[j].y); w.y = pk2(v[j].z, v[j].w); xr[64 * j] = w; }
}
__device__ __forceinline__ float row_rstd(const f32x4 (&v)[4]) {
    float s = 0.f;
#pragma unroll
    for (int j = 0; j < 4; ++j) s += (v[j].x * v[j].x + v[j].y * v[j].y) + (v[j].z * v[j].z + v[j].w * v[j].w);
    return 1.0f / sqrtf(wave_sum(s) * (1.0f / D) + EPS);
}
__device__ __forceinline__ void norm_mod(f32x4 (&v)[4], const float* g, const float* sh, const float* sc, bf16_t* orow, int lane) {
    const float rstd = row_rstd(v);
    unsigned long long* o8 = (unsigned long long*)orow + lane;
#pragma unroll
    for (int j = 0; j < 4; ++j) {
        const f32x4 gg = ((const f32x4*)g)[lane + 64 * j], ss = ((const f32x4*)sh)[lane + 64 * j], cc = ((const f32x4*)sc)[lane + 64 * j];
        v[j] = (v[j] * rstd) * gg * (1.0f + cc) + ss;
        o8[64 * j] = (unsigned long long)pk2(v[j].x, v[j].y) | ((unsigned long long)pk2(v[j].z, v[j].w) << 32);
    }
}


__device__ __forceinline__ void load_mod(const float* g, const float* sh, const float* sc, int lane, f32x4 (&A)[4], f32x4 (&SH)[4]) {
#pragma unroll
    for (int j = 0; j < 4; ++j) { const f32x4 gg = ((const f32x4*)g)[lane + 64 * j], cc = ((const f32x4*)sc)[lane + 64 * j]; A[j] = gg * (1.0f + cc); SH[j] = ((const f32x4*)sh)[lane + 64 * j]; }
}
__device__ __forceinline__ void norm_mod2(f32x4 (&v)[4], const f32x4 (&A)[4], const f32x4 (&SH)[4], bf16_t* orow, int lane) {
    const float rstd = row_rstd(v);
    unsigned long long* o8 = (unsigned long long*)orow + lane;
#pragma unroll
    for (int j = 0; j < 4; ++j) { v[j] = (v[j] * rstd) * A[j] + SH[j];
        o8[64 * j] = (unsigned long long)pk2(v[j].x, v[j].y) | ((unsigned long long)pk2(v[j].z, v[j].w) << 32); }
}

__device__ __forceinline__ void norm_mod_lds(f32x4 (&v)[4], const LAS float* A, const LAS float* SH, bf16_t* orow, int lane) {
    const float rstd = row_rstd(v);
    unsigned long long* o8 = (unsigned long long*)orow + lane;
#pragma unroll
    for (int j = 0; j < 4; ++j) { v[j] = (v[j] * rstd) * *(const LAS f32x4*)(A + (lane + 64 * j) * 4) + *(const LAS f32x4*)(SH + (lane + 64 * j) * 4);
        o8[64 * j] = (unsigned long long)pk2(v[j].x, v[j].y) | ((unsigned long long)pk2(v[j].z, v[j].w) << 32); }
}

__device__ __forceinline__ float reduce16(const float (&p)[16], int lane) {
    float q8[8], q4[4], q2[2];
#pragma unroll
    for (int i = 0; i < 8; ++i) { auto rr = __builtin_amdgcn_permlane32_swap(__float_as_uint(p[i]), __float_as_uint(p[i + 8]), false, false); q8[i] = __uint_as_float(rr[0]) + __uint_as_float(rr[1]); }
    { const bool up = (lane & 16) != 0;
#pragma unroll
      for (int i = 0; i < 4; ++i) { const float snd = up ? q8[i] : q8[i + 4], kp = up ? q8[i + 4] : q8[i]; q4[i] = kp + __shfl_xor(snd, 16); } }
    { const bool up = (lane & 8) != 0;
#pragma unroll
      for (int i = 0; i < 2; ++i) { const float snd = up ? q4[i] : q4[i + 2], kp = up ? q4[i + 2] : q4[i]; q2[i] = kp + dpp<DPP_XOR8>(snd); } }
    float r;
    { const bool up = (lane & 4) != 0; const float snd = up ? q2[0] : q2[1], kp = up ? q2[1] : q2[0]; r = kp + dpp<DPP_HMIR>(snd); }
    r += dpp<DPP_XOR2>(r); r += dpp<DPP_XOR1>(r);
    return r;
}
__device__ __forceinline__ int lane_expert(int lane) { return ((lane >> 5) & 1) * 8 + ((lane >> 4) & 1) * 4 + ((lane >> 3) & 1) * 2 + ((lane >> 2) & 1); }

struct EpiInProj {
    static constexpr bool PERM = false, TWICE = true;
    bf16_t *Q, *Kb, *V, *U, *GV; const float *ropeC, *ropeS;
    __device__ __forceinline__ void operator()(const pg8::f32x4 (&acc)[2][2][4][2], const pg8::Unit& u, int wr, int wc, int fr_, int fq_) const {
        int fr = fr_, fq = fq_; asm volatile("" : "+v"(fr), "+v"(fq));
        const int type = u.pn >> 1;
        bf16_t* base = type == 0 ? Q : type == 1 ? Kb : type == 2 ? V : type == 3 ? U : GV;
        const int col0 = (u.pn & 1) * 256 + wc * 32 + 4 * fq;
        const int row0 = u.pm * 256 + wr * 64 + fr;
        const bool lat = (u.pm % 17) != 0;
        const float qs = (type == 0) ? 0.125f : 1.0f;
        if (type <= 1) {
            f32x4 csT[4], snT[4];
            const bool colax = (wc & 1) != 0;
#pragma unroll
            for (int t = 0; t < 4; ++t) { csT[t] = (f32x4){1.f, 1.f, 1.f, 1.f}; snT[t] = (f32x4){0.f, 0.f, 0.f, 0.f}; }
            if (lat) {
                if (colax) {
#pragma unroll
                    for (int m = 0; m < 4; ++m) { const int pos = m * 16 + fr; csT[m] = *(const f32x4*)(ropeC + pos * 16 + 4 * fq); snT[m] = *(const f32x4*)(ropeS + pos * 16 + 4 * fq); }
                } else {
#pragma unroll
                    for (int ai = 0; ai < 2; ++ai) { const int pos = (((row0 + ai * 128) % RPB) - CTXL) >> 6; csT[ai] = *(const f32x4*)(ropeC + pos * 16 + 4 * fq); snT[ai] = *(const f32x4*)(ropeS + pos * 16 + 4 * fq); }
                }
            }
            asm volatile("" ::: "memory");
#pragma unroll
            for (int ai = 0; ai < 2; ++ai)
#pragma unroll
                for (int m = 0; m < 4; ++m) {
                    const int row = row0 + ai * 128 + m * 16;
                    const f32x4 cs = colax ? csT[m] : csT[ai], sn = colax ? snT[m] : snT[ai];
                    bf16_t* rowp = base + (size_t)row * 512 + col0;
#pragma unroll
                    for (int bj = 0; bj < 2; ++bj) {
                        const f32x4 t0 = acc[ai][bj][m][0], t1 = acc[ai][bj][m][1];
                        const f32x4 o0 = (t0 * cs - t1 * sn) * qs, o1 = (t1 * cs + t0 * sn) * qs;
                        u32x2 w0, w1; w0.x = pk2(o0[0], o0[1]); w0.y = pk2(o0[2], o0[3]); w1.x = pk2(o1[0], o1[1]); w1.y = pk2(o1[2], o1[3]);
                        *(u32x2*)(rowp + bj * 128) = w0; *(u32x2*)(rowp + bj * 128 + 16) = w1;
                    }
                }
        } else if (type == 2) {
#pragma unroll
            for (int ai = 0; ai < 2; ++ai)
#pragma unroll
                for (int m = 0; m < 4; ++m) {
                    bf16_t* rowp = base + (size_t)(row0 + ai * 128 + m * 16) * 512 + col0;
#pragma unroll
                    for (int bj = 0; bj < 2; ++bj)
#pragma unroll
                        for (int n = 0; n < 2; ++n) {
                            const f32x4 v = acc[ai][bj][m][n];
                            u32x2 w; w.x = pk2(v[0], v[1]); w.y = pk2(v[2], v[3]);
                            *(u32x2*)(rowp + bj * 128 + n * 16) = w;
                        }
                }
        } else {
#pragma unroll
            for (int ai = 0; ai < 2; ++ai)
#pragma unroll
                for (int m = 0; m < 4; ++m) {
                    bf16_t* rowp = base + (size_t)(row0 + ai * 128 + m * 16) * 512 + col0;
                    u32x2 w[2][2];
#pragma unroll
                    for (int bj = 0; bj < 2; ++bj)
#pragma unroll
                        for (int n = 0; n < 2; ++n) {
                            f32x4 v = acc[ai][bj][m][n];
#ifdef GELU_X2
                            { f32x4 t_ = pg8::gelu4(v * 1.0001f); asm volatile("" :: "v"(t_)); }
#endif
                            v = pg8::gelu4(v);
                            w[bj][n].x = pk2(v[0], v[1]); w[bj][n].y = pk2(v[2], v[3]);
                        }
#pragma unroll
                    for (int bj = 0; bj < 2; ++bj)
#pragma unroll
                        for (int n = 0; n < 2; ++n) *(u32x2*)(rowp + bj * 128 + n * 16) = w[bj][n];
                }
        }
    }
};
struct EpiOutProj {
    static constexpr bool PERM = true, TWICE = false;
    bf16_t* XR; const float* modl; float scale;
    __device__ __forceinline__ void operator()(const pg8::f32x4 (&acc)[2][2][4][2], const pg8::Unit& u, int wr, int wc, int fr_, int fq_) const {
        int fr = fr_, fq = fq_; asm volatile("" : "+v"(fr), "+v"(fq));
        const int b = u.pm / 17; const int mrow = (u.pm % 17) == 0 ? 8 : b;
        const int col0 = u.pn * 256 + wc * 32 + 8 * fq, row0 = u.pm * 256 + wr * 64 + fr;
        const float* gp = modl + (size_t)mrow * 6144 + 2 * D + col0;
        f32x4 gv[2][2];
#pragma unroll
        for (int bj = 0; bj < 2; ++bj)
#pragma unroll
            for (int n = 0; n < 2; ++n) gv[bj][n] = *(const f32x4*)(gp + bj * 128 + n * 4);
#pragma unroll
        for (int ai = 0; ai < 2; ++ai) {
            u32x4 xv[4][2];
#pragma unroll
            for (int m = 0; m < 4; ++m)
#pragma unroll
                for (int bj = 0; bj < 2; ++bj) xv[m][bj] = *(const u32x4*)(XR + (size_t)(row0 + ai * 128 + m * 16) * D + col0 + bj * 128);
            asm volatile("" ::: "memory");
#pragma unroll
            for (int m = 0; m < 4; ++m)
#pragma unroll
                for (int bj = 0; bj < 2; ++bj) {
                    const u32x4 x = xv[m][bj];
                    const f32x4 x0 = (f32x4){bf2f(x.x & 0xffffu), bf2f(x.x >> 16), bf2f(x.y & 0xffffu), bf2f(x.y >> 16)}, x1 = (f32x4){bf2f(x.z & 0xffffu), bf2f(x.z >> 16), bf2f(x.w & 0xffffu), bf2f(x.w >> 16)};
                    const f32x4 o0 = x0 + gv[bj][0] * acc[ai][bj][m][0], o1 = x1 + gv[bj][1] * acc[ai][bj][m][1];
                    u32x4 w; w.x = pk2(o0.x, o0.y); w.y = pk2(o0.z, o0.w); w.z = pk2(o1.x, o1.y); w.w = pk2(o1.z, o1.w);
                    *(u32x4*)(XR + (size_t)(row0 + ai * 128 + m * 16) * D + col0 + bj * 128) = w;
                }
            asm volatile("" ::: "memory");
        }
    }
};
struct EpiGateUp {
    static constexpr bool PERM = true;
    bf16_t* HID;
    __device__ __forceinline__ void operator()(const pg8::f32x4 (&acc)[2][2][4][2], const pg8::Unit& u, int wr, int wc, int fr_, int fq_) const {
        int fr = fr_, fq = fq_; asm volatile("" : "+v"(fr), "+v"(fq));
        const int j = u.pn & 15; const int col0 = j * 128 + wc * 32 + 8 * fq, row0 = u.pm * 256 + wr * 64 + fr;
#pragma unroll
        for (int ai = 0; ai < 2; ++ai)
#pragma unroll
            for (int m = 0; m < 4; ++m) {
                float hv[8];
#pragma unroll
                for (int n = 0; n < 2; ++n)
#pragma unroll
                    for (int i = 0; i < 4; ++i) { const float gt = acc[ai][0][m][n][i], up = acc[ai][1][m][n][i];
                        hv[n * 4 + i] = gt * __builtin_amdgcn_rcpf(1.0f + __expf(-gt)) * up; }
                u32x4 w; w.x = pk2(hv[0], hv[1]); w.y = pk2(hv[2], hv[3]); w.z = pk2(hv[4], hv[5]); w.w = pk2(hv[6], hv[7]);
                *(u32x4*)(HID + (size_t)(row0 + ai * 128 + m * 16) * FF + col0) = w;
            }
    }
};
struct EpiDown {
    static constexpr bool PERM = true, TWICE = false;
    bf16_t* Y;
    __device__ __forceinline__ void operator()(const pg8::f32x4 (&acc)[2][2][4][2], const pg8::Unit& u, int wr, int wc, int fr_, int fq_) const {
        int fr = fr_, fq = fq_; asm volatile("" : "+v"(fr), "+v"(fq));
        const int col0 = (u.pn & 3) * 256 + wc * 32 + 8 * fq, row0 = u.pm * 256 + wr * 64 + fr;
#pragma unroll
        for (int ai = 0; ai < 2; ++ai)
#pragma unroll
            for (int m = 0; m < 4; ++m) { bf16_t* rowp = Y + (size_t)(row0 + ai * 128 + m * 16) * D + col0;
#pragma unroll
                for (int bj = 0; bj < 2; ++bj) { const f32x4 v0 = acc[ai][bj][m][0], v1 = acc[ai][bj][m][1];
                    u32x4 w; w.x = pk2(v0[0], v0[1]); w.y = pk2(v0[2], v0[3]); w.z = pk2(v1[0], v1[1]); w.w = pk2(v1[2], v1[3]);
                    *(u32x4*)(rowp + bj * 128) = w; } }
    }
};

#define GAS1 __attribute__((address_space(1)))
#define INP(i) ((const float*)(GAS1 const float*)lds_ptr(ptab, (i)))
#define MOD   ((float*)(ws + WS_MOD))
#define ROPEC ((float*)(ws + WS_ROPEC))
#define ROPES ((float*)(ws + WS_ROPES))
#define LAMV  ((float*)(ws + WS_LAM))
#define SGUW  ((bf16_t*)(ws + WS_SGUW))
#define XR    ((bf16_t*)(ws + WS_XR))
#define HA    ((bf16_t*)(ws + WS_HA))
#define QB    ((bf16_t*)(ws + WS_QB))
#define KB    ((bf16_t*)(ws + WS_KB))
#define VB    ((bf16_t*)(ws + WS_VB))
#define UB    ((bf16_t*)(ws + WS_UB))
#define GVB   ((bf16_t*)(ws + WS_GVB))
#define CAT   ((bf16_t*)(ws + WS_CAT))
#define OS    ((float*)(ws + WS_OS))
#define AFF   ((float*)(ws + WS_AFF))
#define INV   ((int*)(ws + WS_INV))
#define RSRC  ((int*)(ws + WS_RSRC))
#define XS    ((bf16_t*)(ws + WS_XS))
#define HID   ((bf16_t*)(ws + WS_HID))
#define Y     ((bf16_t*)(ws + WS_Y))
#define WIN   ((bf16_t*)(ws + WS_WIN))
#define WOUT  ((bf16_t*)(ws + WS_WOUT))
#define WGU   ((bf16_t*)(ws + WS_WGU))
#define WD    ((bf16_t*)(ws + WS_WD))
#define modl  (MOD + (size_t)l * 9 * 6144)
#define PIN_WS() unsigned char* const ws = (unsigned char*)(GAS1 unsigned char*)lds_ptr(ptab, 24)
#define PIN_IDS2() int tid = threadIdx.x; asm volatile("" : "+v"(tid)); const int lane = tid & 63, wave = __builtin_amdgcn_readfirstlane(tid >> 6)
#define PIN_IDS() int tid = threadIdx.x; asm volatile("" : "+v"(tid)); const int lane = tid & 63, wave = __builtin_amdgcn_readfirstlane(tid >> 6), gw = bx * NWAVES + wave; (void)lane; (void)gw; PIN_WS()
#ifndef PH_MASK
#define PH_MASK 0x7ff
#endif
#define INR(k) (lo <= (k) && (k) < hi)
#define IN(k) (((PH_MASK >> (k)) & 1) && INR(k))
#define INL(c) (((PH_MASK >> (2 + (c))) & 1) && INR(pb + (c)))
#ifndef PH_DUP
#define PH_DUP 0
#endif
#define REPS(c) (((PH_DUP >> (c)) & 1) ? 2 : 1)
#define SEAM(k) do { if (INR(k) && INR((k) + 1)) xcd_barrier(bar); } while (0)

constexpr size_t CTL_QUEUE = 16384;
__device__ __forceinline__ int queue_pull(unsigned* ctr, volatile LAS unsigned* slot, int tid) {
    __syncthreads();
    if (tid == 0) *slot = __hip_atomic_fetch_add(ctr, 1u, __ATOMIC_RELAXED, __HIP_MEMORY_SCOPE_AGENT);
    __syncthreads();
    return __builtin_amdgcn_readfirstlane((int)*slot);
}
constexpr int IT_IN = 16 * 80, IT_OUT = 16 * 32, IT_E = 1024, IT_L = IT_IN + IT_OUT + NE * 3 * IT_E;
__device__ __forceinline__ void convert_range(LAS unsigned long long* ptab, unsigned char* ws, LAS unsigned char* ldsl, int l, int it0, int it1, int rank, int nranks, int wave, int lane) {
    LAS float* scr = (LAS float*)(ldsl + 65536 + wave * 8704);
#pragma unroll 1
    for (int it = it0 + rank; it < it1; it += nranks) {
        int r = it;
        if (r < IT_IN) { const int kb = r / 80, nb = r % 80; transpose_item(INP(I_WIN) + (size_t)l * D * PROJ, PROJ, kb * 64, nb * 32, WIN + (size_t)l * PROJ * D, D, nb * 32, scr, lane); continue; }
        r -= IT_IN;
        if (r < IT_OUT) { const int kb = r / 32, nb = r % 32; transpose_item(INP(I_WOUT) + (size_t)l * D * D, D, kb * 64, nb * 32, WOUT + (size_t)l * D * D, D, nb * 32, scr, lane); continue; }
        r -= IT_OUT;
        if (r < NE * 2 * IT_E) { const int e = r / (2 * IT_E), which = (r % (2 * IT_E)) / IT_E, q = r % IT_E; const size_t le = (size_t)l * NE + e;
            const int kb = q / 64, nb = q % 64, n0 = nb * 32;
            transpose_item(INP(which == 0 ? I_WG : I_WU) + le * D * FF, FF, kb * 64, n0, WGU + le * (2 * FF) * D, D, 256 * (n0 >> 7) + which * 128 + (n0 & 127), scr, lane); continue; }
        r -= NE * 2 * IT_E;
        { const int e = r / IT_E, q = r % IT_E; const size_t le = (size_t)l * NE + e; const int kb = q / 32, nb = q % 32;
            transpose_item(INP(I_WDN) + le * FF * D, D, kb * 64, nb * 32, WD + le * D * FF, FF, nb * 32, scr, lane); }
    }
}
constexpr int CV_P = 26444, CV_Q = CV_P + 12000;
template <int L>
__device__ __forceinline__ void layer_body(unsigned char* lds, LAS unsigned char* ldsl, LAS unsigned long long* ptab, const XcdBarrier& bar, const int lo, const int hi, const int G, const int bx, const int NGW) {
    constexpr int l = L, pb = 2 + 9 * L; constexpr bool lastl = (L == DEPTH - 1);
        _Pragma("unroll 1") for (int rep = 0; rep < REPS(2); ++rep) {
        if (INL(0)) {
            PIN_WS();
            pg8::Gemm g{HA, WIN + (size_t)l * PROJ * D, RT, PROJ, D}; pg8::StaticOrder S; S.init(RT, PROJ, G, bx);
            EpiInProj E{QB, KB, VB, UB, GVB, ROPEC, ROPES};
            pg8::gemm_phase<EpiInProj, pg8::StaticOrder>(ldsl, g, S, E);
            if (G == 256 && bx >= 80) { PIN_IDS2(); convert_range(ptab, ws, ldsl, l, CV_P, CV_Q, (bx - 80) * NWAVES + wave, (G - 80) * NWAVES, wave, lane); }
        }
        SEAM(pb + 0); }
        _Pragma("unroll 1") for (int rep = 0; rep < REPS(3); ++rep) {
        if (INL(1)) {
            PIN_IDS();
            const float lam = LAMV[l], osc = 1.0f - kLamInit[l];
            const float* subg = INP(I_SUBG) + l * 128;
            constexpr int NU_LAT = NB * 4 * 16, NU_CTX = NB * 4, NU_SGU = NB * 34;
            const int vcu = (G % 8 == 0) ? (bx % 8) * (G / 8) + bx / 8 : bx;
            unsigned* qA = (unsigned*)(ws + WS_CTL + CTL_QUEUE + (l * 2 + 0) * 64); unsigned* qB = (unsigned*)(ws + WS_CTL + CTL_QUEUE + (l * 2 + 1) * 64);
            volatile LAS unsigned* qslot = (volatile LAS unsigned*)(ldsl + LDS_MISC + 16);
            bool dyn = false;
            for (int u = vcu;;) {
                if (!dyn && u >= NU_LAT) dyn = true;
                if (dyn) { if (lastl) break;
                    const int it = queue_pull(qA, qslot, tid); if (it >= NU_CTX) break; u = NU_LAT + it; }
                {
                    int b, h; long rq0; int nk;
                    if (u < NU_LAT) { b = u >> 6; h = (u >> 4) & 3; rq0 = (long)b * RPB + CTXL + (u & 15) * 256; nk = RPB; }
                    else { const int v2 = u - NU_LAT; b = v2 >> 2; h = v2 & 3; rq0 = (long)b * RPB; nk = CTXL; }
#ifndef NO_ATT
                    att::attn_unit(QB, KB, VB, OS, CAT, subg, lam, osc, h, rq0, (long)b * RPB, nk, (char*)lds);
#endif
                }
                if (!dyn) u += G;
            }
            {
            int tid2 = threadIdx.x; asm volatile("" : "+v"(tid2)); const int lane = tid2 & 63, wave = __builtin_amdgcn_readfirstlane(tid2 >> 6);
            constexpr int NHU = NU_SGU * 2;
            for (;;) { const int s = queue_pull(qB, qslot, tid2); if (s >= NHU) break;
                const int b = s / 68, rem = s % 68, ch = rem >> 1, hg = rem & 1;
                if (lastl && ch < 2) continue;
                {
#ifndef NO_SGU
                    const int hl2 = wave & 3, ph = wave >> 2, h = hg * 4 + hl2;
                    const size_t r0 = (size_t)b * RPB + ch * 128;
                    const int fr = lane & 15, fq = lane >> 4;
                    const bf16_t* Wh = SGUW + ((size_t)l * 8 + h) * 128 * 128;
                    const float* bs = INP(I_SGUB) + (l * 8 + h) * 128;
                    u32x4 uu[4][2]; bf16x8 afA[4], afB[4];
#pragma unroll
                    for (int i = 0; i < 4; ++i)
#pragma unroll
                        for (int gi = 0; gi < 2; ++gi) uu[i][gi] = *(const u32x4*)(UB + (r0 + (ph * 4 + i) * 16 + fr) * 512 + h * 64 + gi * 32 + fq * 8);
#pragma unroll
                    for (int ks = 0; ks < 4; ++ks) { afA[ks] = *(const bf16x8*)(Wh + (size_t)(ph * 64 + fr) * 128 + ks * 32 + fq * 8); afB[ks] = *(const bf16x8*)(Wh + (size_t)(ph * 64 + 16 + fr) * 128 + ks * 32 + fq * 8); }
                    {
                        const int hf = lane >> 5, l32 = lane & 31, hl = l32 >> 3, e8 = (l32 & 7) * 8;
                        const bf16_t* gsrc = GVB + (r0 + wave * 16 + hf * 8) * 512 + hg * 256 + l32 * 8;
                        const f32x4 ga = *(const f32x4*)(INP(I_SGUNG) + l * 512 + hg * 256 + l32 * 8), gb = *(const f32x4*)(INP(I_SGUNG) + l * 512 + hg * 256 + l32 * 8 + 4);
                        const float gg[8] = {ga.x, ga.y, ga.z, ga.w, gb.x, gb.y, gb.z, gb.w};
                        LAS bf16_t* gTh = (LAS bf16_t*)(ldsl + hl * 17424);
                        int slot[8];
#pragma unroll
                        for (int j = 0; j < 8; ++j) { const int e = e8 + j; slot[j] = ((e & 32) + 16 * ((e >> 2) & 1) + 4 * ((e & 31) >> 3) + (e & 3)) * 136; }
                        u32x4 raw[8];
#pragma unroll
                        for (int t = 0; t < 8; ++t) raw[t] = *(const u32x4*)(gsrc + t * 512);
#pragma unroll
                        for (int tb = 0; tb < 2; ++tb) {
                            float xn[4][8];
#pragma unroll
                            for (int t = 0; t < 4; ++t) {
                                float ssq = 0.f;
#pragma unroll
                                for (int k = 0; k < 4; ++k) { xn[t][2 * k] = bf2f(raw[tb * 4 + t][k] & 0xffffu); xn[t][2 * k + 1] = bf2f(raw[tb * 4 + t][k] >> 16); ssq += xn[t][2 * k] * xn[t][2 * k] + xn[t][2 * k + 1] * xn[t][2 * k + 1]; }
                                ssq += __shfl_xor(ssq, 1); ssq += __shfl_xor(ssq, 2); ssq += __shfl_xor(ssq, 4);
                                const float rs = 1.0f / sqrtf(ssq * (1.0f / 64.0f) + EPS);
#pragma unroll
                                for (int j = 0; j < 8; ++j) xn[t][j] = xn[t][j] * rs * gg[j];
                            }
                            const int q0 = wave * 16 + hf * 8 + tb * 4;
#pragma unroll
                            for (int j = 0; j < 8; ++j) { u32x2 w; w.x = pk2(xn[0][j], xn[1][j]); w.y = pk2(xn[2][j], xn[3][j]); *(LAS u32x2*)(gTh + slot[j] + q0) = w; }
                        }
                    }
                    __syncthreads();
                    {
                        LAS bf16_t* gT = (LAS bf16_t*)(ldsl + hl2 * 17424);
#pragma unroll
                        for (int i = 0; i < 4; ++i) {
                            const int p = (ph * 4 + i) * 16 + fr;
                            bf16x8 af[4];
#pragma unroll
                            for (int ks = 0; ks < 4; ++ks) af[ks] = (i & 1) ? afB[ks] : afA[ks];
                            if (i + 2 < 4) {
#pragma unroll
                                for (int ks = 0; ks < 4; ++ks) { const bf16x8 nv = *(const bf16x8*)(Wh + (size_t)(p + 32) * 128 + ks * 32 + fq * 8); if (i & 1) afB[ks] = nv; else afA[ks] = nv; } }
                            const float bsp = bs[p];
#pragma unroll
                            for (int gi = 0; gi < 2; ++gi) {
                                pg8::f32x4 a0 = (pg8::f32x4){0.f, 0.f, 0.f, 0.f}, a1 = (pg8::f32x4){0.f, 0.f, 0.f, 0.f};
#pragma unroll
                                for (int ks = 0; ks < 4; ++ks) {
                                    const bf16x8 b0 = *(const LAS bf16x8*)(gT + (gi * 32 + fr) * 136 + ks * 32 + fq * 8), b1 = *(const LAS bf16x8*)(gT + (gi * 32 + 16 + fr) * 136 + ks * 32 + fq * 8);
                                    a0 = __builtin_amdgcn_mfma_f32_16x16x32_bf16(b0, af[ks], a0, 0, 0, 0); a1 = __builtin_amdgcn_mfma_f32_16x16x32_bf16(b1, af[ks], a1, 0, 0, 0); }
                                const u32x4 ur = uu[i][gi];
                                u32x4 w;
                                w.x = pk2(bf2f(ur.x & 0xffffu) * (a0[0] + bsp), bf2f(ur.x >> 16) * (a0[1] + bsp)); w.y = pk2(bf2f(ur.y & 0xffffu) * (a0[2] + bsp), bf2f(ur.y >> 16) * (a0[3] + bsp));
                                w.z = pk2(bf2f(ur.z & 0xffffu) * (a1[0] + bsp), bf2f(ur.z >> 16) * (a1[1] + bsp)); w.w = pk2(bf2f(ur.w & 0xffffu) * (a1[2] + bsp), bf2f(ur.w >> 16) * (a1[3] + bsp));
                                *(u32x4*)(CAT + (r0 + p) * 1024 + 512 + h * 64 + gi * 32 + fq * 8) = w;
                            }
                            asm volatile("" ::: "memory");
                        }
                    }
                    LDS_WAIT(); asm volatile("" ::: "memory");
                    __syncthreads();
#endif
                }
            }
            }
        }
        SEAM(pb + 1); }
        _Pragma("unroll 1") for (int rep = 0; rep < REPS(4); ++rep) {
        if (INL(2)) {
            PIN_WS();
            pg8::Gemm g{CAT, WOUT + (size_t)l * D * D, RT, D, D}; pg8::GroupedOrder S; S.init(NB, lastl ? 16 : 17, 17, lastl ? 1 : 0, D / 256, 0, G, bx);
            EpiOutProj E{XR, modl, rep == 0 ? 1.0f : 0.0f};
            pg8::gemm_phase<EpiOutProj, pg8::GroupedOrder>(ldsl, g, S, E);
            if (G == 256 && bx >= 32) { PIN_IDS2(); convert_range(ptab, ws, ldsl, l, CV_Q, IT_L, (bx - 32) * NWAVES + wave, (G - 32) * NWAVES, wave, lane); }
        }
        SEAM(pb + 2); }
        _Pragma("unroll 1") for (int rep = 0; rep < REPS(5); ++rep) {
        if (INL(3)) {
            PIN_IDS();
            constexpr int WSTR = 1028;
            constexpr int NG16 = RT / 16;
            const int r16 = lane & 15, kq = lane >> 4;
            u32x4 raw[32];
            const bool pre0 = (gw < NG16) && !(lastl && ((gw * 16) % RPB) < CTXL);
            if (pre0) { const u32x4* src0 = (const u32x4*)(XR + (size_t)(gw * 16 + r16) * D + 8 * kq);
#pragma unroll
                for (int t = 0; t < 32; ++t) raw[t] = src0[4 * t]; }
            LAS float* wT = (LAS float*)ldsl;
            { const f32x4* wsrc = (const f32x4*)(INP(I_WR) + (size_t)l * 1024 * 16); f32x4 wv[8];
#pragma unroll
              for (int t = 0; t < 8; ++t) wv[t] = wsrc[tid + NTHR * t];
#pragma unroll
              for (int t = 0; t < 8; ++t) { const int i4 = tid + NTHR * t, k = i4 >> 2, e0 = (i4 & 3) * 4;
                  wT[(e0 + 0) * WSTR + k] = wv[t].x; wT[(e0 + 1) * WSTR + k] = wv[t].y; wT[(e0 + 2) * WSTR + k] = wv[t].z; wT[(e0 + 3) * WSTR + k] = wv[t].w; } }
            LAS float* modA = (LAS float*)(ldsl + 16 * WSTR * 4);
            LAS float* modS = modA + 9 * 1024;
            for (int i = tid; i < 9 * 256; i += NTHR) { const int c = i >> 8, k4 = i & 255;
                if (G == 256 && c != bx / 34 && c != 7 && c != 8) continue;
                const float* mm = modl + (size_t)c * 6144; const f32x4 gg = ((const f32x4*)(INP(I_N2G) + l * D))[k4], ss = ((const f32x4*)(mm + 3 * D))[k4], cc = ((const f32x4*)(mm + 4 * D))[k4];
                *(LAS f32x4*)(modA + c * 1024 + k4 * 4) = gg * (1.0f + cc); *(LAS f32x4*)(modS + c * 1024 + k4 * 4) = ss; }
            __syncthreads();
            {
            const bool spread = (NGW == 2048);
#pragma unroll 1
            for (int pass = 0;; ++pass) {
                int grp;
                if (spread) { if (pass == 0) grp = gw; else if (pass == 1 && (gw & 15) == 0) grp = 2048 + (gw >> 4); else break; }
                else { grp = gw + pass * NGW; }
                if (grp >= NG16) break;
                const int row0 = grp * 16, b = row0 / RPB, j0 = row0 % RPB;
                if (lastl && j0 < CTXL) continue;
                const int mrow = (j0 < CTXL) ? 8 : b;
                const int row = row0 + r16;
                if (pass > 0) { const u32x4* src = (const u32x4*)(XR + (size_t)row * D + 8 * kq);
#pragma unroll
                    for (int t = 0; t < 32; ++t) raw[t] = src[4 * t]; }
                float ssq = 0.f;
#pragma unroll
                for (int t = 0; t < 32; ++t)
#pragma unroll
                    for (int c = 0; c < 4; ++c) { float lo_, hi_;
                        asm volatile("v_lshlrev_b32 %1, 16, %3\n\tv_and_b32 %2, 0xffff0000, %3\n\tv_fmac_f32 %0, %1, %1\n\tv_fmac_f32 %0, %2, %2" : "+v"(ssq), "=&v"(lo_), "=&v"(hi_) : "v"(raw[t][c])); }
                ssq = xrow16_sum(ssq);
                const float rstd = 1.0f / sqrtf(ssq * (1.0f / D) + EPS);
                const LAS float* Ac = modA + mrow * 1024 + 8 * kq; const LAS float* Sc = modS + mrow * 1024 + 8 * kq; const LAS float* Wc = wT + r16 * WSTR + 8 * kq;
                u32x4* dst = (u32x4*)(HA + (size_t)row * D + 8 * kq);
                pg8::f32x4 acc0 = (pg8::f32x4){0.f, 0.f, 0.f, 0.f}, acc1 = (pg8::f32x4){0.f, 0.f, 0.f, 0.f};
#pragma unroll
                for (int t = 0; t < 32; ++t) {
                    const f32x4 a0 = *(const LAS f32x4*)(Ac + 32 * t), a1 = *(const LAS f32x4*)(Ac + 32 * t + 4), s0 = *(const LAS f32x4*)(Sc + 32 * t), s1 = *(const LAS f32x4*)(Sc + 32 * t + 4);
                    const f32x4 w0 = *(const LAS f32x4*)(Wc + 32 * t), w1 = *(const LAS f32x4*)(Wc + 32 * t + 4);
                    const u32x4 rw = raw[t];
                    f32x4 h0 = (f32x4){bf2f(rw.x & 0xffffu), bf2f(rw.x >> 16), bf2f(rw.y & 0xffffu), bf2f(rw.y >> 16)}, h1 = (f32x4){bf2f(rw.z & 0xffffu), bf2f(rw.z >> 16), bf2f(rw.w & 0xffffu), bf2f(rw.w >> 16)};
                    h0 = (h0 * rstd) * a0 + s0; h1 = (h1 * rstd) * a1 + s1;
                    u32x4 o; o.x = pk2(h0.x, h0.y); o.y = pk2(h0.z, h0.w); o.z = pk2(h1.x, h1.y); o.w = pk2(h1.z, h1.w);
                    dst[4 * t] = o;
                    acc0 = __builtin_amdgcn_mfma_f32_16x16x4f32(w0.x, h0.x, acc0, 0, 0, 0); acc1 = __builtin_amdgcn_mfma_f32_16x16x4f32(w0.y, h0.y, acc1, 0, 0, 0);
                    acc0 = __builtin_amdgcn_mfma_f32_16x16x4f32(w0.z, h0.z, acc0, 0, 0, 0); acc1 = __builtin_amdgcn_mfma_f32_16x16x4f32(w0.w, h0.w, acc1, 0, 0, 0);
                    acc0 = __builtin_amdgcn_mfma_f32_16x16x4f32(w1.x, h1.x, acc0, 0, 0, 0); acc1 = __builtin_amdgcn_mfma_f32_16x16x4f32(w1.y, h1.y, acc1, 0, 0, 0);
                    acc0 = __builtin_amdgcn_mfma_f32_16x16x4f32(w1.z, h1.z, acc0, 0, 0, 0); acc1 = __builtin_amdgcn_mfma_f32_16x16x4f32(w1.w, h1.w, acc1, 0, 0, 0);
                    asm volatile("" ::: "memory");
                }
                const pg8::f32x4 lg = acc0 + acc1;
                float mx = fmaxf(fmaxf(lg[0], lg[1]), fmaxf(lg[2], lg[3])); mx = xrow16_max(mx);
                f32x4 ex; ex.x = expf(lg[0] - mx); ex.y = expf(lg[1] - mx); ex.z = expf(lg[2] - mx); ex.w = expf(lg[3] - mx);
                float sm = (ex.x + ex.y) + (ex.z + ex.w); sm = xrow16_sum(sm);
                const float inv = 1.0f / sm;
                *(f32x4*)(AFF + (size_t)row * 16 + 4 * kq) = ex * inv;
            }
            }
            __syncthreads();
        }
        SEAM(pb + 3); }
        _Pragma("unroll 1") for (int rep = 0; rep < REPS(6); ++rep) {
        if (INL(4)) {
            PIN_IDS();
            LAS unsigned* keys = (LAS unsigned*)ldsl;
            LAS unsigned* hist = keys + 4096;
            LAS unsigned* wtot = hist + 256;
            LAS unsigned* sel = wtot + 8;
            for (int gq = bx; gq < (lastl ? 128 : 256); gq += G) {
                const int stream = gq >> 7, b = (gq >> 4) & 7, e = gq & 15;
                const int n = stream ? CTXL : SEQ, cap = stream ? CAP_C : CAP_L;
                const int row0 = b * RPB + (stream ? 0 : CTXL), sbase = stream ? NB * CAP_L + b * CAP_C : b * CAP_L;
                { unsigned kv8[8];
#pragma unroll
                  for (int t = 0; t < 8; ++t) { const int i = tid + NTHR * t; kv8[t] = (i < n) ? __float_as_uint(AFF[(size_t)(row0 + i) * 16 + e]) : 0u; }
#pragma unroll
                  for (int t = 0; t < 8; ++t) { const int i = tid + NTHR * t; if (i < n) keys[i] = kv8[t]; } }
                unsigned prefix = 0u, mask = 0u, kk = (unsigned)cap;
                for (int pass = 0; pass < 4; ++pass) {
                    const int shift = 24 - 8 * pass;
                    if (tid < 256) hist[tid] = 0u;
                    __syncthreads();
                    for (int i = tid; i < n; i += NTHR) { const unsigned kv = keys[i]; if ((kv & mask) == prefix) __hip_atomic_fetch_add(&hist[(kv >> shift) & 255u], 1u, __ATOMIC_RELAXED, __HIP_MEMORY_SCOPE_WORKGROUP); }
                    __syncthreads();
                    if (wave == 0) {
                        const unsigned c0 = hist[4 * lane], c1 = hist[4 * lane + 1], c2 = hist[4 * lane + 2], c3 = hist[4 * lane + 3], tot = (c0 + c1) + (c2 + c3);
                        unsigned inc = tot;
#pragma unroll
                        for (int o = 1; o < 64; o <<= 1) { const unsigned t = __shfl_down(inc, o); if (lane + o < 64) inc += t; }
                        const unsigned excl = inc - tot;
                        if (excl < kk && excl + tot >= kk) { unsigned run = excl, dsel, knew;
                            if (run + c3 >= kk) { dsel = 4u * lane + 3u; knew = kk - run; }
                            else { run += c3; if (run + c2 >= kk) { dsel = 4u * lane + 2u; knew = kk - run; }
                                else { run += c2; if (run + c1 >= kk) { dsel = 4u * lane + 1u; knew = kk - run; } else { run += c1; dsel = 4u * lane; knew = kk - run; } } }
                            sel[0] = dsel; sel[1] = knew; } }
                    __syncthreads();
                    prefix |= sel[0] << shift; mask |= 0xFFu << shift; kk = sel[1];
                    __syncthreads();
                }
                const int chunk = (n >= NTHR) ? n / NTHR : 1, i0 = tid * chunk; const bool active = i0 < n;
                unsigned cg = 0u, ce = 0u;
                if (active) for (int i = 0; i < chunk; ++i) { const unsigned kv = keys[i0 + i]; cg += kv > prefix; ce += kv == prefix; }
                unsigned pk = cg | (ce << 16), incl = pk;
#pragma unroll
                for (int o = 1; o < 64; o <<= 1) { const unsigned t = __shfl_up(incl, o); if (lane >= o) incl += t; }
                if (lane == 63) wtot[wave] = incl;
                __syncthreads();
                unsigned wbase = 0u;
                for (int w = 0; w < wave; ++w) wbase += wtot[w];
                unsigned excl = wbase + incl - pk; unsigned ng = excl & 0xffffu, ne = excl >> 16;
                if (active) for (int i = 0; i < chunk; ++i) { const unsigned kv = keys[i0 + i]; const int row = row0 + i0 + i;
                    const bool isg = kv > prefix, ise = kv == prefix; const bool take = isg || (ise && ne < kk);
                    const unsigned slot = ng + (ne < kk ? ne : kk);
                    if (take) { RSRC[(size_t)e * ER + sbase + slot] = row; INV[(size_t)row * 16 + e] = sbase + (int)slot; } else INV[(size_t)row * 16 + e] = -1;
                    ng += isg; ne += ise; }
                __syncthreads();
            }
        }
        SEAM(pb + 4); }
        _Pragma("unroll 1") for (int rep = 0; rep < REPS(8); ++rep) {
        if (INL(6)) {
            PIN_WS();
            pg8::Gemm g{HA, WGU + (size_t)l * NE * 2 * FF * D, NE * ER, NE * 2 * FF, D}; pg8::GroupedOrder S; S.init(NE, lastl ? 16 : 17, 17, 0, 2 * FF / 256, 2 * FF / 256, G, bx);
            EpiGateUp E{HID};
            pg8::gemm_phase_gather<EpiGateUp, pg8::GroupedOrder, 17>(ldsl, g, S, E, RSRC, (LAS unsigned short*)(ldsl + pg8::STAGE_BYTES));
        }
        SEAM(pb + 6); }
        _Pragma("unroll 1") for (int rep = 0; rep < REPS(9); ++rep) {
        if (INL(7)) {
            PIN_WS();
            pg8::Gemm g{HID, WD + (size_t)l * NE * D * FF, NE * ER, NE * D, FF}; pg8::GroupedOrder S; S.init(NE, lastl ? 16 : 17, 17, 0, D / 256, D / 256, G, bx);
            EpiDown E{Y};
            pg8::gemm_phase<EpiDown, pg8::GroupedOrder>(ldsl, g, S, E);
            if (!lastl && G == 256 && bx >= 64) { PIN_IDS2(); convert_range(ptab, ws, ldsl, l + 1, 0, CV_P, (bx - 64) * NWAVES + wave, (G - 64) * NWAVES, wave, lane); }
        }
        SEAM(pb + 7); }
        _Pragma("unroll 1") for (int rep = 0; rep < REPS(10); ++rep) {
        if (INL(8)) {
            PIN_IDS();
            const float g2s = (rep == 0 || lastl) ? 1.0f : 0.0f;
            f32x4 mA[4], mSH[4], mG2[4]; int curm = -1;
#pragma unroll 1
            for (int wslot = gw; wslot < RT / 17; wslot += NGW) { const int wrow0 = wslot * 17;
#pragma unroll 1
            for (int it = 0; it < 9; ++it) {
                const int kL = (lane >> 4) & 1; const int idxL = it * 2 + kL; const int rowL = wrow0 + (idxL < 17 ? idxL : 16);
                int myinv = INV[(size_t)rowL * 16 + (lane & 15)]; const float myaff = AFF[(size_t)rowL * 16 + (lane & 15)];
                if (idxL >= 17 || (lastl && (rowL % RPB) < CTXL)) myinv = -1;
                f32x4 v[2][4];
#pragma unroll
                for (int k = 0; k < 2; ++k) { const int idx = it * 2 + k; const int row = wrow0 + (idx < 17 ? idx : 16); row_load_bf(XR + (size_t)row * D, lane, v[k]); }
                const unsigned long long sel = __ballot(myinv >= 0);
                u32x2 y0[2][4], y1[2][4]; float g0[2], g1[2]; unsigned rest[2];
#pragma unroll
                for (int k = 0; k < 2; ++k) {
                    unsigned mk = (unsigned)(sel >> (16 * k)) & 0xffffu; g0[k] = 0.f; g1[k] = 0.f;
#pragma unroll
                    for (int jj = 0; jj < 4; ++jj) { y0[k][jj] = (u32x2){0u, 0u}; y1[k][jj] = (u32x2){0u, 0u}; }
                    if (mk) { const int e = __builtin_ctz(mk); mk &= mk - 1; const int slot = __builtin_amdgcn_readlane(myinv, 16 * k + e); g0[k] = __builtin_bit_cast(float, __builtin_amdgcn_readlane(__builtin_bit_cast(int, myaff), 16 * k + e));
                        const u32x2* yp = (const u32x2*)(Y + ((size_t)e * ER + slot) * D) + lane;
#pragma unroll
                        for (int jj = 0; jj < 4; ++jj) y0[k][jj] = yp[64 * jj]; }
                    if (mk) { const int e = __builtin_ctz(mk); mk &= mk - 1; const int slot = __builtin_amdgcn_readlane(myinv, 16 * k + e); g1[k] = __builtin_bit_cast(float, __builtin_amdgcn_readlane(__builtin_bit_cast(int, myaff), 16 * k + e));
                        const u32x2* yp = (const u32x2*)(Y + ((size_t)e * ER + slot) * D) + lane;
#pragma unroll
                        for (int jj = 0; jj < 4; ++jj) y1[k][jj] = yp[64 * jj]; }
                    rest[k] = mk;
                }
#pragma unroll
                for (int k = 0; k < 2; ++k) {
                    const int idx = it * 2 + k; if (idx >= 17) continue; const int row = wrow0 + idx;
                    const int b = row / RPB, j = row % RPB; const bool isctx = j < CTXL;
                    if (lastl && isctx) continue;
                    const int mrow = isctx ? 8 : b;
                    if (mrow != curm) { curm = mrow; const float* m = modl + (size_t)mrow * 6144;
#pragma unroll
                        for (int jj = 0; jj < 4; ++jj) mG2[jj] = ((const f32x4*)(m + 5 * D))[lane + 64 * jj] * g2s;
                        if (!lastl) { const float* m2 = MOD + (size_t)(l + 1) * 9 * 6144 + (size_t)mrow * 6144; load_mod(INP(I_N1G) + (l + 1) * D, m2 + 0 * D, m2 + 1 * D, lane, mA, mSH); }
                        else {
#pragma unroll
                            for (int jj = 0; jj < 4; ++jj) mA[jj] = ((const f32x4*)INP(I_NFG))[lane + 64 * jj]; } }
                    f32x4 a[4];
#pragma unroll
                    for (int jj = 0; jj < 4; ++jj) {
                        a[jj].x = g0[k] * bf2f(y0[k][jj].x & 0xffffu) + g1[k] * bf2f(y1[k][jj].x & 0xffffu); a[jj].y = g0[k] * bf2f(y0[k][jj].x >> 16) + g1[k] * bf2f(y1[k][jj].x >> 16);
                        a[jj].z = g0[k] * bf2f(y0[k][jj].y & 0xffffu) + g1[k] * bf2f(y1[k][jj].y & 0xffffu); a[jj].w = g0[k] * bf2f(y0[k][jj].y >> 16) + g1[k] * bf2f(y1[k][jj].y >> 16); }
                    unsigned mk = rest[k];
#pragma unroll 1
                    while (mk) { const int e = __builtin_ctz(mk); mk &= mk - 1; const int slot = __builtin_amdgcn_readlane(myinv, 16 * k + e); const float ga = __builtin_bit_cast(float, __builtin_amdgcn_readlane(__builtin_bit_cast(int, myaff), 16 * k + e));
                        const u32x2* yp = (const u32x2*)(Y + ((size_t)e * ER + slot) * D) + lane;
#pragma unroll
                        for (int jj = 0; jj < 4; ++jj) { const u32x2 yy = yp[64 * jj];
                            a[jj].x += ga * bf2f(yy.x & 0xffffu); a[jj].y += ga * bf2f(yy.x >> 16); a[jj].z += ga * bf2f(yy.y & 0xffffu); a[jj].w += ga * bf2f(yy.y >> 16); } }
#pragma unroll
                    for (int jj = 0; jj < 4; ++jj) v[k][jj] = v[k][jj] + mG2[jj] * a[jj];
                    if (!lastl) {
                        row_store_bf(XR + (size_t)row * D, lane, v[k]);
                        norm_mod2(v[k], mA, mSH, HA + (size_t)row * D, lane);
                    } else {
                        const float rstd = row_rstd(v[k]);
                        float* orow = (float*)(GAS1 float*)lds_ptr(ptab, 23) + ((size_t)b * SEQ + (j - CTXL)) * D;
#pragma unroll
                        for (int jj = 0; jj < 4; ++jj) ((f32x4*)orow)[lane + 64 * jj] = (v[k][jj] * rstd) * mA[jj];
                    }
                }
            } }
        }
        if (!lastl) SEAM(pb + 8); }
    }

__global__ void __launch_bounds__(NTHR, 2) fwd(Args args) {
    extern __shared__ __attribute__((aligned(16))) unsigned char lds[];
    LAS unsigned char* ldsl = (LAS unsigned char*)lds;
    const int tid0 = threadIdx.x;
    const int G = gridDim.x, bx = blockIdx.x, NGW = G * NWAVES;
    LAS unsigned long long* ptab = (LAS unsigned long long*)(ldsl + LDS_MISC + 32);
    if (tid0 < 8) ((LAS unsigned*)(ldsl + LDS_MISC))[tid0] = 0u;
    if (tid0 < 25) ptab[tid0] = (tid0 < 23) ? (unsigned long long)args.in[tid0] : (tid0 == 23) ? (unsigned long long)args.out : (unsigned long long)args.ws;
    __syncthreads();
    XcdBarrier bar = xcd_barrier_post((unsigned*)(args.ws + WS_CTL), (volatile LAS unsigned*)(ldsl + LDS_MISC));
    const int lo = args.ph_lo, hi = args.ph_hi;

    _Pragma("unroll 1") for (int rep = 0; rep < REPS(0); ++rep) {
    if (IN(0)) {
            PIN_IDS();
        {
            LAS float* svec = (LAS float*)ldsl;
            LAS float* part = (LAS float*)(ldsl + 9 * 1024 * 4);
            bool have = false;
            for (int u = bx; u < DEPTH * 48; u += G) {
                if (!have) {
                    for (int i = tid; i < 9 * 1024; i += NTHR) { const int r = i >> 10, k = i & 1023; const float x = (r < 8) ? INP(I_C)[r * 1024 + k] : INP(I_CCTX)[k]; svec[i] = x / (1.0f + __expf(-x)); }
                    have = true; __syncthreads();
                }
                const int l = u / 48, j0 = (u % 48) * 128, c4 = tid & 31, kg = tid >> 5;
                const float* w = INP(I_WADA) + (size_t)l * 1024 * 6144 + j0 + 4 * c4;
                f32x4 a[9];
#pragma unroll
                for (int r = 0; r < 9; ++r) a[r] = (f32x4){0.f, 0.f, 0.f, 0.f};
#pragma unroll 2
                for (int k = kg * 64; k < kg * 64 + 64; k += 4) {
                    f32x4 wv[4];
#pragma unroll
                    for (int i = 0; i < 4; ++i) wv[i] = *(const f32x4*)(w + (size_t)(k + i) * 6144);
#pragma unroll
                    for (int r = 0; r < 9; ++r) { const f32x4 sv = *(const LAS f32x4*)(svec + r * 1024 + k);
                        a[r] = a[r] + wv[0] * sv.x + wv[1] * sv.y + wv[2] * sv.z + wv[3] * sv.w; } }
#pragma unroll
                for (int r = 0; r < 9; ++r) *(LAS f32x4*)(part + (kg * 9 + r) * 128 + 4 * c4) = a[r];
                __syncthreads();
                for (int i = tid; i < 9 * 128; i += NTHR) { const int r = i >> 7, c2 = i & 127; float sum = INP(I_BADA)[l * 6144 + j0 + c2];
#pragma unroll
                    for (int g = 0; g < 16; ++g) sum += part[(g * 9 + r) * 128 + c2];
                    MOD[((size_t)l * 9 + r) * 6144 + j0 + c2] = sum; }
                __syncthreads();
            }
            __syncthreads();
        }
        if (bx == G - 1) {
            for (int i = tid; i < 64 * 16; i += NTHR) { const int pos = i >> 4, f = i & 15; double s, c; sincos_d((double)pos * kFreq[f], s, c); ROPEC[i] = (float)c; ROPES[i] = (float)s; }
            if (wave < DEPTH) { const int l = wave;
                const float d1 = wave_sum(INP(I_LQ1)[l * 64 + lane] * INP(I_LK1)[l * 64 + lane]), d2 = wave_sum(INP(I_LQ2)[l * 64 + lane] * INP(I_LK2)[l * 64 + lane]);
                if (lane == 0) LAMV[l] = expf(d1) - expf(d2) + kLamInit[l]; }
        }
        for (int i = bx * NTHR + tid; i < DEPTH * 8 * 128 * 128 / 4; i += G * NTHR) { const f32x4 v = ((const f32x4*)INP(I_SGUW))[i]; u32x2 w; w.x = pk2(v.x, v.y); w.y = pk2(v.z, v.w); ((u32x2*)SGUW)[i] = w; }
        convert_range(ptab, ws, ldsl, 0, 0, G == 256 ? CV_P : IT_L, gw, NGW, wave, lane);
        if (G != 256) {
#pragma unroll 1
            for (int l2 = 1; l2 < DEPTH; ++l2) convert_range(ptab, ws, ldsl, l2, 0, IT_L, gw, NGW, wave, lane); }
    }
    SEAM(0); }
    if (IN(1)) {
            PIN_IDS();
        f32x4 mA[4], mSH[4]; int curm = -1;
#pragma unroll 1
        for (int wslot = gw; wslot < RT / 17; wslot += NGW) { const int wrow0 = wslot * 17;
#pragma unroll 1
        for (int it = 0; it < 5; ++it) {
            f32x4 v[4][4];
#pragma unroll
            for (int k = 0; k < 4; ++k) { const int idx = it * 4 + k; const int row = wrow0 + (idx < 17 ? idx : 16); const int b = row / RPB, j = row % RPB;
                const float* src = (j < CTXL) ? INP(I_CTX) + ((size_t)b * CTXL + j) * D : INP(I_X) + ((size_t)b * SEQ + (j - CTXL)) * D; row_load(src, lane, v[k]); }
#pragma unroll
            for (int k = 0; k < 4; ++k) { const int idx = it * 4 + k; if (idx >= 17) continue; const int row = wrow0 + idx; const int b = row / RPB, j = row % RPB;
                row_store_bf(XR + (size_t)row * D, lane, v[k]);
                const int mrow = (j < CTXL) ? 8 : b;
                if (mrow != curm) { curm = mrow; const float* m = MOD + (size_t)mrow * 6144; load_mod(INP(I_N1G), m + 0 * D, m + 1 * D, lane, mA, mSH); }
                norm_mod2(v[k], mA, mSH, HA + (size_t)row * D, lane); }
        } }
    }
    SEAM(1);

    layer_body<0>(lds, ldsl, ptab, bar, lo, hi, G, bx, NGW);
    layer_body<1>(lds, ldsl, ptab, bar, lo, hi, G, bx, NGW);
    layer_body<2>(lds, ldsl, ptab, bar, lo, hi, G, bx, NGW);
    layer_body<3>(lds, ldsl, ptab, bar, lo, hi, G, bx, NGW);
}

#ifndef MK_LAUNCHES_PER_PHASE
#define MK_LAUNCHES_PER_PHASE 0
#endif
extern "C" void kernel_launch(void* const* d_in, const int* in_sizes, int n_in, void* d_out, int out_size, void* d_ws, size_t ws_size, hipStream_t stream) {
    static int grid = 0;
    if (grid == 0) {
        if (n_in != 23 || out_size != NB * SEQ * D || ws_size < WS_END) { fprintf(stderr, "kernel_launch: unexpected shapes: n_in %d out %d ws %zu (need %zu)\n", n_in, out_size, ws_size, (size_t)WS_END); grid = -1; return; }
        int dev = 0, cus = 0, per_cu = 0;
        if (hipGetDevice(&dev) != hipSuccess || hipDeviceGetAttribute(&cus, hipDeviceAttributeMultiprocessorCount, dev) != hipSuccess) { grid = -1; return; }
        if (hipFuncSetAttribute((const void*)fwd, hipFuncAttributeMaxDynamicSharedMemorySize, LDS_BYTES) != hipSuccess) { fprintf(stderr, "kernel_launch: hipFuncSetAttribute failed\n"); grid = -1; return; }
        if (hipOccupancyMaxActiveBlocksPerMultiprocessor(&per_cu, (const void*)fwd, NTHR, LDS_BYTES) != hipSuccess || per_cu < 1) { fprintf(stderr, "kernel_launch: occupancy query says %d blocks per CU\n", per_cu); }
        (void)hipGetLastError();
        grid = cus;
        if (grid > 256) grid = 256;
    }
    if (grid < 0) return;
    (void)hipMemsetAsync((char*)d_ws + WS_CTL, 0, CTL_BYTES, stream);
    Args a{};
    for (int i = 0; i < 23; ++i) a.in[i] = (const float*)d_in[i];
    a.out = (float*)d_out; a.ws = (unsigned char*)d_ws;
    constexpr int NPH = 2 + 9 * DEPTH;
#if MK_LAUNCHES_PER_PHASE
    for (int p = 0; p < NPH; ++p) { a.ph_lo = p; a.ph_hi = p + 1; hipLaunchKernelGGL(fwd, dim3(grid), dim3(NTHR), LDS_BYTES, stream, a); }
#else
    a.ph_lo = 0; a.ph_hi = NPH;
    hipLaunchKernelGGL(fwd, dim3(grid), dim3(NTHR), LDS_BYTES, stream, a);
#endif
    const hipError_t le = hipPeekAtLastError();
    if (le != hipSuccess) fprintf(stderr, "kernel_launch: launch failed: %s\n", hipGetErrorName(le));
}
```

```cpp
#include <hip/hip_runtime.h>
#include <cstdio>
#include <cstdint>
namespace pg8 {
#define PG8_LAS __attribute__((address_space(3)))
typedef unsigned short bf16_t;
typedef short bf16x8 __attribute__((ext_vector_type(8)));
typedef float f32x4 __attribute__((ext_vector_type(4)));
typedef float f32x2 __attribute__((ext_vector_type(2)));
typedef unsigned u32x4 __attribute__((ext_vector_type(4)));
typedef unsigned u32x2 __attribute__((ext_vector_type(2)));
constexpr int BM = 256, BK = 64, HALF = 128, HTB = HALF * BK * 2  , STAGE_BYTES = 8 * HTB, NXCD = 8, WGM = 8;

__host__ __device__ __forceinline__ int lds_byte(int r, int c) { const int st = (r >> 4) * 2 + (c >> 5), rr = r & 15, cc = c & 31, ob = rr * 64 + cc * 2; return st * 1024 + (ob ^ (((ob >> 9) & 1) << 5)); }
__host__ __device__ __forceinline__ void stage_rc(int b, int& R, int& C) { const int st = b / 1024, sb = b % 1024, swz = sb ^ (((sb >> 9) & 1) << 5); R = (st >> 1) * 16 + swz / 64; C = (st & 1) * 32 + (swz % 64) / 2; }
__host__ __device__ __forceinline__ int perm32(int rho) { const int n = rho >> 4, i = rho & 15; return 8 * (i >> 2) + 4 * n + (i & 3); }

struct Unit { int pm, pn; };
struct Gemm { const bf16_t* A; const bf16_t* Bt; int M, N, K; };

struct StaticOrder {
    int nM, nN, nwg, G, c;
    __host__ __device__ void init(int M, int N, int G_, int c_) { nM = M / BM; nN = N / BM; nwg = nM * nN; G = G_; c = c_; }
    __host__ __device__ bool next(int i, Unit& u) const {
        const long L = (long)i * G + c; if (L >= nwg) return false;
        int wgid = (int)L; { const int q = nwg / NXCD, r = nwg % NXCD, xcd = wgid % NXCD, off = wgid / NXCD; wgid = (xcd < r ? xcd * (q + 1) : r * (q + 1) + (xcd - r) * q) + off; }
        const int nig = WGM * nN, gid = wgid / nig, fm = gid * WGM, gsz = (nM - fm) < WGM ? (nM - fm) : WGM;
        u.pm = fm + ((wgid % nig) % gsz); u.pn = (wgid % nig) / gsz; return true;
    }
    __device__ __forceinline__ void a_ready(const Unit&) const {}
    __device__ __forceinline__ void done(const Unit&) const {}
};
struct GroupedOrder {
    int TM, TN, TMS, MOFF, BGS, nunits, G, c;
    __host__ __device__ void init(int NG, int TM_, int TMS_, int MOFF_, int TN_, int BGS_, int G_, int c_) { TM = TM_; TN = TN_; TMS = TMS_; MOFF = MOFF_; BGS = BGS_; nunits = NG * TM_ * TN_; G = G_; c = c_; }
    __host__ __device__ bool next(int i, Unit& u) const {
        const long L = (long)i * G + c; if (L >= nunits) return false;
        int wgid = (int)L; { const int q = nunits / NXCD, r = nunits % NXCD, xcd = wgid % NXCD, off = wgid / NXCD; wgid = (xcd < r ? xcd * (q + 1) : r * (q + 1) + (xcd - r) * q) + off; }
        const int per = TM * TN, e = wgid / per, w = wgid % per;
        const int nig = WGM * TN, gid = w / nig, fm = gid * WGM, gsz = (TM - fm) < WGM ? (TM - fm) : WGM;
        u.pm = e * TMS + MOFF + fm + ((w % nig) % gsz); u.pn = e * BGS + (w % nig) / gsz; return true;
    }
    __device__ __forceinline__ void a_ready(const Unit&) const {}
    __device__ __forceinline__ void done(const Unit&) const {}
};

__device__ __forceinline__ unsigned cvt_pk_bf16(float lo, float hi) { unsigned r; asm volatile("v_cvt_pk_bf16_f32 %0, %1, %2" : "=v"(r) : "v"(lo), "v"(hi)); return r; }
__device__ __forceinline__ f32x2 gelu_pk(f32x2 v) {
    f32x2 d; d.x = __builtin_fmaf(__builtin_fabsf(v.x), 0.2316418882f, 1.0f); d.y = __builtin_fmaf(__builtin_fabsf(v.y), 0.2316418882f, 1.0f);
    f32x2 t; t.x = __builtin_amdgcn_rcpf(d.x); t.y = __builtin_amdgcn_rcpf(d.y);
    f32x2 q = t * 0.5307027145f + (-0.7265760135f); q = q * t + 0.7107068705f; q = q * t + (-0.142248368f); q = q * t + 0.127414796f; q = q * t;
    const f32x2 s = (v * v) * (-0.72134752044f);
    f32x2 e; e.x = __builtin_amdgcn_exp2f(s.x); e.y = __builtin_amdgcn_exp2f(s.y);
    const f32x2 c = q * e;
    float rx, ry; asm("v_max_f32 %0, 0, %1" : "=v"(rx) : "v"(v.x)); asm("v_max_f32 %0, 0, %1" : "=v"(ry) : "v"(v.y));
    f32x2 o; o.x = __builtin_fmaf(-__builtin_fabsf(v.x), c.x, rx); o.y = __builtin_fmaf(-__builtin_fabsf(v.y), c.y, ry); return o;
}
__device__ __forceinline__ f32x4 gelu4(f32x4 v) { const f32x2 a = gelu_pk((f32x2){v[0], v[1]}), b = gelu_pk((f32x2){v[2], v[3]}); return (f32x4){a.x, a.y, b.x, b.y}; }

template <class Epi, class Sched, bool ALIGN_EPI = true, bool SP2 = true>
__device__ __forceinline__ void gemm_phase(PG8_LAS unsigned char* lds, const Gemm g, const Sched& S, const Epi& E) {
    int tid = threadIdx.x; asm volatile("" : "+v"(tid));
    const int wid = __builtin_amdgcn_readfirstlane(tid >> 6), lane = tid & 63, wr = wid >> 2, wc = wid & 3, fr = lane & 15, fq = lane >> 4;
    const int K = g.K, nt = K / BK;
    unsigned voffA[2], voffB[2];
#pragma unroll
    for (int i = 0; i < 2; ++i) { int R, C; stage_rc(tid * 16 + i * 8192, R, C); const int Rb = Epi::PERM ? ((R & ~31) + perm32(R & 31)) : R;
        voffA[i] = (unsigned)(R * K + C) * 2u; voffB[i] = (unsigned)(Rb * K + C) * 2u; }
    const size_t kstep = (size_t)(BK * 2);
    const size_t hstep = (size_t)HALF * K * 2;
    const size_t tstep = 2 * hstep;
    const unsigned ldsw = (unsigned)wid * 1024u;
    const int aoff = lds_byte(wr * 64 + fr, fq * 8), boff = lds_byte(wc * 32 + fr, fq * 8);
#define PG8_SA(b, h) (((b) * 2 + (h)) * HTB)
#define PG8_SB(b, h) ((4 + (b) * 2 + (h)) * HTB)
#define PG8_STAGE(bufoff, gbase, voff) do { _Pragma("unroll") for (int _i = 0; _i < 2; ++_i) \
        __builtin_amdgcn_global_load_lds((const unsigned*)((const char*)(gbase) + (voff)[_i]), (PG8_LAS unsigned*)(lds + (bufoff) + ldsw + _i * 8192), 16, 0, 0); } while (0)
#define PG8_LDA(dst, b, h) do { _Pragma("unroll") for (int m = 0; m < 4; ++m) _Pragma("unroll") for (int k = 0; k < 2; ++k) dst[m][k] = *(const PG8_LAS bf16x8*)(lds + PG8_SA(b, h) + aoff + m * 2048 + k * 1024); } while (0)
#define PG8_LDB(dst, b, h) do { _Pragma("unroll") for (int n = 0; n < 2; ++n) _Pragma("unroll") for (int k = 0; k < 2; ++k) dst[n][k] = *(const PG8_LAS bf16x8*)(lds + PG8_SB(b, h) + boff + n * 2048 + k * 1024); } while (0)
#define PG8_MMA(ai, bj, At, Bt) do { __builtin_amdgcn_s_setprio(1); _Pragma("unroll") for (int m = 0; m < 4; ++m) _Pragma("unroll") for (int n = 0; n < 2; ++n) _Pragma("unroll") for (int k = 0; k < 2; ++k) \
        acc[ai][bj][m][n] = __builtin_amdgcn_mfma_f32_16x16x32_bf16(Bt[n][k], At[m][k], acc[ai][bj][m][n], 0, 0, 0); __builtin_amdgcn_s_setprio(0); } while (0)
#define PG8_WAIT_V(n) asm volatile("s_waitcnt vmcnt(" #n ")" ::: "memory")
#define PG8_WAIT_L(n) asm volatile("s_waitcnt lgkmcnt(" #n ")" ::: "memory")
#define PG8_BAR __builtin_amdgcn_s_barrier()
#define PG8_SCHED __builtin_amdgcn_sched_barrier(0)
    Unit cur, nxt; int ui = 0;
    if (!S.next(0, cur)) return;
    f32x4 acc[2][2][4][2];
#pragma unroll
    for (int a = 0; a < 2; ++a)
#pragma unroll
        for (int b = 0; b < 2; ++b)
#pragma unroll
            for (int m = 0; m < 4; ++m)
#pragma unroll
                for (int n = 0; n < 2; ++n) acc[a][b][m][n] = (f32x4){0.f, 0.f, 0.f, 0.f};
    bf16x8 At[4][2], B0[2][2], B1[2][2];
    const char* cA = (const char*)g.A + (size_t)cur.pm * tstep; const char* cB = (const char*)g.Bt + (size_t)cur.pn * tstep;
    S.a_ready(cur);
    if constexpr (SP2) {
        PG8_STAGE(PG8_SB(0, 0), cB, voffB); PG8_STAGE(PG8_SB(0, 1), cB + hstep, voffB); PG8_STAGE(PG8_SA(0, 0), cA, voffA); PG8_STAGE(PG8_SA(0, 1), cA + hstep, voffA);
        if (wr == 1) PG8_BAR;
        PG8_WAIT_V(2); PG8_BAR;
        PG8_STAGE(PG8_SB(1, 0), cB + kstep, voffB); PG8_STAGE(PG8_SA(1, 0), cA + kstep, voffA); PG8_STAGE(PG8_SB(1, 1), cB + hstep + kstep, voffB);
        PG8_WAIT_V(6); PG8_BAR;
    } else {
        PG8_STAGE(PG8_SB(0, 0), cB, voffB); PG8_STAGE(PG8_SA(0, 0), cA, voffA); PG8_STAGE(PG8_SB(0, 1), cB + hstep, voffB); PG8_STAGE(PG8_SA(0, 1), cA + hstep, voffA);
        if (wr == 1) PG8_BAR;
        PG8_WAIT_V(4); PG8_BAR;
        PG8_STAGE(PG8_SB(1, 0), cB + kstep, voffB); PG8_STAGE(PG8_SA(1, 0), cA + kstep, voffA); PG8_STAGE(PG8_SB(1, 1), cB + hstep + kstep, voffB);
        PG8_WAIT_V(6); PG8_BAR;
    }
    for (;;) {
        const bool has_next = S.next(ui + 1, nxt);
        const char* nA = has_next ? (const char*)g.A + (size_t)nxt.pm * tstep : cA; const char* nB = has_next ? (const char*)g.Bt + (size_t)nxt.pn * tstep : cB;
        for (int t = 0; t < nt; t += 2) {
            const bool last = (t == nt - 2);
            const char* a1 = cA + (size_t)(t + 1) * kstep;
            const char* a2 = last ? nA : cA + (size_t)(t + 2) * kstep; const char* b2 = last ? nB : cB + (size_t)(t + 2) * kstep;
            const char* a3 = a2 + kstep; const char* b3 = b2 + kstep;
            if (last && has_next) S.a_ready(nxt);
            if constexpr (SP2) {
            PG8_LDB(B0, 0, 0); PG8_LDB(B1, 0, 1); PG8_SCHED; PG8_LDA(At, 0, 0); PG8_STAGE(PG8_SA(1, 1), a1 + hstep, voffA);
            PG8_WAIT_V(8); PG8_WAIT_L(0); PG8_BAR; PG8_MMA(0, 0, At, B0); PG8_MMA(0, 1, At, B1); PG8_BAR; PG8_SCHED;
            PG8_LDA(At, 0, 1); PG8_STAGE(PG8_SB(0, 0), b2, voffB); PG8_STAGE(PG8_SB(0, 1), b2 + hstep, voffB); PG8_STAGE(PG8_SA(0, 0), a2, voffA);
            PG8_WAIT_V(8); PG8_WAIT_L(0); PG8_BAR; PG8_MMA(1, 0, At, B0); PG8_MMA(1, 1, At, B1); PG8_BAR; PG8_SCHED;
            PG8_LDB(B0, 1, 0); PG8_LDB(B1, 1, 1); PG8_SCHED; PG8_LDA(At, 1, 0); PG8_STAGE(PG8_SA(0, 1), a2 + hstep, voffA);
            PG8_WAIT_V(8); PG8_WAIT_L(0); PG8_BAR; PG8_MMA(0, 0, At, B0); PG8_MMA(0, 1, At, B1); PG8_BAR; PG8_SCHED;
            PG8_LDA(At, 1, 1); PG8_STAGE(PG8_SB(1, 0), b3, voffB); PG8_STAGE(PG8_SB(1, 1), b3 + hstep, voffB); PG8_STAGE(PG8_SA(1, 0), a3, voffA);
            PG8_WAIT_V(8); PG8_WAIT_L(0); PG8_BAR; PG8_MMA(1, 0, At, B0); PG8_MMA(1, 1, At, B1); PG8_BAR; PG8_SCHED;
            } else {
            PG8_LDB(B0, 0, 0); PG8_SCHED; PG8_LDA(At, 0, 0); PG8_STAGE(PG8_SA(1, 1), a1 + hstep, voffA);
            PG8_WAIT_L(8); PG8_BAR; PG8_WAIT_L(0); PG8_MMA(0, 0, At, B0); PG8_BAR; PG8_SCHED;
            PG8_LDB(B1, 0, 1); PG8_STAGE(PG8_SB(0, 0), b2, voffB);
            PG8_BAR; PG8_WAIT_L(0); PG8_MMA(0, 1, At, B1); PG8_BAR;
            PG8_LDA(At, 0, 1); PG8_STAGE(PG8_SA(0, 0), a2, voffA);
            PG8_BAR; PG8_WAIT_L(0); PG8_MMA(1, 0, At, B0); PG8_BAR; PG8_SCHED;
            PG8_STAGE(PG8_SB(0, 1), b2 + hstep, voffB);
            PG8_WAIT_V(6); PG8_BAR; PG8_MMA(1, 1, At, B1); PG8_BAR;
            PG8_LDB(B0, 1, 0); PG8_SCHED; PG8_LDA(At, 1, 0); PG8_STAGE(PG8_SA(0, 1), a2 + hstep, voffA);
            PG8_WAIT_L(8); PG8_BAR; PG8_WAIT_L(0); PG8_MMA(0, 0, At, B0); PG8_BAR; PG8_SCHED;
            PG8_LDB(B1, 1, 1); PG8_STAGE(PG8_SB(1, 0), b3, voffB);
            PG8_BAR; PG8_WAIT_L(0); PG8_MMA(0, 1, At, B1); PG8_BAR;
            PG8_LDA(At, 1, 1); PG8_STAGE(PG8_SA(1, 0), a3, voffA);
            PG8_BAR; PG8_WAIT_L(0); PG8_MMA(1, 0, At, B0); PG8_BAR; PG8_SCHED;
            PG8_STAGE(PG8_SB(1, 1), b3 + hstep, voffB);
            PG8_WAIT_V(6); PG8_BAR; PG8_MMA(1, 1, At, B1); PG8_BAR;
                    }
        }
        if constexpr (ALIGN_EPI) { if (wr == 0) PG8_BAR; }
        E(acc, cur, wr, wc, fr, fq); S.done(cur);
#ifdef INPROJ_EPI2
        if constexpr (Epi::TWICE) { asm volatile("" ::: "memory"); E(acc, cur, wr, wc, fr, fq); }
#endif
        if (!has_next) break;
#pragma unroll
        for (int a = 0; a < 2; ++a)
#pragma unroll
            for (int b = 0; b < 2; ++b)
#pragma unroll
                for (int m = 0; m < 4; ++m)
#pragma unroll
                    for (int n = 0; n < 2; ++n) acc[a][b][m][n] = (f32x4){0.f, 0.f, 0.f, 0.f};
        cur = nxt; cA = nA; cB = nB; ++ui;
        if constexpr (ALIGN_EPI) { if (wr == 1) PG8_BAR; }
    }
    PG8_WAIT_V(0);
    if constexpr (!ALIGN_EPI) { if (wr == 0) PG8_BAR; }
    PG8_BAR;
#undef PG8_SA
#undef PG8_SB
#undef PG8_STAGE
#undef PG8_LDA
#undef PG8_LDB
#undef PG8_MMA
#undef PG8_WAIT_V
#undef PG8_WAIT_L
#undef PG8_BAR
#undef PG8_SCHED
}

template <class Epi, class Sched, int MAXU>
__device__ __forceinline__ void gemm_phase_gather(PG8_LAS unsigned char* lds, const Gemm g, const Sched& S, const Epi& E, const int* __restrict__ rowsrc, PG8_LAS unsigned short* gtab) {
    int tid = threadIdx.x; asm volatile("" : "+v"(tid));
    const int wid = __builtin_amdgcn_readfirstlane(tid >> 6), lane = tid & 63, wr = wid >> 2, wc = wid & 3, fr = lane & 15, fq = lane >> 4;
    const int K = g.K, nt = K / BK;
    Unit cur, nxt; int ui = 0;
    if (!S.next(0, cur)) return;
    { int idx[MAXU];
#pragma unroll
      for (int i = 0; i < MAXU; ++i) { Unit u; const bool have = S.next(i, u); idx[i] = (have && tid < 256) ? rowsrc[u.pm * 256 + tid] : 0; }
#pragma unroll
      for (int i = 0; i < MAXU; ++i) { if (tid < 256) gtab[i * 256 + tid] = (unsigned short)idx[i]; }
      asm volatile("s_waitcnt vmcnt(0) lgkmcnt(0)" ::: "memory"); __builtin_amdgcn_s_barrier(); asm volatile("" ::: "memory"); }
    unsigned voffB[2]; int RA[2], CA[2];
#pragma unroll
    for (int i = 0; i < 2; ++i) { int R, C; stage_rc(tid * 16 + i * 8192, R, C); const int Rb = Epi::PERM ? ((R & ~31) + perm32(R & 31)) : R;
        RA[i] = R; CA[i] = C * 2; voffB[i] = (unsigned)(Rb * K + C) * 2u; }
    const size_t kstep = (size_t)(BK * 2);
    const size_t hstep = (size_t)HALF * K * 2;
    const size_t tstep = 2 * hstep;
    const unsigned ldsw = (unsigned)wid * 1024u;
    const int aoff = lds_byte(wr * 64 + fr, fq * 8), boff = lds_byte(wc * 32 + fr, fq * 8);
    const unsigned rowb = (unsigned)K * 2u;
#define PG8_SA(b, h) (((b) * 2 + (h)) * HTB)
#define PG8_SB(b, h) ((4 + (b) * 2 + (h)) * HTB)
#define PG8_STAGE(bufoff, gbase, voff) do { _Pragma("unroll") for (int _i = 0; _i < 2; ++_i) \
        __builtin_amdgcn_global_load_lds((const unsigned*)((const char*)(gbase) + (voff)[_i]), (PG8_LAS unsigned*)(lds + (bufoff) + ldsw + _i * 8192), 16, 0, 0); } while (0)
#define PG8_LDA(dst, b, h) do { _Pragma("unroll") for (int m = 0; m < 4; ++m) _Pragma("unroll") for (int k = 0; k < 2; ++k) dst[m][k] = *(const PG8_LAS bf16x8*)(lds + PG8_SA(b, h) + aoff + m * 2048 + k * 1024); } while (0)
#define PG8_LDB(dst, b, h) do { _Pragma("unroll") for (int n = 0; n < 2; ++n) _Pragma("unroll") for (int k = 0; k < 2; ++k) dst[n][k] = *(const PG8_LAS bf16x8*)(lds + PG8_SB(b, h) + boff + n * 2048 + k * 1024); } while (0)
#define PG8_MMA(ai, bj, At, Bt) do { __builtin_amdgcn_s_setprio(1); _Pragma("unroll") for (int m = 0; m < 4; ++m) _Pragma("unroll") for (int n = 0; n < 2; ++n) _Pragma("unroll") for (int k = 0; k < 2; ++k) \
        acc[ai][bj][m][n] = __builtin_amdgcn_mfma_f32_16x16x32_bf16(Bt[n][k], At[m][k], acc[ai][bj][m][n], 0, 0, 0); __builtin_amdgcn_s_setprio(0); } while (0)
#define PG8_WAIT_V(n) asm volatile("s_waitcnt vmcnt(" #n ")" ::: "memory")
#define PG8_WAIT_L(n) asm volatile("s_waitcnt lgkmcnt(" #n ")" ::: "memory")
#define PG8_BAR __builtin_amdgcn_s_barrier()
#define PG8_SCHED __builtin_amdgcn_sched_barrier(0)
#define PG8_GOFF(dst, ORD) do { _Pragma("unroll") for (int _h = 0; _h < 2; ++_h) _Pragma("unroll") for (int _i = 0; _i < 2; ++_i) \
        dst[_h][_i] = (unsigned)gtab[(ORD) * 256 + _h * HALF + RA[_i]] * rowb + (unsigned)CA[_i]; } while (0)
    f32x4 acc[2][2][4][2];
#pragma unroll
    for (int a = 0; a < 2; ++a)
#pragma unroll
        for (int b = 0; b < 2; ++b)
#pragma unroll
            for (int m = 0; m < 4; ++m)
#pragma unroll
                for (int n = 0; n < 2; ++n) acc[a][b][m][n] = (f32x4){0.f, 0.f, 0.f, 0.f};
    bf16x8 At[4][2], B0[2][2], B1[2][2];
    unsigned vAc[2][2], vAn[2][2];
    PG8_GOFF(vAc, 0);
#pragma unroll
    for (int h = 0; h < 2; ++h)
#pragma unroll
        for (int i = 0; i < 2; ++i) vAn[h][i] = vAc[h][i];
    const char* gA = (const char*)g.A;
    const char* cB = (const char*)g.Bt + (size_t)cur.pn * tstep;
    PG8_STAGE(PG8_SB(0, 0), cB, voffB); PG8_STAGE(PG8_SB(0, 1), cB + hstep, voffB); PG8_STAGE(PG8_SA(0, 0), gA, vAc[0]); PG8_STAGE(PG8_SA(0, 1), gA, vAc[1]);
    if (wr == 1) PG8_BAR;
    PG8_WAIT_V(2); PG8_BAR;
    PG8_STAGE(PG8_SB(1, 0), cB + kstep, voffB); PG8_STAGE(PG8_SA(1, 0), gA + kstep, vAc[0]); PG8_STAGE(PG8_SB(1, 1), cB + hstep + kstep, voffB);
    PG8_WAIT_V(6); PG8_BAR;
    for (;;) {
        const bool has_next = S.next(ui + 1, nxt);
        const char* nB = has_next ? (const char*)g.Bt + (size_t)nxt.pn * tstep : cB;
        for (int t = 0; t < nt; t += 2) {
            const bool last = (t == nt - 2);
            if (last) { if (has_next) { PG8_GOFF(vAn, ui + 1); } }
            const char* ka1 = gA + (size_t)(t + 1) * kstep;
            const char* ka2 = last ? gA : gA + (size_t)(t + 2) * kstep; const char* b2 = last ? nB : cB + (size_t)(t + 2) * kstep;
            const char* ka3 = ka2 + kstep; const char* b3 = b2 + kstep;
            unsigned x2[2][2];
#pragma unroll
            for (int h = 0; h < 2; ++h)
#pragma unroll
                for (int i = 0; i < 2; ++i) x2[h][i] = last ? vAn[h][i] : vAc[h][i];
            PG8_LDB(B0, 0, 0); PG8_LDB(B1, 0, 1); PG8_SCHED; PG8_LDA(At, 0, 0); PG8_STAGE(PG8_SA(1, 1), ka1, vAc[1]);
            PG8_WAIT_V(8); PG8_WAIT_L(0); PG8_BAR; PG8_MMA(0, 0, At, B0); PG8_MMA(0, 1, At, B1); PG8_BAR; PG8_SCHED;
            PG8_LDA(At, 0, 1); PG8_STAGE(PG8_SB(0, 0), b2, voffB); PG8_STAGE(PG8_SB(0, 1), b2 + hstep, voffB); PG8_STAGE(PG8_SA(0, 0), ka2, x2[0]);
            PG8_WAIT_V(8); PG8_WAIT_L(0); PG8_BAR; PG8_MMA(1, 0, At, B0); PG8_MMA(1, 1, At, B1); PG8_BAR; PG8_SCHED;
            PG8_LDB(B0, 1, 0); PG8_LDB(B1, 1, 1); PG8_SCHED; PG8_LDA(At, 1, 0); PG8_STAGE(PG8_SA(0, 1), ka2, x2[1]);
            PG8_WAIT_V(8); PG8_WAIT_L(0); PG8_BAR; PG8_MMA(0, 0, At, B0); PG8_MMA(0, 1, At, B1); PG8_BAR; PG8_SCHED;
            PG8_LDA(At, 1, 1); PG8_STAGE(PG8_SB(1, 0), b3, voffB); PG8_STAGE(PG8_SB(1, 1), b3 + hstep, voffB); PG8_STAGE(PG8_SA(1, 0), ka3, x2[0]);
            PG8_WAIT_V(8); PG8_WAIT_L(0); PG8_BAR; PG8_MMA(1, 0, At, B0); PG8_MMA(1, 1, At, B1); PG8_BAR; PG8_SCHED;
        }
        if (wr == 0) PG8_BAR;
        E(acc, cur, wr, wc, fr, fq); S.done(cur);
        if (!has_next) break;
#pragma unroll
        for (int a = 0; a < 2; ++a)
#pragma unroll
            for (int b = 0; b < 2; ++b)
#pragma unroll
                for (int m = 0; m < 4; ++m)
#pragma unroll
                    for (int n = 0; n < 2; ++n) acc[a][b][m][n] = (f32x4){0.f, 0.f, 0.f, 0.f};
        cur = nxt; cB = nB; ++ui;
#pragma unroll
        for (int h = 0; h < 2; ++h)
#pragma unroll
            for (int i = 0; i < 2; ++i) vAc[h][i] = vAn[h][i];
        if (wr == 1) PG8_BAR;
    }
    PG8_WAIT_V(0);
    PG8_BAR;
#undef PG8_GOFF
#undef PG8_SA
#undef PG8_SB
#undef PG8_STAGE
#undef PG8_LDA
#undef PG8_LDB
#undef PG8_MMA
#undef PG8_WAIT_V
#undef PG8_WAIT_L
#undef PG8_BAR
#undef PG8_SCHED
}
}
#define XB_TMO      128
#define XB_XCNT(j)  (256  + 64 * (j))
#define XB_XSUB(j)  (1280 + 64 * (j))
#define XB_XGEN(j)  (2304 + 64 * (j))
#define XB_TOP      3328
#define XB_TOPGEN   3392
#define XCD_BAR_WORDS 3456
#define XB_SPIN_CAP (1u << 22)
#define LAS __attribute__((address_space(3)))

__device__ __forceinline__ unsigned xb_ld(unsigned* p)              { return __hip_atomic_load(p, __ATOMIC_RELAXED, __HIP_MEMORY_SCOPE_AGENT); }
__device__ __forceinline__ unsigned xb_add(unsigned* p, unsigned v) { return __hip_atomic_fetch_add(p, v, __ATOMIC_RELAXED, __HIP_MEMORY_SCOPE_AGENT); }
__device__ __forceinline__ unsigned xb_xcc_id() { return (unsigned)__builtin_amdgcn_s_getreg((3 << 11) | 20) & 0xFu; }
#define XB_SPIN(cond, bar) do { unsigned _sp = 0; while (cond) { __builtin_amdgcn_s_sleep(1); \
    if ((++_sp & 255u) == 0u) { if (xb_ld(&(bar)[XB_TMO])) break; if (_sp > XB_SPIN_CAP) { atomicAdd(&(bar)[XB_TMO], 1u); break; } } } } while (0)

struct XcdBarrier {
    unsigned* bar; unsigned x;
    volatile LAS unsigned* st;
};
__device__ __forceinline__ XcdBarrier xcd_barrier_post(unsigned* bar, volatile LAS unsigned* st) {
    XcdBarrier b; b.bar = bar; b.x = xb_xcc_id(); b.st = st;
    if (threadIdx.x == 0) (void)xb_add(&bar[XB_XCNT(b.x)], 1u);
    return b;
}
__device__ __forceinline__ void xcd_barrier_complete(unsigned* bar, unsigned x, unsigned& nloc, unsigned& nx) {
    const unsigned G = gridDim.x * gridDim.y * gridDim.z;
    unsigned sum, cnt, mine, sp = 0u;
    for (;;) {
        sum = 0u; cnt = 0u; mine = 0u;
#pragma unroll
        for (unsigned j = 0; j < 16; ++j) { const unsigned c = xb_ld(&bar[XB_XCNT(j)]); sum += c; cnt += (c > 0u) ? 1u : 0u; mine = (j == x) ? c : mine; }
        if (sum == G) break;
        __builtin_amdgcn_s_sleep(1);
        if ((++sp & 255u) == 0u) { if (xb_ld(&bar[XB_TMO])) break; if (sp > XB_SPIN_CAP) { atomicAdd(&bar[XB_TMO], 1u); break; } }
    }
    nloc = mine > 0u ? mine : 1u; nx = cnt > 0u ? cnt : 1u;
}
__device__ __forceinline__ void xcd_barrier(const XcdBarrier& b) {
    asm volatile("s_waitcnt vmcnt(0)" ::: "memory");
    __syncthreads();
    if (threadIdx.x == 0) {
        unsigned* bar = b.bar;
        __builtin_amdgcn_s_waitcnt(0);
        unsigned nloc = b.st[0], nx = b.st[1];
        if (nloc == 0u) { xcd_barrier_complete(bar, b.x, nloc, nx); b.st[0] = nloc; b.st[1] = nx; }
        const unsigned old = xb_add(&bar[XB_XSUB(b.x)], 1u);
        const unsigned gen = old / nloc;
        if (old + 1u == (gen + 1u) * nloc) {
            __builtin_amdgcn_fence(__ATOMIC_RELEASE, "agent");
            asm volatile("s_waitcnt vmcnt(0)" ::: "memory");
            const unsigned og = xb_add(&bar[XB_TOP], 1u);
            const unsigned tg = og / nx;
            if (og + 1u == (tg + 1u) * nx) xb_add(&bar[XB_TOPGEN], 1u);
            else XB_SPIN(xb_ld(&bar[XB_TOPGEN]) == tg, bar);
            __builtin_amdgcn_fence(__ATOMIC_ACQUIRE, "agent");
            xb_add(&bar[XB_XGEN(b.x)], 1u);
            asm volatile("s_waitcnt vmcnt(0)" ::: "memory");
        } else {
            XB_SPIN(xb_ld(&bar[XB_XGEN(b.x)]) == gen, bar);
            __builtin_amdgcn_fence(__ATOMIC_ACQUIRE, "agent");
            asm volatile("s_waitcnt vmcnt(0)" ::: "memory");
        }
    }
    __syncthreads();
}
namespace att {
typedef unsigned short bf16_t;
using bf16x8 = __attribute__((ext_vector_type(8))) short;
using s16x4  = __attribute__((ext_vector_type(4))) short;
using f32x16 = __attribute__((ext_vector_type(16))) float;
using u32x4  = __attribute__((ext_vector_type(4))) unsigned;
constexpr int NW = 8, QBLK = 32, KVBLK = 64;
constexpr int LDR = 512;
constexpr float THR = 8.f;
constexpr int SHM_V = KVBLK * 128 * 2, SHM_K = KVBLK * 64 * 2, NBUF = 3, WS_OFF = NBUF * (SHM_V + SHM_K), SHM_ATTN = WS_OFF + NW * 64 * 4;
#define KSWZ(row, colB) ((row) * 128 + ((colB) ^ ((((row) >> 1) & 7) << 4)))
#define SBAR() __builtin_amdgcn_sched_barrier(0)
__device__ __forceinline__ int crow(int r, int hi) { return (r & 3) + 8 * (r >> 2) + 4 * hi; }
__device__ __forceinline__ unsigned cvtpk(float lo, float hi) { unsigned r; asm volatile("v_cvt_pk_bf16_f32 %0, %1, %2" : "=v"(r) : "v"(lo), "v"(hi)); return r; }

__device__ __forceinline__ void partialSM(f32x16& p0, f32x16& p1, float& m_reg, float& mn, float& alpha) {
  constexpr float C = 1.4426950408889634f;
  float pmax = p0[0];
#pragma unroll
  for (int r = 1; r < 16; ++r) pmax = fmaxf(pmax, p0[r]);
#pragma unroll
  for (int r = 0; r < 16; ++r) pmax = fmaxf(pmax, p1[r]);
  { auto rr = __builtin_amdgcn_permlane32_swap(__float_as_uint(pmax), __float_as_uint(pmax), false, false);
    pmax = fmaxf(__uint_as_float(rr[0]), __uint_as_float(rr[1])); }
  if (__builtin_expect(__all(pmax - m_reg <= THR), 1)) { mn = m_reg; alpha = 1.f; }
  else { mn = fmaxf(m_reg, pmax); alpha = __builtin_amdgcn_exp2f((m_reg - mn) * C); m_reg = mn; }
  float mnC = -mn * C;
#pragma unroll
  for (int r = 0; r < 16; ++r) p0[r] = fmaf(p0[r], C, mnC);
#pragma unroll
  for (int r = 0; r < 16; ++r) p1[r] = fmaf(p1[r], C, mnC);
#pragma unroll
  for (int r = 0; r < 16; ++r) p0[r] = __builtin_amdgcn_exp2f(p0[r]);
}
__device__ __forceinline__ float psm_max0(const f32x16& p0) {
  float pmax = p0[0];
#pragma unroll
  for (int r = 1; r < 16; ++r) pmax = fmaxf(pmax, p0[r]);
  return pmax;
}
__device__ __forceinline__ void psm_max1(const f32x16& p1, float pmax, float& m_reg, float& mn, float& alpha) {
  constexpr float C = 1.4426950408889634f;
#pragma unroll
  for (int r = 0; r < 16; ++r) pmax = fmaxf(pmax, p1[r]);
  { auto rr = __builtin_amdgcn_permlane32_swap(__float_as_uint(pmax), __float_as_uint(pmax), false, false);
    pmax = fmaxf(__uint_as_float(rr[0]), __uint_as_float(rr[1])); }
  if (__builtin_expect(__all(pmax - m_reg <= THR), 1)) { mn = m_reg; alpha = 1.f; }
  else { mn = fmaxf(m_reg, pmax); alpha = __builtin_amdgcn_exp2f((m_reg - mn) * C); m_reg = mn; }
}
__device__ __forceinline__ void psm_scale(f32x16& p0, f32x16& p1, float mn) {
  constexpr float C = 1.4426950408889634f; const float mnC = -mn * C;
#pragma unroll
  for (int r = 0; r < 16; ++r) p0[r] = fmaf(p0[r], C, mnC);
#pragma unroll
  for (int r = 0; r < 16; ++r) p1[r] = fmaf(p1[r], C, mnC);
}
__device__ __forceinline__ void psm_exp0(f32x16& p0) {
#pragma unroll
  for (int r = 0; r < 16; ++r) p0[r] = __builtin_amdgcn_exp2f(p0[r]);
}
__device__ __forceinline__ void finishSM(f32x16& p0, f32x16& p1, float alpha, float& l_reg, bf16x8& pa0, bf16x8& pa1, bf16x8& pa2, bf16x8& pa3) {
#pragma unroll
  for (int r = 0; r < 16; ++r) p1[r] = __builtin_amdgcn_exp2f(p1[r]);
  float ps = 0;
#pragma unroll
  for (int r = 0; r < 16; ++r) ps += p0[r];
#pragma unroll
  for (int r = 0; r < 16; ++r) ps += p1[r];
  { auto rr = __builtin_amdgcn_permlane32_swap(__float_as_uint(ps), __float_as_uint(ps), false, false);
    ps = __uint_as_float(rr[0]) + __uint_as_float(rr[1]); }
  l_reg = l_reg * alpha + ps;
#define PK4(P, BASE, OUT) do { unsigned a0 = cvtpk(P[BASE + 0], P[BASE + 1]), a1 = cvtpk(P[BASE + 2], P[BASE + 3]);   \
    unsigned b0 = cvtpk(P[BASE + 4], P[BASE + 5]), b1 = cvtpk(P[BASE + 6], P[BASE + 7]);                              \
    auto r0 = __builtin_amdgcn_permlane32_swap(a0, b0, false, false); auto r1 = __builtin_amdgcn_permlane32_swap(a1, b1, false, false); \
    u32x4 w = {r0[0], r1[0], r0[1], r1[1]}; OUT = *reinterpret_cast<bf16x8*>(&w); } while (0)
  PK4(p0, 0, pa0); PK4(p0, 8, pa1); PK4(p1, 0, pa2); PK4(p1, 8, pa3);
#undef PK4
}
__device__ __forceinline__ void qkt(f32x16& p0, f32x16& p1, const char* Ks, const bf16x8 (&qr)[4], int r32, int hi) {
  p0 = f32x16{}; p1 = f32x16{};
#pragma unroll
  for (int d0 = 0; d0 < 4; ++d0) { const int cb = (d0 * 16 + hi * 8) * 2;
    bf16x8 b0 = *reinterpret_cast<const bf16x8*>(Ks + KSWZ(r32, cb));
    bf16x8 b1 = *reinterpret_cast<const bf16x8*>(Ks + KSWZ(32 + r32, cb));
    p0 = __builtin_amdgcn_mfma_f32_32x32x16_bf16(b0, qr[d0], p0, 0, 0, 0);
    p1 = __builtin_amdgcn_mfma_f32_32x32x16_bf16(b1, qr[d0], p1, 0, 0, 0); }
}
__device__ __forceinline__ int v_st(int k, int c) { const int kk = (k & ~0xC) | ((k & 4) << 1) | ((k & 8) >> 1); return ((kk >> 3) * 4 + (c >> 5)) * 512 + ((kk & 7) * 32 + (c & 31)) * 2; }
__device__ __forceinline__ int v_rd_base(int lane) { return ((lane & 3) << 3) | (((lane >> 2) & 3) << 6) | (((lane >> 4) & 1) << 5) | (((lane >> 5) & 1) << 8); }
constexpr int v_rd_off(int d0, int ks, int half) { return d0 * 512 + ks * 4096 + half * 2048; }
template <int OFF> __device__ __forceinline__ s16x4 tr_read(int vb) {
  s16x4 r; asm volatile("ds_read_b64_tr_b16 %0, %1 offset:%2" : "=&v"(r) : "v"(vb), "i"(OFF) : "memory"); return r;
}
template <int D0> __device__ __forceinline__ void pv_one(f32x16& od, int vb, bf16x8 pa0, bf16x8 pa1, bf16x8 pa2, bf16x8 pa3) {
  const s16x4 l0 = tr_read<v_rd_off(D0, 0, 0)>(vb), h0 = tr_read<v_rd_off(D0, 0, 1)>(vb), l1 = tr_read<v_rd_off(D0, 1, 0)>(vb), h1 = tr_read<v_rd_off(D0, 1, 1)>(vb);
  const s16x4 l2 = tr_read<v_rd_off(D0, 2, 0)>(vb), h2 = tr_read<v_rd_off(D0, 2, 1)>(vb), l3 = tr_read<v_rd_off(D0, 3, 0)>(vb), h3 = tr_read<v_rd_off(D0, 3, 1)>(vb);
  asm volatile("s_waitcnt lgkmcnt(0)" ::: "memory"); SBAR();
#define PK(L, H) (bf16x8){L[0], L[1], L[2], L[3], H[0], H[1], H[2], H[3]}
  od = __builtin_amdgcn_mfma_f32_32x32x16_bf16(pa0, PK(l0, h0), od, 0, 0, 0);
  od = __builtin_amdgcn_mfma_f32_32x32x16_bf16(pa1, PK(l1, h1), od, 0, 0, 0);
  od = __builtin_amdgcn_mfma_f32_32x32x16_bf16(pa2, PK(l2, h2), od, 0, 0, 0);
  od = __builtin_amdgcn_mfma_f32_32x32x16_bf16(pa3, PK(l3, h3), od, 0, 0, 0);
#undef PK
}
__device__ __forceinline__ void pv_d0(f32x16 (&o)[4], int vb, bf16x8 pa0, bf16x8 pa1, bf16x8 pa2, bf16x8 pa3) {
  pv_one<0>(o[0], vb, pa0, pa1, pa2, pa3); pv_one<1>(o[1], vb, pa0, pa1, pa2, pa3); pv_one<2>(o[2], vb, pa0, pa1, pa2, pa3); pv_one<3>(o[3], vb, pa0, pa1, pa2, pa3);
}

__device__ __forceinline__ void pv_psm(f32x16 (&o)[4], int vb, bf16x8 pa0, bf16x8 pa1, bf16x8 pa2, bf16x8 pa3, f32x16& p0, f32x16& p1, float& m_reg, float& mn, float& alpha) {
  pv_one<0>(o[0], vb, pa0, pa1, pa2, pa3); const float pm0 = psm_max0(p0);
  pv_one<1>(o[1], vb, pa0, pa1, pa2, pa3); psm_max1(p1, pm0, m_reg, mn, alpha);
  pv_one<2>(o[2], vb, pa0, pa1, pa2, pa3); psm_scale(p0, p1, mn);
  pv_one<3>(o[3], vb, pa0, pa1, pa2, pa3); psm_exp0(p0);
}

__device__ __forceinline__ void attn_pass(const bf16_t* __restrict__ Qb, const bf16_t* __restrict__ Kh, const bf16_t* __restrict__ Vh, int seq, char* lds, f32x16 (&o)[4], float& l_out) {
  int tid = threadIdx.x; asm volatile("" : "+v"(tid));
  const int wid = tid >> 6, lane = tid & 63, r32 = lane & 31, hi = lane >> 5;
  char* V_lds = lds; char* K_lds = lds + NBUF * SHM_V;
  float* ws = (float*)(lds + WS_OFF) + wid * 64; float* al_l = ws + 32;
  float m_reg = -1e30f, l_reg = 0; bf16x8 qr[4];
#pragma unroll
  for (int d = 0; d < 4; ++d) o[d] = f32x16{};
  const bf16_t* Qw = Qb + (long)(wid * QBLK + r32) * LDR + hi * 8;
#pragma unroll
  for (int d0 = 0; d0 < 4; ++d0) qr[d0] = *reinterpret_cast<const bf16x8*>(Qw + d0 * 16);
  const int sr = tid >> 4, sc = (tid & 15) * 8, vst0 = v_st(sr, sc), vst1 = v_st(32 + sr, sc);
  const int kr = tid >> 3, kc = (tid & 7) * 8, kst = KSWZ(kr, kc * 2);
  const int vb0 = (int)(uintptr_t)V_lds + v_rd_base(lane);
  struct { bf16x8 vs0, vs1, ks0; } sr_[2];
#define SLOAD(i, k0) do { sr_[i].vs0 = *reinterpret_cast<const bf16x8*>(&Vh[(long)((k0) + sr) * LDR + sc]); sr_[i].vs1 = *reinterpret_cast<const bf16x8*>(&Vh[(long)((k0) + 32 + sr) * LDR + sc]); \
    sr_[i].ks0 = *reinterpret_cast<const bf16x8*>(&Kh[(long)((k0) + kr) * LDR + kc]); } while (0)
#define SWRITE(b, i) do { *(bf16x8*)(V_lds + (b) * SHM_V + vst0) = sr_[i].vs0; *(bf16x8*)(V_lds + (b) * SHM_V + vst1) = sr_[i].vs1; \
    *(bf16x8*)(K_lds + (b) * SHM_K + kst) = sr_[i].ks0; } while (0)
#define SWAIT() asm volatile("s_waitcnt vmcnt(3)" ::: "memory")
#define RESC(a) do { if (__any((a) < 1.f)) { if (hi == 0) al_l[r32] = (a); asm volatile("s_waitcnt lgkmcnt(0)" ::: "memory"); \
    _Pragma("unroll") for (int d = 0; d < 4; ++d) _Pragma("unroll") for (int r = 0; r < 16; ++r) o[d][r] *= al_l[crow(r, hi)]; } } while (0)
#define ROT() do { const int t_ = bprev; bprev = bcur; bcur = bnext; bnext = t_; } while (0)
  f32x16 pA0, pA1, pB0, pB1; float mnA, mnB, alA, alB; bf16x8 pa0, pa1, pa2, pa3; const int NT = seq / KVBLK;
  constexpr int SE = 0, SO = 1;
  SLOAD(SE, 0); asm volatile("s_waitcnt vmcnt(0)" ::: "memory"); SWRITE(0, SE);
  SLOAD(SO, KVBLK); if (2 < NT) SLOAD(SE, 2 * KVBLK);
  __syncthreads();
  qkt(pA0, pA1, K_lds, qr, r32, hi); partialSM(pA0, pA1, m_reg, mnA, alA);
  SWAIT(); SWRITE(1, SO);
  int bprev = 0, bcur = 1, bnext = 2;
  for (int j = 1; j + 1 < NT; j += 2) {
    __syncthreads();
    SBAR(); qkt(pB0, pB1, K_lds + bcur * SHM_K, qr, r32, hi);
#ifdef ATT_X1
    asm volatile("" : "+v"(pB0), "+v"(pB1)); qkt(pB0, pB1, K_lds + bcur * SHM_K, qr, r32, hi);
#endif
    finishSM(pA0, pA1, alA, l_reg, pa0, pa1, pa2, pa3); SBAR();
#ifdef ATT_X2
    { bf16x8 z = {0,0,0,0,0,0,0,0}; asm volatile("" : "+v"(z)); pv_d0(o, vb0 + bprev * (int)SHM_V, z, z, z, z); }
#endif
    SLOAD(SO, (j + 2) * KVBLK); SBAR();
    pv_psm(o, vb0 + bprev * (int)SHM_V, pa0, pa1, pa2, pa3, pB0, pB1, m_reg, mnB, alB);
    SWAIT(); SWRITE(bnext, SE);
    RESC(alB); ROT();
    __syncthreads();
    SBAR(); qkt(pA0, pA1, K_lds + bcur * SHM_K, qr, r32, hi);
#ifdef ATT_X1
    asm volatile("" : "+v"(pA0), "+v"(pA1)); qkt(pA0, pA1, K_lds + bcur * SHM_K, qr, r32, hi);
#endif
    finishSM(pB0, pB1, alB, l_reg, pa0, pa1, pa2, pa3); SBAR();
#ifdef ATT_X2
    { bf16x8 z = {0,0,0,0,0,0,0,0}; asm volatile("" : "+v"(z)); pv_d0(o, vb0 + bprev * (int)SHM_V, z, z, z, z); }
#endif
    SLOAD(SE, (j + 3 < NT ? j + 3 : NT - 1) * KVBLK); SBAR();
    pv_psm(o, vb0 + bprev * (int)SHM_V, pa0, pa1, pa2, pa3, pA0, pA1, m_reg, mnA, alA);
    SWAIT(); SWRITE(bnext, SO);
    RESC(alA); ROT();
  }
  __syncthreads();
  SBAR(); qkt(pB0, pB1, K_lds + bcur * SHM_K, qr, r32, hi);
  finishSM(pA0, pA1, alA, l_reg, pa0, pa1, pa2, pa3); SBAR();
  pv_psm(o, vb0 + bprev * (int)SHM_V, pa0, pa1, pa2, pa3, pB0, pB1, m_reg, mnB, alB);
  RESC(alB);
  finishSM(pB0, pB1, alB, l_reg, pa0, pa1, pa2, pa3); SBAR();
  pv_d0(o, vb0 + bcur * (int)SHM_V, pa0, pa1, pa2, pa3);
  l_out = l_reg;
#undef SLOAD
#undef SWRITE
#undef SWAIT
#undef RESC
#undef ROT
}

__device__ __forceinline__ void attn_unit(const bf16_t* QB, const bf16_t* KB, const bf16_t* VB, float* OS, bf16_t* CAT, const float* subg, float lam, float outscale,
                                          int h, long row_q0, long row_k0, int nkeys, char* lds) {
  int tid = threadIdx.x; asm volatile("" : "+v"(tid));
  const int wid = tid >> 6, lane = tid & 63, r32 = lane & 31, hi = lane >> 5;
  float* li_l = (float*)(lds + WS_OFF) + wid * 64;
  float* OSu = OS + row_q0 * 512 + h * 128;
  bf16_t* CATu = CAT + row_q0 * 1024 + h * 128;
  {
    f32x16 o[4]; float l_reg;
    attn_pass(QB + row_q0 * LDR + h * 64, KB + row_k0 * LDR + h * 64, VB + row_k0 * LDR + h * 128, nkeys, lds, o, l_reg);
    if (hi == 0) li_l[r32] = l_reg;
    asm volatile("s_waitcnt lgkmcnt(0)" ::: "memory");
    int ob = (wid * QBLK + 4 * hi) * 512 + r32; asm volatile("" : "+v"(ob));
#pragma unroll
    for (int r = 0; r < 16; ++r) { const int oo = ob + ((r & 3) + 8 * (r >> 2)) * 512; const float rl = __builtin_amdgcn_rcpf(li_l[crow(r, hi)]);
#pragma unroll
      for (int d0 = 0; d0 < 4; ++d0) OSu[oo + d0 * 32] = o[d0][r] * rl; }
    asm volatile("s_waitcnt vmcnt(0)" ::: "memory");
    __syncthreads();
  }
  {
    f32x16 o[4]; float l_reg;
    attn_pass(QB + row_q0 * LDR + 256 + h * 64, KB + row_k0 * LDR + 256 + h * 64, VB + row_k0 * LDR + h * 128, nkeys, lds, o, l_reg);
    if (hi == 0) li_l[r32] = l_reg;
    asm volatile("s_waitcnt lgkmcnt(0)" ::: "memory");
    float ss[16];
    int ob = (wid * QBLK + 4 * hi) * 512 + r32; asm volatile("" : "+v"(ob));
#pragma unroll
    for (int r = 0; r < 16; ++r) { const int oo = ob + ((r & 3) + 8 * (r >> 2)) * 512; float s = 0.f; const float rl = lam * __builtin_amdgcn_rcpf(li_l[crow(r, hi)]);
#pragma unroll
      for (int d0 = 0; d0 < 4; ++d0) { const float v = OSu[oo + d0 * 32] - o[d0][r] * rl; o[d0][r] = v; s += v * v; }
      s += __shfl_xor(s, 1); s += __shfl_xor(s, 2); s += __shfl_xor(s, 4); s += __shfl_xor(s, 8); s += __shfl_xor(s, 16);
      ss[r] = (1.0f / sqrtf(s * (1.0f / 128.0f) + 1e-6f)) * outscale; asm volatile("" ::: "memory"); }
    float gs[4];
#pragma unroll
    for (int d0 = 0; d0 < 4; ++d0) gs[d0] = subg[d0 * 32 + r32];
    int cbo = (wid * QBLK + 4 * hi) * 1024 + r32; asm volatile("" : "+v"(cbo));
#pragma unroll
    for (int r = 0; r < 16; ++r) { const int co = cbo + ((r & 3) + 8 * (r >> 2)) * 1024;
#pragma unroll
      for (int d0 = 0; d0 < 4; ++d0) CATu[co + d0 * 32] = (bf16_t)(cvtpk(o[d0][r] * ss[r] * gs[d0], 0.f) & 0xffffu); }
    asm volatile("s_waitcnt vmcnt(0)" ::: "memory");
    __syncthreads();
  }
}
#undef KSWZ
#undef SBAR
}
typedef unsigned short bf16_t;
typedef float f32x4 __attribute__((ext_vector_type(4)));
typedef float f32x2 __attribute__((ext_vector_type(2)));
typedef unsigned u32x4 __attribute__((ext_vector_type(4)));
typedef unsigned u32x2 __attribute__((ext_vector_type(2)));
typedef short bf16x8 __attribute__((ext_vector_type(8)));

constexpr int D = 1024, NB = 8, SEQ = 4096, DEPTH = 4, CTXL = 256;
constexpr int RPB = CTXL + SEQ;
constexpr int RT = NB * RPB;
constexpr int PROJ = 2560, NE = 16, FF = 2048;
constexpr int CAP_L = 512, CAP_C = 32;
constexpr int ER = NB * CAP_L + NB * CAP_C;
constexpr int NWAVES = 8, NTHR = 512;
constexpr float EPS = 1e-6f;

constexpr size_t al256(size_t x) { return (x + 255) / 256 * 256; }
constexpr size_t WS_CTL   = 0;
constexpr size_t CTL_BYTES = 1u << 16;
constexpr size_t WS_MOD   = WS_CTL + CTL_BYTES;
constexpr size_t WS_ROPEC = al256(WS_MOD + (size_t)DEPTH * 9 * 6 * D * 4);
constexpr size_t WS_ROPES = WS_ROPEC + 64 * 16 * 4;
constexpr size_t WS_LAM   = WS_ROPES + 64 * 16 * 4;
constexpr size_t WS_SGUW  = al256(WS_LAM + 256);
constexpr size_t WS_XR    = al256(WS_SGUW + (size_t)DEPTH * 8 * 128 * 128 * 2);
constexpr size_t WS_HA    = al256(WS_XR + (size_t)RT * D * 4);
constexpr size_t WS_QB    = al256(WS_HA + (size_t)RT * D * 2);
constexpr size_t WS_KB    = al256(WS_QB + (size_t)RT * 512 * 2);
constexpr size_t WS_VB    = al256(WS_KB + (size_t)RT * 512 * 2);
constexpr size_t WS_UB    = al256(WS_VB + (size_t)RT * 512 * 2);
constexpr size_t WS_GVB   = al256(WS_UB + (size_t)RT * 512 * 2);
constexpr size_t WS_CAT   = al256(WS_GVB + (size_t)RT * 512 * 2);
constexpr size_t WS_OS    = al256(WS_CAT + (size_t)RT * D * 2);
constexpr size_t WS_AFF   = al256(WS_OS + (size_t)RT * 512 * 4);
constexpr size_t WS_INV   = al256(WS_AFF + (size_t)RT * 16 * 4);
constexpr size_t WS_RSRC  = al256(WS_INV + (size_t)RT * 16 * 4);
constexpr size_t WS_XS    = al256(WS_RSRC + (size_t)NE * ER * 4);
constexpr size_t WS_HID   = al256(WS_XS + (size_t)NE * ER * D * 2);
constexpr size_t WS_Y     = al256(WS_HID + (size_t)NE * ER * FF * 2);
constexpr size_t WS_WIN   = al256(WS_Y + (size_t)NE * ER * D * 2);
constexpr size_t WS_WOUT  = al256(WS_WIN + (size_t)DEPTH * PROJ * D * 2);
constexpr size_t WS_WGU   = al256(WS_WOUT + (size_t)DEPTH * D * D * 2);
constexpr size_t WS_WD    = al256(WS_WGU + (size_t)DEPTH * NE * 2 * FF * D * 2);
constexpr size_t WS_END   = al256(WS_WD + (size_t)DEPTH * NE * D * FF * 2);

constexpr int LDS_MISC = 147456 - 256;
constexpr int LDS_BYTES = 147456;

__device__ __forceinline__ unsigned f2bf(float f) { unsigned u = __builtin_bit_cast(unsigned, f); return (u + 0x7fffu + ((u >> 16) & 1u)) >> 16; }
__device__ __forceinline__ unsigned pk2(float lo, float hi) { return pg8::cvt_pk_bf16(lo, hi); }
__device__ __forceinline__ float bf2f(unsigned h) { return __builtin_bit_cast(float, h << 16); }
template <int CTRL> __device__ __forceinline__ float dpp(float x) { return __builtin_bit_cast(float, __builtin_amdgcn_mov_dpp(__builtin_bit_cast(int, x), CTRL, 0xf, 0xf, true)); }
constexpr int DPP_XOR1 = 0xB1, DPP_XOR2 = 0x4E, DPP_HMIR = 0x141, DPP_XOR8 = 0x128;
__device__ __forceinline__ float xrow16_sum(float x) {
    auto s = __builtin_amdgcn_permlane16_swap(__float_as_uint(x), __float_as_uint(x), false, false); x = __uint_as_float(s[0]) + __uint_as_float(s[1]);
    auto t = __builtin_amdgcn_permlane32_swap(__float_as_uint(x), __float_as_uint(x), false, false); return __uint_as_float(t[0]) + __uint_as_float(t[1]);
}
__device__ __forceinline__ float xrow16_max(float x) {
    auto s = __builtin_amdgcn_permlane16_swap(__float_as_uint(x), __float_as_uint(x), false, false); x = fmaxf(__uint_as_float(s[0]), __uint_as_float(s[1]));
    auto t = __builtin_amdgcn_permlane32_swap(__float_as_uint(x), __float_as_uint(x), false, false); return fmaxf(__uint_as_float(t[0]), __uint_as_float(t[1]));
}
__device__ __forceinline__ float wave_sum(float v) {
    v += dpp<DPP_XOR1>(v); v += dpp<DPP_XOR2>(v); v += dpp<DPP_HMIR>(v); v += dpp<DPP_XOR8>(v);
    return xrow16_sum(v);
}
#define LDS_WAIT() asm volatile("s_waitcnt lgkmcnt(0)" ::: "memory")

__constant__ double kFreq[16] = {1.0, 0.56234132519034908, 0.31622776601683794, 0.17782794100389228,
                                 0.1, 0.056234132519034908, 0.031622776601683794, 0.017782794100389228,
                                 0.01, 0.0056234132519034908, 0.0031622776601683794, 0.0017782794100389228,
                                 0.001, 0.00056234132519034908, 0.00031622776601683794, 0.00017782794100389228};
__constant__ float kLamInit[4] = {0.2f, 0.35550906759096926f, 0.47071301834358416f, 0.5560582041556405f};

__device__ __forceinline__ void sincos_d(double a, double& s, double& c) {
    const double TWO_OVER_PI = 0.63661977236758134308, PIO2_HI = 1.57079632679489655800e+00, PIO2_LO = 6.12323399573676603587e-17;
    const double kf = __builtin_rint(a * TWO_OVER_PI); const int k = (int)kf;
    const double r = (a - kf * PIO2_HI) - kf * PIO2_LO, r2 = r * r;
    double sp = -1.0 / 1307674368000.0; sp = sp * r2 + 1.0 / 6227020800.0; sp = sp * r2 - 1.0 / 39916800.0; sp = sp * r2 + 1.0 / 362880.0; sp = sp * r2 - 1.0 / 5040.0; sp = sp * r2 + 1.0 / 120.0; sp = sp * r2 - 1.0 / 6.0; sp = sp * r2 + 1.0;
    const double sr = sp * r;
    double cp = 1.0 / 20922789888000.0; cp = cp * r2 - 1.0 / 87178291200.0; cp = cp * r2 + 1.0 / 479001600.0; cp = cp * r2 - 1.0 / 3628800.0; cp = cp * r2 + 1.0 / 40320.0; cp = cp * r2 - 1.0 / 720.0; cp = cp * r2 + 1.0 / 24.0; cp = cp * r2 - 0.5; cp = cp * r2 + 1.0;
    const int q = k & 3;
    s = (q == 0) ? sr : (q == 1) ? cp : (q == 2) ? -sr : -cp;
    c = (q == 0) ? cp : (q == 1) ? -sr : (q == 2) ? -cp : sr;
}


__device__ __forceinline__ unsigned long long lds_ptr(LAS unsigned long long* tab, int i) {
    const unsigned long long v = tab[i];
    const unsigned lo = __builtin_amdgcn_readfirstlane((unsigned)v), hi = __builtin_amdgcn_readfirstlane((unsigned)(v >> 32));
    return ((unsigned long long)hi << 32) | lo;
}
struct Args { const float* in[23]; float* out; unsigned char* ws; int ph_lo, ph_hi; };
enum { I_X = 0, I_C, I_CTX, I_CCTX, I_WADA, I_BADA, I_N1G, I_N2G, I_WIN, I_WOUT, I_LQ1, I_LK1, I_LQ2, I_LK2, I_SUBG, I_SGUNG, I_SGUW, I_SGUB, I_WR, I_WG, I_WU, I_WDN, I_NFG };

__device__ __forceinline__ void transpose_item(const float* __restrict__ W, int N, int k0, int n0, bf16_t* __restrict__ WT, int K, int drow0, LAS float* scr, int lane) {
    float t[32];
#pragma unroll
    for (int i = 0; i < 32; ++i) { const int kk = 2 * i + (lane >> 5); t[i] = __builtin_nontemporal_load(&W[(size_t)(k0 + kk) * N + n0 + (lane & 31)]); }
#pragma unroll
    for (int i = 0; i < 32; ++i) { const int kk = 2 * i + (lane >> 5); scr[kk * 33 + (lane & 31)] = t[i]; }
    LDS_WAIT(); asm volatile("" ::: "memory");
    const int c = lane & 7;
#pragma unroll
    for (int j = 0; j < 4; ++j) { const int n = (lane >> 3) + 8 * j; const LAS float* s = scr + (8 * c) * 33 + n;
        u32x4 o; o.x = pk2(s[0 * 33], s[1 * 33]); o.y = pk2(s[2 * 33], s[3 * 33]); o.z = pk2(s[4 * 33], s[5 * 33]); o.w = pk2(s[6 * 33], s[7 * 33]);
        __builtin_nontemporal_store(o, (u32x4*)(WT + (size_t)(drow0 + n) * K + k0 + 8 * c)); }
    LDS_WAIT(); asm volatile("" ::: "memory");
}

__device__ __forceinline__ void row_load(const float* p, int lane, f32x4 (&v)[4]) {
    const f32x4* xr = (const f32x4*)p + lane;
#pragma unroll
    for (int j = 0; j < 4; ++j) v[j] = xr[64 * j];
}
__device__ __forceinline__ void row_store(float* p, int lane, const f32x4 (&v)[4]) {
    f32x4* xr = (f32x4*)p + lane;
#pragma unroll
    for (int j = 0; j < 4; ++j) xr[64 * j] = v[j];
}
__device__ __forceinline__ void row_load_bf(const bf16_t* p, int lane, f32x4 (&v)[4]) {
    const u32x2* xr = (const u32x2*)p + lane; u32x2 t[4];
#pragma unroll
    for (int j = 0; j < 4; ++j) t[j] = xr[64 * j];
#pragma unroll
    for (int j = 0; j < 4; ++j) v[j] = (f32x4){bf2f(t[j].x & 0xffffu), bf2f(t[j].x >> 16), bf2f(t[j].y & 0xffffu), bf2f(t[j].y >> 16)};
}
__device__ __forceinline__ void row_store_bf(bf16_t* p, int lane, const f32x4 (&v)[4]) {
    u32x2* xr = (u32x2*)p + lane;
#pragma unroll
    for (int j = 0; j < 4; ++j) { u32x2 w; w.x = pk2(v[j].x, v[j].y); w.y = pk2(v[j].z, v[j].w); xr[64 * j] = w; }
}
__device__ __forceinline__ float row_rstd(const f32x4 (&v)[4]) {
    float s = 0.f;
#pragma unroll
    for (int j = 0; j < 4; ++j) s += (v[j].x * v[j].x + v[j].y * v[j].y) + (v[j].z * v[j].z + v[j].w * v[j].w);
    return __builtin_amdgcn_rsqf(wave_sum(s) * (1.0f / D) + EPS);
}
__device__ __forceinline__ void norm_mod(f32x4 (&v)[4], const float* g, const float* sh, const float* sc, bf16_t* orow, int lane) {
    const float rstd = row_rstd(v);
    unsigned long long* o8 = (unsigned long long*)orow + lane;
#pragma unroll
    for (int j = 0; j < 4; ++j) {
        const f32x4 gg = ((const f32x4*)g)[lane + 64 * j], ss = ((const f32x4*)sh)[lane + 64 * j], cc = ((const f32x4*)sc)[lane + 64 * j];
        v[j] = (v[j] * rstd) * gg * (1.0f + cc) + ss;
        o8[64 * j] = (unsigned long long)pk2(v[j].x, v[j].y) | ((unsigned long long)pk2(v[j].z, v[j].w) << 32);
    }
}


__device__ __forceinline__ void load_mod(const float* g, const float* sh, const float* sc, int lane, f32x4 (&A)[4], f32x4 (&SH)[4]) {
#pragma unroll
    for (int j = 0; j < 4; ++j) { const f32x4 gg = ((const f32x4*)g)[lane + 64 * j], cc = ((const f32x4*)sc)[lane + 64 * j]; A[j] = gg * (1.0f + cc); SH[j] = ((const f32x4*)sh)[lane + 64 * j]; }
}
__device__ __forceinline__ void norm_mod2(f32x4 (&v)[4], const f32x4 (&A)[4], const f32x4 (&SH)[4], bf16_t* orow, int lane) {
    const float rstd = row_rstd(v);
    unsigned long long* o8 = (unsigned long long*)orow + lane;
#pragma unroll
    for (int j = 0; j < 4; ++j) { v[j] = (v[j] * rstd) * A[j] + SH[j];
        o8[64 * j] = (unsigned long long)pk2(v[j].x, v[j].y) | ((unsigned long long)pk2(v[j].z, v[j].w) << 32); }
}

__device__ __forceinline__ void norm_mod_lds(f32x4 (&v)[4], const LAS float* A, const LAS float* SH, bf16_t* orow, int lane) {
    const float rstd = row_rstd(v);
    unsigned long long* o8 = (unsigned long long*)orow + lane;
#pragma unroll
    for (int j = 0; j < 4; ++j) { v[j] = (v[j] * rstd) * *(const LAS f32x4*)(A + (lane + 64 * j) * 4) + *(const LAS f32x4*)(SH + (lane + 64 * j) * 4);
        o8[64 * j] = (unsigned long long)pk2(v[j].x, v[j].y) | ((unsigned long long)pk2(v[j].z, v[j].w) << 32); }
}

__device__ __forceinline__ float reduce16(const float (&p)[16], int lane) {
    float q8[8], q4[4], q2[2];
#pragma unroll
    for (int i = 0; i < 8; ++i) { auto rr = __builtin_amdgcn_permlane32_swap(__float_as_uint(p[i]), __float_as_uint(p[i + 8]), false, false); q8[i] = __uint_as_float(rr[0]) + __uint_as_float(rr[1]); }
    { const bool up = (lane & 16) != 0;
#pragma unroll
      for (int i = 0; i < 4; ++i) { const float snd = up ? q8[i] : q8[i + 4], kp = up ? q8[i + 4] : q8[i]; q4[i] = kp + __shfl_xor(snd, 16); } }
    { const bool up = (lane & 8) != 0;
#pragma unroll
      for (int i = 0; i < 2; ++i) { const float snd = up ? q4[i] : q4[i + 2], kp = up ? q4[i + 2] : q4[i]; q2[i] = kp + dpp<DPP_XOR8>(snd); } }
    float r;
    { const bool up = (lane & 4) != 0; const float snd = up ? q2[0] : q2[1], kp = up ? q2[1] : q2[0]; r = kp + dpp<DPP_HMIR>(snd); }
    r += dpp<DPP_XOR2>(r); r += dpp<DPP_XOR1>(r);
    return r;
}
__device__ __forceinline__ int lane_expert(int lane) { return ((lane >> 5) & 1) * 8 + ((lane >> 4) & 1) * 4 + ((lane >> 3) & 1) * 2 + ((lane >> 2) & 1); }

struct EpiInProj {
    static constexpr bool PERM = false, TWICE = true;
    bf16_t *Q, *Kb, *V, *U, *GV; const float *ropeC, *ropeS;
    __device__ __forceinline__ void operator()(const pg8::f32x4 (&acc)[2][2][4][2], const pg8::Unit& u, int wr, int wc, int fr_, int fq_) const {
        int fr = fr_, fq = fq_; asm volatile("" : "+v"(fr), "+v"(fq));
        const int type = u.pn >> 1;
        bf16_t* base = type == 0 ? Q : type == 1 ? Kb : type == 2 ? V : type == 3 ? U : GV;
        const int col0 = (u.pn & 1) * 256 + wc * 32 + 4 * fq;
        const int row0 = u.pm * 256 + wr * 64 + fr;
        const bool lat = (u.pm % 17) != 0;
        const float qs = (type == 0) ? 0.125f : 1.0f;
        if (type <= 1) {
            f32x4 csT[4], snT[4];
            const bool colax = (wc & 1) != 0;
#pragma unroll
            for (int t = 0; t < 4; ++t) { csT[t] = (f32x4){1.f, 1.f, 1.f, 1.f}; snT[t] = (f32x4){0.f, 0.f, 0.f, 0.f}; }
            if (lat) {
                if (colax) {
#pragma unroll
                    for (int m = 0; m < 4; ++m) { const int pos = m * 16 + fr; csT[m] = *(const f32x4*)(ropeC + pos * 16 + 4 * fq); snT[m] = *(const f32x4*)(ropeS + pos * 16 + 4 * fq); }
                } else {
#pragma unroll
                    for (int ai = 0; ai < 2; ++ai) { const int pos = (((row0 + ai * 128) % RPB) - CTXL) >> 6; csT[ai] = *(const f32x4*)(ropeC + pos * 16 + 4 * fq); snT[ai] = *(const f32x4*)(ropeS + pos * 16 + 4 * fq); }
                }
            }
            asm volatile("" ::: "memory");
#pragma unroll
            for (int ai = 0; ai < 2; ++ai)
#pragma unroll
                for (int m = 0; m < 4; ++m) {
                    const int row = row0 + ai * 128 + m * 16;
                    const f32x4 cs = colax ? csT[m] : csT[ai], sn = colax ? snT[m] : snT[ai];
                    bf16_t* rowp = base + (size_t)row * 512 + col0;
#pragma unroll
                    for (int bj = 0; bj < 2; ++bj) {
                        const f32x4 t0 = acc[ai][bj][m][0], t1 = acc[ai][bj][m][1];
                        const f32x4 o0 = (t0 * cs - t1 * sn) * qs, o1 = (t1 * cs + t0 * sn) * qs;
                        u32x2 w0, w1; w0.x = pk2(o0[0], o0[1]); w0.y = pk2(o0[2], o0[3]); w1.x = pk2(o1[0], o1[1]); w1.y = pk2(o1[2], o1[3]);
                        *(u32x2*)(rowp + bj * 128) = w0; *(u32x2*)(rowp + bj * 128 + 16) = w1;
                    }
                }
        } else if (type == 2) {
#pragma unroll
            for (int ai = 0; ai < 2; ++ai)
#pragma unroll
                for (int m = 0; m < 4; ++m) {
                    bf16_t* rowp = base + (size_t)(row0 + ai * 128 + m * 16) * 512 + col0;
#pragma unroll
                    for (int bj = 0; bj < 2; ++bj)
#pragma unroll
                        for (int n = 0; n < 2; ++n) {
                            const f32x4 v = acc[ai][bj][m][n];
                            u32x2 w; w.x = pk2(v[0], v[1]); w.y = pk2(v[2], v[3]);
                            *(u32x2*)(rowp + bj * 128 + n * 16) = w;
                        }
                }
        } else {
#pragma unroll
            for (int ai = 0; ai < 2; ++ai)
#pragma unroll
                for (int m = 0; m < 4; ++m) {
                    bf16_t* rowp = base + (size_t)(row0 + ai * 128 + m * 16) * 512 + col0;
                    u32x2 w[2][2];
#pragma unroll
                    for (int bj = 0; bj < 2; ++bj)
#pragma unroll
                        for (int n = 0; n < 2; ++n) {
                            f32x4 v = acc[ai][bj][m][n];
#ifdef GELU_X2
                            { f32x4 t_ = pg8::gelu4(v * 1.0001f); asm volatile("" :: "v"(t_)); }
#endif
                            v = pg8::gelu4(v);
                            w[bj][n].x = pk2(v[0], v[1]); w[bj][n].y = pk2(v[2], v[3]);
                        }
#pragma unroll
                    for (int bj = 0; bj < 2; ++bj)
#pragma unroll
                        for (int n = 0; n < 2; ++n) *(u32x2*)(rowp + bj * 128 + n * 16) = w[bj][n];
                }
        }
    }
};
struct EpiOutProj {
    static constexpr bool PERM = true, TWICE = false;
    bf16_t* XR; const float* modl; float scale;
    __device__ __forceinline__ void operator()(const pg8::f32x4 (&acc)[2][2][4][2], const pg8::Unit& u, int wr, int wc, int fr_, int fq_) const {
        int fr = fr_, fq = fq_; asm volatile("" : "+v"(fr), "+v"(fq));
        const int b = u.pm / 17; const int mrow = (u.pm % 17) == 0 ? 8 : b;
        const int col0 = u.pn * 256 + wc * 32 + 8 * fq, row0 = u.pm * 256 + wr * 64 + fr;
        const float* gp = modl + (size_t)mrow * 6144 + 2 * D + col0;
        f32x4 gv[2][2];
#pragma unroll
        for (int bj = 0; bj < 2; ++bj)
#pragma unroll
            for (int n = 0; n < 2; ++n) gv[bj][n] = *(const f32x4*)(gp + bj * 128 + n * 4);
#pragma unroll
        for (int ai = 0; ai < 2; ++ai) {
            u32x4 xv[4][2];
#pragma unroll
            for (int m = 0; m < 4; ++m)
#pragma unroll
                for (int bj = 0; bj < 2; ++bj) xv[m][bj] = *(const u32x4*)(XR + (size_t)(row0 + ai * 128 + m * 16) * D + col0 + bj * 128);
            asm volatile("" ::: "memory");
#pragma unroll
            for (int m = 0; m < 4; ++m)
#pragma unroll
                for (int bj = 0; bj < 2; ++bj) {
                    const u32x4 x = xv[m][bj];
                    const f32x4 x0 = (f32x4){bf2f(x.x & 0xffffu), bf2f(x.x >> 16), bf2f(x.y & 0xffffu), bf2f(x.y >> 16)}, x1 = (f32x4){bf2f(x.z & 0xffffu), bf2f(x.z >> 16), bf2f(x.w & 0xffffu), bf2f(x.w >> 16)};
                    const f32x4 o0 = x0 + gv[bj][0] * acc[ai][bj][m][0], o1 = x1 + gv[bj][1] * acc[ai][bj][m][1];
                    u32x4 w; w.x = pk2(o0.x, o0.y); w.y = pk2(o0.z, o0.w); w.z = pk2(o1.x, o1.y); w.w = pk2(o1.z, o1.w);
                    *(u32x4*)(XR + (size_t)(row0 + ai * 128 + m * 16) * D + col0 + bj * 128) = w;
                }
            asm volatile("" ::: "memory");
        }
    }
};
struct EpiGateUp {
    static constexpr bool PERM = true;
    bf16_t* HID;
    __device__ __forceinline__ void operator()(const pg8::f32x4 (&acc)[2][2][4][2], const pg8::Unit& u, int wr, int wc, int fr_, int fq_) const {
        int fr = fr_, fq = fq_; asm volatile("" : "+v"(fr), "+v"(fq));
        const int j = u.pn & 15; const int col0 = j * 128 + wc * 32 + 8 * fq, row0 = u.pm * 256 + wr * 64 + fr;
#pragma unroll
        for (int ai = 0; ai < 2; ++ai)
#pragma unroll
            for (int m = 0; m < 4; ++m) {
                float hv[8];
#pragma unroll
                for (int n = 0; n < 2; ++n)
#pragma unroll
                    for (int i = 0; i < 4; ++i) { const float gt = acc[ai][0][m][n][i], up = acc[ai][1][m][n][i];
                        hv[n * 4 + i] = gt * __builtin_amdgcn_rcpf(1.0f + __expf(-gt)) * up; }
                u32x4 w; w.x = pk2(hv[0], hv[1]); w.y = pk2(hv[2], hv[3]); w.z = pk2(hv[4], hv[5]); w.w = pk2(hv[6], hv[7]);
                *(u32x4*)(HID + (size_t)(row0 + ai * 128 + m * 16) * FF + col0) = w;
            }
    }
};
struct EpiDown {
    static constexpr bool PERM = true, TWICE = false;
    bf16_t* Y;
    __device__ __forceinline__ void operator()(const pg8::f32x4 (&acc)[2][2][4][2], const pg8::Unit& u, int wr, int wc, int fr_, int fq_) const {
        int fr = fr_, fq = fq_; asm volatile("" : "+v"(fr), "+v"(fq));
        const int col0 = (u.pn & 3) * 256 + wc * 32 + 8 * fq, row0 = u.pm * 256 + wr * 64 + fr;
#pragma unroll
        for (int ai = 0; ai < 2; ++ai)
#pragma unroll
            for (int m = 0; m < 4; ++m) { bf16_t* rowp = Y + (size_t)(row0 + ai * 128 + m * 16) * D + col0;
#pragma unroll
                for (int bj = 0; bj < 2; ++bj) { const f32x4 v0 = acc[ai][bj][m][0], v1 = acc[ai][bj][m][1];
                    u32x4 w; w.x = pk2(v0[0], v0[1]); w.y = pk2(v0[2], v0[3]); w.z = pk2(v1[0], v1[1]); w.w = pk2(v1[2], v1[3]);
                    *(u32x4*)(rowp + bj * 128) = w; } }
    }
};

#define GAS1 __attribute__((address_space(1)))
#define INP(i) ((const float*)(GAS1 const float*)lds_ptr(ptab, (i)))
#define MOD   ((float*)(ws + WS_MOD))
#define ROPEC ((float*)(ws + WS_ROPEC))
#define ROPES ((float*)(ws + WS_ROPES))
#define LAMV  ((float*)(ws + WS_LAM))
#define SGUW  ((bf16_t*)(ws + WS_SGUW))
#define XR    ((bf16_t*)(ws + WS_XR))
#define HA    ((bf16_t*)(ws + WS_HA))
#define QB    ((bf16_t*)(ws + WS_QB))
#define KB    ((bf16_t*)(ws + WS_KB))
#define VB    ((bf16_t*)(ws + WS_VB))
#define UB    ((bf16_t*)(ws + WS_UB))
#define GVB   ((bf16_t*)(ws + WS_GVB))
#define CAT   ((bf16_t*)(ws + WS_CAT))
#define OS    ((float*)(ws + WS_OS))
#define AFF   ((float*)(ws + WS_AFF))
#define INV   ((int*)(ws + WS_INV))
#define RSRC  ((int*)(ws + WS_RSRC))
#define XS    ((bf16_t*)(ws + WS_XS))
#define HID   ((bf16_t*)(ws + WS_HID))
#define Y     ((bf16_t*)(ws + WS_Y))
#define WIN   ((bf16_t*)(ws + WS_WIN))
#define WOUT  ((bf16_t*)(ws + WS_WOUT))
#define WGU   ((bf16_t*)(ws + WS_WGU))
#define WD    ((bf16_t*)(ws + WS_WD))
#define modl  (MOD + (size_t)l * 9 * 6144)
#define PIN_WS() unsigned char* const ws = (unsigned char*)(GAS1 unsigned char*)lds_ptr(ptab, 24)
#define PIN_IDS2() int tid = threadIdx.x; asm volatile("" : "+v"(tid)); const int lane = tid & 63, wave = __builtin_amdgcn_readfirstlane(tid >> 6)
#define PIN_IDS() int tid = threadIdx.x; asm volatile("" : "+v"(tid)); const int lane = tid & 63, wave = __builtin_amdgcn_readfirstlane(tid >> 6), gw = bx * NWAVES + wave; (void)lane; (void)gw; PIN_WS()
#ifndef PH_MASK
#define PH_MASK 0x7ff
#endif
#define INR(k) (lo <= (k) && (k) < hi)
#define IN(k) (((PH_MASK >> (k)) & 1) && INR(k))
#define INL(c) (((PH_MASK >> (2 + (c))) & 1) && INR(pb + (c)))
#ifndef PH_DUP
#define PH_DUP 0
#endif
#define REPS(c) (((PH_DUP >> (c)) & 1) ? 2 : 1)
#define SEAM(k) do { if (INR(k) && INR((k) + 1)) xcd_barrier(bar); } while (0)

constexpr size_t CTL_QUEUE = 16384;
__device__ __forceinline__ int queue_pull(unsigned* ctr, volatile LAS unsigned* slot, int tid) {
    __syncthreads();
    if (tid == 0) *slot = __hip_atomic_fetch_add(ctr, 1u, __ATOMIC_RELAXED, __HIP_MEMORY_SCOPE_AGENT);
    __syncthreads();
    return __builtin_amdgcn_readfirstlane((int)*slot);
}
constexpr int IT_IN = 16 * 80, IT_OUT = 16 * 32, IT_E = 1024, IT_L = IT_IN + IT_OUT + NE * 3 * IT_E;
__device__ __forceinline__ void convert_range(LAS unsigned long long* ptab, unsigned char* ws, LAS unsigned char* ldsl, int l, int it0, int it1, int rank, int nranks, int wave, int lane) {
    LAS float* scr = (LAS float*)(ldsl + 65536 + wave * 8704);
#pragma unroll 1
    for (int it = it0 + rank; it < it1; it += nranks) {
        int r = it;
        if (r < IT_IN) { const int kb = r / 80, nb = r % 80; transpose_item(INP(I_WIN) + (size_t)l * D * PROJ, PROJ, kb * 64, nb * 32, WIN + (size_t)l * PROJ * D, D, nb * 32, scr, lane); continue; }
        r -= IT_IN;
        if (r < IT_OUT) { const int kb = r / 32, nb = r % 32; transpose_item(INP(I_WOUT) + (size_t)l * D * D, D, kb * 64, nb * 32, WOUT + (size_t)l * D * D, D, nb * 32, scr, lane); continue; }
        r -= IT_OUT;
        if (r < NE * 2 * IT_E) { const int e = r / (2 * IT_E), which = (r % (2 * IT_E)) / IT_E, q = r % IT_E; const size_t le = (size_t)l * NE + e;
            const int kb = q / 64, nb = q % 64, n0 = nb * 32;
            transpose_item(INP(which == 0 ? I_WG : I_WU) + le * D * FF, FF, kb * 64, n0, WGU + le * (2 * FF) * D, D, 256 * (n0 >> 7) + which * 128 + (n0 & 127), scr, lane); continue; }
        r -= NE * 2 * IT_E;
        { const int e = r / IT_E, q = r % IT_E; const size_t le = (size_t)l * NE + e; const int kb = q / 32, nb = q % 32;
            transpose_item(INP(I_WDN) + le * FF * D, D, kb * 64, nb * 32, WD + le * D * FF, FF, nb * 32, scr, lane); }
    }
}
constexpr int CV_P = 26444, CV_Q = CV_P + 12000;
template <int L>
__device__ __forceinline__ void layer_body(unsigned char* lds, LAS unsigned char* ldsl, LAS unsigned long long* ptab, const XcdBarrier& bar, const int lo, const int hi, const int G, const int bx, const int NGW) {
    constexpr int l = L, pb = 2 + 9 * L; constexpr bool lastl = (L == DEPTH - 1);
        _Pragma("unroll 1") for (int rep = 0; rep < REPS(2); ++rep) {
        if (INL(0)) {
            PIN_WS();
            pg8::Gemm g{HA, WIN + (size_t)l * PROJ * D, RT, PROJ, D}; pg8::StaticOrder S; S.init(RT, PROJ, G, bx);
            EpiInProj E{QB, KB, VB, UB, GVB, ROPEC, ROPES};
            pg8::gemm_phase<EpiInProj, pg8::StaticOrder>(ldsl, g, S, E);
            if (G == 256 && bx >= 80) { PIN_IDS2(); convert_range(ptab, ws, ldsl, l, CV_P, CV_Q, (bx - 80) * NWAVES + wave, (G - 80) * NWAVES, wave, lane); }
        }
        SEAM(pb + 0); }
        _Pragma("unroll 1") for (int rep = 0; rep < REPS(3); ++rep) {
        if (INL(1)) {
            PIN_IDS();
            const float lam = LAMV[l], osc = 1.0f - kLamInit[l];
            const float* subg = INP(I_SUBG) + l * 128;
            constexpr int NU_LAT = NB * 4 * 16, NU_CTX = NB * 4, NU_SGU = NB * 34;
            const int vcu = (G % 8 == 0) ? (bx % 8) * (G / 8) + bx / 8 : bx;
            unsigned* qA = (unsigned*)(ws + WS_CTL + CTL_QUEUE + (l * 2 + 0) * 64); unsigned* qB = (unsigned*)(ws + WS_CTL + CTL_QUEUE + (l * 2 + 1) * 64);
            volatile LAS unsigned* qslot = (volatile LAS unsigned*)(ldsl + LDS_MISC + 16);
            bool dyn = false;
            for (int u = vcu;;) {
                if (!dyn && u >= NU_LAT) dyn = true;
                if (dyn) { if (lastl) break;
                    const int it = queue_pull(qA, qslot, tid); if (it >= NU_CTX) break; u = NU_LAT + it; }
                {
                    int b, h; long rq0; int nk;
                    if (u < NU_LAT) { b = u >> 6; h = (u >> 4) & 3; rq0 = (long)b * RPB + CTXL + (u & 15) * 256; nk = RPB; }
                    else { const int v2 = u - NU_LAT; b = v2 >> 2; h = v2 & 3; rq0 = (long)b * RPB; nk = CTXL; }
#ifndef NO_ATT
                    att::attn_unit(QB, KB, VB, OS, CAT, subg, lam, osc, h, rq0, (long)b * RPB, nk, (char*)lds);
#endif
                }
                if (!dyn) u += G;
            }
            {
            int tid2 = threadIdx.x; asm volatile("" : "+v"(tid2)); const int lane = tid2 & 63, wave = __builtin_amdgcn_readfirstlane(tid2 >> 6);
            constexpr int NHU = NU_SGU * 2;
            for (;;) { const int s = queue_pull(qB, qslot, tid2); if (s >= NHU) break;
                const int b = s / 68, rem = s % 68, ch = rem >> 1, hg = rem & 1;
                if (lastl && ch < 2) continue;
                {
#ifndef NO_SGU
                    const int hl2 = wave & 3, ph = wave >> 2, h = hg * 4 + hl2;
                    const size_t r0 = (size_t)b * RPB + ch * 128;
                    const int fr = lane & 15, fq = lane >> 4;
                    const bf16_t* Wh = SGUW + ((size_t)l * 8 + h) * 128 * 128;
                    const float* bs = INP(I_SGUB) + (l * 8 + h) * 128;
                    u32x4 uu[4][2]; bf16x8 afA[4], afB[4];
#pragma unroll
                    for (int i = 0; i < 4; ++i)
#pragma unroll
                        for (int gi = 0; gi < 2; ++gi) uu[i][gi] = *(const u32x4*)(UB + (r0 + (ph * 4 + i) * 16 + fr) * 512 + h * 64 + gi * 32 + fq * 8);
#pragma unroll
                    for (int ks = 0; ks < 4; ++ks) { afA[ks] = *(const bf16x8*)(Wh + (size_t)(ph * 64 + fr) * 128 + ks * 32 + fq * 8); afB[ks] = *(const bf16x8*)(Wh + (size_t)(ph * 64 + 16 + fr) * 128 + ks * 32 + fq * 8); }
                    {
                        const int hf = lane >> 5, l32 = lane & 31, hl = l32 >> 3, e8 = (l32 & 7) * 8;
                        const bf16_t* gsrc = GVB + (r0 + wave * 16 + hf * 8) * 512 + hg * 256 + l32 * 8;
                        const f32x4 ga = *(const f32x4*)(INP(I_SGUNG) + l * 512 + hg * 256 + l32 * 8), gb = *(const f32x4*)(INP(I_SGUNG) + l * 512 + hg * 256 + l32 * 8 + 4);
                        const float gg[8] = {ga.x, ga.y, ga.z, ga.w, gb.x, gb.y, gb.z, gb.w};
                        LAS bf16_t* gTh = (LAS bf16_t*)(ldsl + hl * 17424);
                        int slot[8];
#pragma unroll
                        for (int j = 0; j < 8; ++j) { const int e = e8 + j; slot[j] = ((e & 32) + 16 * ((e >> 2) & 1) + 4 * ((e & 31) >> 3) + (e & 3)) * 136; }
                        u32x4 raw[8];
#pragma unroll
                        for (int t = 0; t < 8; ++t) raw[t] = *(const u32x4*)(gsrc + t * 512);
#pragma unroll
                        for (int tb = 0; tb < 2; ++tb) {
                            float xn[4][8];
#pragma unroll
                            for (int t = 0; t < 4; ++t) {
                                float ssq = 0.f;
#pragma unroll
                                for (int k = 0; k < 4; ++k) { xn[t][2 * k] = bf2f(raw[tb * 4 + t][k] & 0xffffu); xn[t][2 * k + 1] = bf2f(raw[tb * 4 + t][k] >> 16); ssq += xn[t][2 * k] * xn[t][2 * k] + xn[t][2 * k + 1] * xn[t][2 * k + 1]; }
                                ssq += __shfl_xor(ssq, 1); ssq += __shfl_xor(ssq, 2); ssq += __shfl_xor(ssq, 4);
                                const float rs = __builtin_amdgcn_rsqf(ssq * (1.0f / 64.0f) + EPS);
#pragma unroll
                                for (int j = 0; j < 8; ++j) xn[t][j] = xn[t][j] * rs * gg[j];
                            }
                            const int q0 = wave * 16 + hf * 8 + tb * 4;
#pragma unroll
                            for (int j = 0; j < 8; ++j) { u32x2 w; w.x = pk2(xn[0][j], xn[1][j]); w.y = pk2(xn[2][j], xn[3][j]); *(LAS u32x2*)(gTh + slot[j] + q0) = w; }
                        }
                    }
                    __syncthreads();
                    {
                        LAS bf16_t* gT = (LAS bf16_t*)(ldsl + hl2 * 17424);
#pragma unroll
                        for (int i = 0; i < 4; ++i) {
                            const int p = (ph * 4 + i) * 16 + fr;
                            bf16x8 af[4];
#pragma unroll
                            for (int ks = 0; ks < 4; ++ks) af[ks] = (i & 1) ? afB[ks] : afA[ks];
                            if (i + 2 < 4) {
#pragma unroll
                                for (int ks = 0; ks < 4; ++ks) { const bf16x8 nv = *(const bf16x8*)(Wh + (size_t)(p + 32) * 128 + ks * 32 + fq * 8); if (i & 1) afB[ks] = nv; else afA[ks] = nv; } }
                            const float bsp = bs[p];
#pragma unroll
                            for (int gi = 0; gi < 2; ++gi) {
                                pg8::f32x4 a0 = (pg8::f32x4){0.f, 0.f, 0.f, 0.f}, a1 = (pg8::f32x4){0.f, 0.f, 0.f, 0.f};
#pragma unroll
                                for (int ks = 0; ks < 4; ++ks) {
                                    const bf16x8 b0 = *(const LAS bf16x8*)(gT + (gi * 32 + fr) * 136 + ks * 32 + fq * 8), b1 = *(const LAS bf16x8*)(gT + (gi * 32 + 16 + fr) * 136 + ks * 32 + fq * 8);
                                    a0 = __builtin_amdgcn_mfma_f32_16x16x32_bf16(b0, af[ks], a0, 0, 0, 0); a1 = __builtin_amdgcn_mfma_f32_16x16x32_bf16(b1, af[ks], a1, 0, 0, 0); }
                                const u32x4 ur = uu[i][gi];
                                u32x4 w;
                                w.x = pk2(bf2f(ur.x & 0xffffu) * (a0[0] + bsp), bf2f(ur.x >> 16) * (a0[1] + bsp)); w.y = pk2(bf2f(ur.y & 0xffffu) * (a0[2] + bsp), bf2f(ur.y >> 16) * (a0[3] + bsp));
                                w.z = pk2(bf2f(ur.z & 0xffffu) * (a1[0] + bsp), bf2f(ur.z >> 16) * (a1[1] + bsp)); w.w = pk2(bf2f(ur.w & 0xffffu) * (a1[2] + bsp), bf2f(ur.w >> 16) * (a1[3] + bsp));
                                *(u32x4*)(CAT + (r0 + p) * 1024 + 512 + h * 64 + gi * 32 + fq * 8) = w;
                            }
                            asm volatile("" ::: "memory");
                        }
                    }
                    LDS_WAIT(); asm volatile("" ::: "memory");
                    __syncthreads();
#endif
                }
            }
            }
        }
        SEAM(pb + 1); }
        _Pragma("unroll 1") for (int rep = 0; rep < REPS(4); ++rep) {
        if (INL(2)) {
            PIN_WS();
            pg8::Gemm g{CAT, WOUT + (size_t)l * D * D, RT, D, D}; pg8::GroupedOrder S; S.init(NB, lastl ? 16 : 17, 17, lastl ? 1 : 0, D / 256, 0, G, bx);
            EpiOutProj E{XR, modl, rep == 0 ? 1.0f : 0.0f};
            pg8::gemm_phase<EpiOutProj, pg8::GroupedOrder>(ldsl, g, S, E);
            if (G == 256 && bx >= 32) { PIN_IDS2(); convert_range(ptab, ws, ldsl, l, CV_Q, IT_L, (bx - 32) * NWAVES + wave, (G - 32) * NWAVES, wave, lane); }
        }
        SEAM(pb + 2); }
        _Pragma("unroll 1") for (int rep = 0; rep < REPS(5); ++rep) {
        if (INL(3)) {
            PIN_IDS();
            constexpr int WSTR = 1028;
            LAS float* wT = (LAS float*)ldsl;
            { const f32x4* wsrc = (const f32x4*)(INP(I_WR) + (size_t)l * 1024 * 16); f32x4 wv[8];
#pragma unroll
              for (int t = 0; t < 8; ++t) wv[t] = wsrc[tid + NTHR * t];
#pragma unroll
              for (int t = 0; t < 8; ++t) { const int i4 = tid + NTHR * t, k = i4 >> 2, e0 = (i4 & 3) * 4;
                  wT[(e0 + 0) * WSTR + k] = wv[t].x; wT[(e0 + 1) * WSTR + k] = wv[t].y; wT[(e0 + 2) * WSTR + k] = wv[t].z; wT[(e0 + 3) * WSTR + k] = wv[t].w; } }
            LAS float* modA = (LAS float*)(ldsl + 16 * WSTR * 4);
            LAS float* modS = modA + 9 * 1024;
            for (int i = tid; i < 9 * 256; i += NTHR) { const int c = i >> 8, k4 = i & 255;
                const float* mm = modl + (size_t)c * 6144; const f32x4 gg = ((const f32x4*)(INP(I_N2G) + l * D))[k4], ss = ((const f32x4*)(mm + 3 * D))[k4], cc = ((const f32x4*)(mm + 4 * D))[k4];
                *(LAS f32x4*)(modA + c * 1024 + k4 * 4) = gg * (1.0f + cc); *(LAS f32x4*)(modS + c * 1024 + k4 * 4) = ss; }
            __syncthreads();
            {
            constexpr int NG16 = RT / 16;
            const int r16 = lane & 15, kq = lane >> 4;
            const bool spread = (NGW == 2048);
#pragma unroll 1
            for (int pass = 0;; ++pass) {
                int grp;
                if (spread) { if (pass == 0) grp = gw; else if (pass == 1 && (gw & 15) == 0) grp = 2048 + (gw >> 4); else break; }
                else { grp = gw + pass * NGW; }
                if (grp >= NG16) break;
                const int row0 = grp * 16, b = row0 / RPB, j0 = row0 % RPB;
                if (lastl && j0 < CTXL) continue;
                const int mrow = (j0 < CTXL) ? 8 : b;
                const int row = row0 + r16;
                const u32x4* src = (const u32x4*)(XR + (size_t)row * D + 8 * kq);
                u32x4 raw[32];
#pragma unroll
                for (int t = 0; t < 32; ++t) raw[t] = src[4 * t];
                float ssq = 0.f;
#pragma unroll
                for (int t = 0; t < 32; ++t)
#pragma unroll
                    for (int c = 0; c < 4; ++c) { float lo_, hi_;
                        asm volatile("v_lshlrev_b32 %1, 16, %3\n\tv_and_b32 %2, 0xffff0000, %3\n\tv_fmac_f32 %0, %1, %1\n\tv_fmac_f32 %0, %2, %2" : "+v"(ssq), "=&v"(lo_), "=&v"(hi_) : "v"(raw[t][c])); }
                ssq = xrow16_sum(ssq);
                const float rstd = __builtin_amdgcn_rsqf(ssq * (1.0f / D) + EPS);
                const LAS float* Ac = modA + mrow * 1024 + 8 * kq; const LAS float* Sc = modS + mrow * 1024 + 8 * kq; const LAS float* Wc = wT + r16 * WSTR + 8 * kq;
                u32x4* dst = (u32x4*)(HA + (size_t)row * D + 8 * kq);
                pg8::f32x4 acc0 = (pg8::f32x4){0.f, 0.f, 0.f, 0.f}, acc1 = (pg8::f32x4){0.f, 0.f, 0.f, 0.f};
#pragma unroll
                for (int t = 0; t < 32; ++t) {
                    const f32x4 a0 = *(const LAS f32x4*)(Ac + 32 * t), a1 = *(const LAS f32x4*)(Ac + 32 * t + 4), s0 = *(const LAS f32x4*)(Sc + 32 * t), s1 = *(const LAS f32x4*)(Sc + 32 * t + 4);
                    const f32x4 w0 = *(const LAS f32x4*)(Wc + 32 * t), w1 = *(const LAS f32x4*)(Wc + 32 * t + 4);
                    const u32x4 rw = raw[t];
                    f32x4 h0 = (f32x4){bf2f(rw.x & 0xffffu), bf2f(rw.x >> 16), bf2f(rw.y & 0xffffu), bf2f(rw.y >> 16)}, h1 = (f32x4){bf2f(rw.z & 0xffffu), bf2f(rw.z >> 16), bf2f(rw.w & 0xffffu), bf2f(rw.w >> 16)};
                    h0 = (h0 * rstd) * a0 + s0; h1 = (h1 * rstd) * a1 + s1;
                    u32x4 o; o.x = pk2(h0.x, h0.y); o.y = pk2(h0.z, h0.w); o.z = pk2(h1.x, h1.y); o.w = pk2(h1.z, h1.w);
                    dst[4 * t] = o;
                    acc0 = __builtin_amdgcn_mfma_f32_16x16x4f32(w0.x, h0.x, acc0, 0, 0, 0); acc1 = __builtin_amdgcn_mfma_f32_16x16x4f32(w0.y, h0.y, acc1, 0, 0, 0);
                    acc0 = __builtin_amdgcn_mfma_f32_16x16x4f32(w0.z, h0.z, acc0, 0, 0, 0); acc1 = __builtin_amdgcn_mfma_f32_16x16x4f32(w0.w, h0.w, acc1, 0, 0, 0);
                    acc0 = __builtin_amdgcn_mfma_f32_16x16x4f32(w1.x, h1.x, acc0, 0, 0, 0); acc1 = __builtin_amdgcn_mfma_f32_16x16x4f32(w1.y, h1.y, acc1, 0, 0, 0);
                    acc0 = __builtin_amdgcn_mfma_f32_16x16x4f32(w1.z, h1.z, acc0, 0, 0, 0); acc1 = __builtin_amdgcn_mfma_f32_16x16x4f32(w1.w, h1.w, acc1, 0, 0, 0);
                    asm volatile("" ::: "memory");
                }
                const pg8::f32x4 lg = acc0 + acc1;
                float mx = fmaxf(fmaxf(lg[0], lg[1]), fmaxf(lg[2], lg[3])); mx = xrow16_max(mx);
                f32x4 ex; ex.x = expf(lg[0] - mx); ex.y = expf(lg[1] - mx); ex.z = expf(lg[2] - mx); ex.w = expf(lg[3] - mx);
                float sm = (ex.x + ex.y) + (ex.z + ex.w); sm = xrow16_sum(sm);
                const float inv = 1.0f / sm;
                *(f32x4*)(AFF + (size_t)row * 16 + 4 * kq) = ex * inv;
            }
            }
            __syncthreads();
        }
        SEAM(pb + 3); }
        _Pragma("unroll 1") for (int rep = 0; rep < REPS(6); ++rep) {
        if (INL(4)) {
            PIN_IDS();
            LAS unsigned* keys = (LAS unsigned*)ldsl;
            LAS unsigned* hist = keys + 4096;
            LAS unsigned* wtot = hist + 256;
            LAS unsigned* sel = wtot + 8;
            for (int gq = bx; gq < (lastl ? 128 : 256); gq += G) {
                const int stream = gq >> 7, b = (gq >> 4) & 7, e = gq & 15;
                const int n = stream ? CTXL : SEQ, cap = stream ? CAP_C : CAP_L;
                const int row0 = b * RPB + (stream ? 0 : CTXL), sbase = stream ? NB * CAP_L + b * CAP_C : b * CAP_L;
                { unsigned kv8[8];
#pragma unroll
                  for (int t = 0; t < 8; ++t) { const int i = tid + NTHR * t; kv8[t] = (i < n) ? __float_as_uint(AFF[(size_t)(row0 + i) * 16 + e]) : 0u; }
#pragma unroll
                  for (int t = 0; t < 8; ++t) { const int i = tid + NTHR * t; if (i < n) keys[i] = kv8[t]; } }
                unsigned prefix = 0u, mask = 0u, kk = (unsigned)cap;
                for (int pass = 0; pass < 4; ++pass) {
                    const int shift = 24 - 8 * pass;
                    if (tid < 256) hist[tid] = 0u;
                    __syncthreads();
                    for (int i = tid; i < n; i += NTHR) { const unsigned kv = keys[i]; if ((kv & mask) == prefix) __hip_atomic_fetch_add(&hist[(kv >> shift) & 255u], 1u, __ATOMIC_RELAXED, __HIP_MEMORY_SCOPE_WORKGROUP); }
                    __syncthreads();
                    if (wave == 0) {
                        const unsigned c0 = hist[4 * lane], c1 = hist[4 * lane + 1], c2 = hist[4 * lane + 2], c3 = hist[4 * lane + 3], tot = (c0 + c1) + (c2 + c3);
                        unsigned inc = tot;
#pragma unroll
                        for (int o = 1; o < 64; o <<= 1) { const unsigned t = __shfl_down(inc, o); if (lane + o < 64) inc += t; }
                        const unsigned excl = inc - tot;
                        if (excl < kk && excl + tot >= kk) { unsigned run = excl, dsel, knew;
                            if (run + c3 >= kk) { dsel = 4u * lane + 3u; knew = kk - run; }
                            else { run += c3; if (run + c2 >= kk) { dsel = 4u * lane + 2u; knew = kk - run; }
                                else { run += c2; if (run + c1 >= kk) { dsel = 4u * lane + 1u; knew = kk - run; } else { run += c1; dsel = 4u * lane; knew = kk - run; } } }
                            sel[0] = dsel; sel[1] = knew; } }
                    __syncthreads();
                    prefix |= sel[0] << shift; mask |= 0xFFu << shift; kk = sel[1];
                    __syncthreads();
                }
                const int chunk = (n >= NTHR) ? n / NTHR : 1, i0 = tid * chunk; const bool active = i0 < n;
                unsigned cg = 0u, ce = 0u;
                if (active) for (int i = 0; i < chunk; ++i) { const unsigned kv = keys[i0 + i]; cg += kv > prefix; ce += kv == prefix; }
                unsigned pk = cg | (ce << 16), incl = pk;
#pragma unroll
                for (int o = 1; o < 64; o <<= 1) { const unsigned t = __shfl_up(incl, o); if (lane >= o) incl += t; }
                if (lane == 63) wtot[wave] = incl;
                __syncthreads();
                unsigned wbase = 0u;
                for (int w = 0; w < wave; ++w) wbase += wtot[w];
                unsigned excl = wbase + incl - pk; unsigned ng = excl & 0xffffu, ne = excl >> 16;
                if (active) for (int i = 0; i < chunk; ++i) { const unsigned kv = keys[i0 + i]; const int row = row0 + i0 + i;
                    const bool isg = kv > prefix, ise = kv == prefix; const bool take = isg || (ise && ne < kk);
                    const unsigned slot = ng + (ne < kk ? ne : kk);
                    if (take) { RSRC[(size_t)e * ER + sbase + slot] = row; INV[(size_t)row * 16 + e] = sbase + (int)slot; } else INV[(size_t)row * 16 + e] = -1;
                    ng += isg; ne += ise; }
                __syncthreads();
            }
        }
        SEAM(pb + 4); }
        _Pragma("unroll 1") for (int rep = 0; rep < REPS(8); ++rep) {
        if (INL(6)) {
            PIN_WS();
            pg8::Gemm g{HA, WGU + (size_t)l * NE * 2 * FF * D, NE * ER, NE * 2 * FF, D}; pg8::GroupedOrder S; S.init(NE, lastl ? 16 : 17, 17, 0, 2 * FF / 256, 2 * FF / 256, G, bx);
            EpiGateUp E{HID};
            pg8::gemm_phase_gather<EpiGateUp, pg8::GroupedOrder, 17>(ldsl, g, S, E, RSRC, (LAS unsigned short*)(ldsl + pg8::STAGE_BYTES));
        }
        SEAM(pb + 6); }
        _Pragma("unroll 1") for (int rep = 0; rep < REPS(9); ++rep) {
        if (INL(7)) {
            PIN_WS();
            pg8::Gemm g{HID, WD + (size_t)l * NE * D * FF, NE * ER, NE * D, FF}; pg8::GroupedOrder S; S.init(NE, lastl ? 16 : 17, 17, 0, D / 256, D / 256, G, bx);
            EpiDown E{Y};
            pg8::gemm_phase<EpiDown, pg8::GroupedOrder>(ldsl, g, S, E);
            if (!lastl && G == 256 && bx >= 64) { PIN_IDS2(); convert_range(ptab, ws, ldsl, l + 1, 0, CV_P, (bx - 64) * NWAVES + wave, (G - 64) * NWAVES, wave, lane); }
        }
        SEAM(pb + 7); }
        _Pragma("unroll 1") for (int rep = 0; rep < REPS(10); ++rep) {
        if (INL(8)) {
            PIN_IDS();
            const float g2s = (rep == 0 || lastl) ? 1.0f : 0.0f;
            f32x4 mA[4], mSH[4], mG2[4]; int curm = -1;
#pragma unroll 1
            for (int wslot = gw; wslot < RT / 17; wslot += NGW) { const int wrow0 = wslot * 17;
#pragma unroll 1
            for (int it = 0; it < 9; ++it) {
                const int kL = (lane >> 4) & 1; const int idxL = it * 2 + kL; const int rowL = wrow0 + (idxL < 17 ? idxL : 16);
                int myinv = INV[(size_t)rowL * 16 + (lane & 15)]; const float myaff = AFF[(size_t)rowL * 16 + (lane & 15)];
                if (idxL >= 17 || (lastl && (rowL % RPB) < CTXL)) myinv = -1;
                f32x4 v[2][4];
#pragma unroll
                for (int k = 0; k < 2; ++k) { const int idx = it * 2 + k; const int row = wrow0 + (idx < 17 ? idx : 16); row_load_bf(XR + (size_t)row * D, lane, v[k]); }
                const unsigned long long sel = __ballot(myinv >= 0);
                u32x2 y0[2][4], y1[2][4]; float g0[2], g1[2]; unsigned rest[2];
#pragma unroll
                for (int k = 0; k < 2; ++k) {
                    unsigned mk = (unsigned)(sel >> (16 * k)) & 0xffffu; g0[k] = 0.f; g1[k] = 0.f;
#pragma unroll
                    for (int jj = 0; jj < 4; ++jj) { y0[k][jj] = (u32x2){0u, 0u}; y1[k][jj] = (u32x2){0u, 0u}; }
                    if (mk) { const int e = __builtin_ctz(mk); mk &= mk - 1; const int slot = __builtin_amdgcn_readlane(myinv, 16 * k + e); g0[k] = __builtin_bit_cast(float, __builtin_amdgcn_readlane(__builtin_bit_cast(int, myaff), 16 * k + e));
                        const u32x2* yp = (const u32x2*)(Y + ((size_t)e * ER + slot) * D) + lane;
#pragma unroll
                        for (int jj = 0; jj < 4; ++jj) y0[k][jj] = yp[64 * jj]; }
                    if (mk) { const int e = __builtin_ctz(mk); mk &= mk - 1; const int slot = __builtin_amdgcn_readlane(myinv, 16 * k + e); g1[k] = __builtin_bit_cast(float, __builtin_amdgcn_readlane(__builtin_bit_cast(int, myaff), 16 * k + e));
                        const u32x2* yp = (const u32x2*)(Y + ((size_t)e * ER + slot) * D) + lane;
#pragma unroll
                        for (int jj = 0; jj < 4; ++jj) y1[k][jj] = yp[64 * jj]; }
                    rest[k] = mk;
                }
#pragma unroll
                for (int k = 0; k < 2; ++k) {
                    const int idx = it * 2 + k; if (idx >= 17) continue; const int row = wrow0 + idx;
                    const int b = row / RPB, j = row % RPB; const bool isctx = j < CTXL;
                    if (lastl && isctx) continue;
                    const int mrow = isctx ? 8 : b;
                    if (mrow != curm) { curm = mrow; const float* m = modl + (size_t)mrow * 6144;
#pragma unroll
                        for (int jj = 0; jj < 4; ++jj) mG2[jj] = ((const f32x4*)(m + 5 * D))[lane + 64 * jj] * g2s;
                        if (!lastl) { const float* m2 = MOD + (size_t)(l + 1) * 9 * 6144 + (size_t)mrow * 6144; load_mod(INP(I_N1G) + (l + 1) * D, m2 + 0 * D, m2 + 1 * D, lane, mA, mSH); }
                        else {
#pragma unroll
                            for (int jj = 0; jj < 4; ++jj) mA[jj] = ((const f32x4*)INP(I_NFG))[lane + 64 * jj]; } }
                    f32x4 a[4];
#pragma unroll
                    for (int jj = 0; jj < 4; ++jj) {
                        a[jj].x = g0[k] * bf2f(y0[k][jj].x & 0xffffu) + g1[k] * bf2f(y1[k][jj].x & 0xffffu); a[jj].y = g0[k] * bf2f(y0[k][jj].x >> 16) + g1[k] * bf2f(y1[k][jj].x >> 16);
                        a[jj].z = g0[k] * bf2f(y0[k][jj].y & 0xffffu) + g1[k] * bf2f(y1[k][jj].y & 0xffffu); a[jj].w = g0[k] * bf2f(y0[k][jj].y >> 16) + g1[k] * bf2f(y1[k][jj].y >> 16); }
                    unsigned mk = rest[k];
#pragma unroll 1
                    while (mk) { const int e = __builtin_ctz(mk); mk &= mk - 1; const int slot = __builtin_amdgcn_readlane(myinv, 16 * k + e); const float ga = __builtin_bit_cast(float, __builtin_amdgcn_readlane(__builtin_bit_cast(int, myaff), 16 * k + e));
                        const u32x2* yp = (const u32x2*)(Y + ((size_t)e * ER + slot) * D) + lane;
#pragma unroll
                        for (int jj = 0; jj < 4; ++jj) { const u32x2 yy = yp[64 * jj];
                            a[jj].x += ga * bf2f(yy.x & 0xffffu); a[jj].y += ga * bf2f(yy.x >> 16); a[jj].z += ga * bf2f(yy.y & 0xffffu); a[jj].w += ga * bf2f(yy.y >> 16); } }
#pragma unroll
                    for (int jj = 0; jj < 4; ++jj) v[k][jj] = v[k][jj] + mG2[jj] * a[jj];
                    if (!lastl) {
                        row_store_bf(XR + (size_t)row * D, lane, v[k]);
                        norm_mod2(v[k], mA, mSH, HA + (size_t)row * D, lane);
                    } else {
                        const float rstd = row_rstd(v[k]);
                        float* orow = (float*)(GAS1 float*)lds_ptr(ptab, 23) + ((size_t)b * SEQ + (j - CTXL)) * D;
#pragma unroll
                        for (int jj = 0; jj < 4; ++jj) ((f32x4*)orow)[lane + 64 * jj] = (v[k][jj] * rstd) * mA[jj];
                    }
                }
            } }
        }
        if (!lastl) SEAM(pb + 8); }
    }

__global__ void __launch_bounds__(NTHR, 2) fwd(Args args) {
    extern __shared__ __attribute__((aligned(16))) unsigned char lds[];
    LAS unsigned char* ldsl = (LAS unsigned char*)lds;
    const int tid0 = threadIdx.x;
    const int G = gridDim.x, bx = blockIdx.x, NGW = G * NWAVES;
    LAS unsigned long long* ptab = (LAS unsigned long long*)(ldsl + LDS_MISC + 32);
    if (tid0 < 8) ((LAS unsigned*)(ldsl + LDS_MISC))[tid0] = 0u;
    if (tid0 < 25) ptab[tid0] = (tid0 < 23) ? (unsigned long long)args.in[tid0] : (tid0 == 23) ? (unsigned long long)args.out : (unsigned long long)args.ws;
    __syncthreads();
    XcdBarrier bar = xcd_barrier_post((unsigned*)(args.ws + WS_CTL), (volatile LAS unsigned*)(ldsl + LDS_MISC));
    const int lo = args.ph_lo, hi = args.ph_hi;

    _Pragma("unroll 1") for (int rep = 0; rep < REPS(0); ++rep) {
    if (IN(0)) {
            PIN_IDS();
        {
            LAS float* svec = (LAS float*)ldsl;
            LAS float* part = (LAS float*)(ldsl + 9 * 1024 * 4);
            bool have = false;
            for (int u = bx; u < DEPTH * 48; u += G) {
                if (!have) {
                    for (int i = tid; i < 9 * 1024; i += NTHR) { const int r = i >> 10, k = i & 1023; const float x = (r < 8) ? INP(I_C)[r * 1024 + k] : INP(I_CCTX)[k]; svec[i] = x / (1.0f + __expf(-x)); }
                    have = true; __syncthreads();
                }
                const int l = u / 48, j0 = (u % 48) * 128, c4 = tid & 31, kg = tid >> 5;
                const float* w = INP(I_WADA) + (size_t)l * 1024 * 6144 + j0 + 4 * c4;
                f32x4 a[9];
#pragma unroll
                for (int r = 0; r < 9; ++r) a[r] = (f32x4){0.f, 0.f, 0.f, 0.f};
#pragma unroll 2
                for (int k = kg * 64; k < kg * 64 + 64; k += 4) {
                    f32x4 wv[4];
#pragma unroll
                    for (int i = 0; i < 4; ++i) wv[i] = *(const f32x4*)(w + (size_t)(k + i) * 6144);
#pragma unroll
                    for (int r = 0; r < 9; ++r) { const f32x4 sv = *(const LAS f32x4*)(svec + r * 1024 + k);
                        a[r] = a[r] + wv[0] * sv.x + wv[1] * sv.y + wv[2] * sv.z + wv[3] * sv.w; } }
#pragma unroll
                for (int r = 0; r < 9; ++r) *(LAS f32x4*)(part + (kg * 9 + r) * 128 + 4 * c4) = a[r];
                __syncthreads();
                for (int i = tid; i < 9 * 128; i += NTHR) { const int r = i >> 7, c2 = i & 127; float sum = INP(I_BADA)[l * 6144 + j0 + c2];
#pragma unroll
                    for (int g = 0; g < 16; ++g) sum += part[(g * 9 + r) * 128 + c2];
                    MOD[((size_t)l * 9 + r) * 6144 + j0 + c2] = sum; }
                __syncthreads();
            }
            __syncthreads();
        }
        if (bx == G - 1) {
            for (int i = tid; i < 64 * 16; i += NTHR) { const int pos = i >> 4, f = i & 15; double s, c; sincos_d((double)pos * kFreq[f], s, c); ROPEC[i] = (float)c; ROPES[i] = (float)s; }
            if (wave < DEPTH) { const int l = wave;
                const float d1 = wave_sum(INP(I_LQ1)[l * 64 + lane] * INP(I_LK1)[l * 64 + lane]), d2 = wave_sum(INP(I_LQ2)[l * 64 + lane] * INP(I_LK2)[l * 64 + lane]);
                if (lane == 0) LAMV[l] = expf(d1) - expf(d2) + kLamInit[l]; }
        }
        for (int i = bx * NTHR + tid; i < DEPTH * 8 * 128 * 128 / 4; i += G * NTHR) { const f32x4 v = ((const f32x4*)INP(I_SGUW))[i]; u32x2 w; w.x = pk2(v.x, v.y); w.y = pk2(v.z, v.w); ((u32x2*)SGUW)[i] = w; }
        convert_range(ptab, ws, ldsl, 0, 0, G == 256 ? CV_P : IT_L, gw, NGW, wave, lane);
        if (G != 256) {
#pragma unroll 1
            for (int l2 = 1; l2 < DEPTH; ++l2) convert_range(ptab, ws, ldsl, l2, 0, IT_L, gw, NGW, wave, lane); }
    }
    SEAM(0); }
    if (IN(1)) {
            PIN_IDS();
        f32x4 mA[4], mSH[4]; int curm = -1;
#pragma unroll 1
        for (int wslot = gw; wslot < RT / 17; wslot += NGW) { const int wrow0 = wslot * 17;
#pragma unroll 1
        for (int it = 0; it < 5; ++it) {
            f32x4 v[4][4];
#pragma unroll
            for (int k = 0; k < 4; ++k) { const int idx = it * 4 + k; const int row = wrow0 + (idx < 17 ? idx : 16); const int b = row / RPB, j = row % RPB;
                const float* src = (j < CTXL) ? INP(I_CTX) + ((size_t)b * CTXL + j) * D : INP(I_X) + ((size_t)b * SEQ + (j - CTXL)) * D; row_load(src, lane, v[k]); }
#pragma unroll
            for (int k = 0; k < 4; ++k) { const int idx = it * 4 + k; if (idx >= 17) continue; const int row = wrow0 + idx; const int b = row / RPB, j = row % RPB;
                row_store_bf(XR + (size_t)row * D, lane, v[k]);
                const int mrow = (j < CTXL) ? 8 : b;
                if (mrow != curm) { curm = mrow; const float* m = MOD + (size_t)mrow * 6144; load_mod(INP(I_N1G), m + 0 * D, m + 1 * D, lane, mA, mSH); }
                norm_mod2(v[k], mA, mSH, HA + (size_t)row * D, lane); }
        } }
    }
    SEAM(1);

    layer_body<0>(lds, ldsl, ptab, bar, lo, hi, G, bx, NGW);
    layer_body<1>(lds, ldsl, ptab, bar, lo, hi, G, bx, NGW);
    layer_body<2>(lds, ldsl, ptab, bar, lo, hi, G, bx, NGW);
    layer_body<3>(lds, ldsl, ptab, bar, lo, hi, G, bx, NGW);
}

#ifndef MK_LAUNCHES_PER_PHASE
#define MK_LAUNCHES_PER_PHASE 0
#endif
extern "C" void kernel_launch(void* const* d_in, const int* in_sizes, int n_in, void* d_out, int out_size, void* d_ws, size_t ws_size, hipStream_t stream) {
    static int grid = 0;
    if (grid == 0) {
        if (n_in != 23 || out_size != NB * SEQ * D || ws_size < WS_END) { fprintf(stderr, "kernel_launch: unexpected shapes: n_in %d out %d ws %zu (need %zu)\n", n_in, out_size, ws_size, (size_t)WS_END); grid = -1; return; }
        int dev = 0, cus = 0, per_cu = 0;
        if (hipGetDevice(&dev) != hipSuccess || hipDeviceGetAttribute(&cus, hipDeviceAttributeMultiprocessorCount, dev) != hipSuccess) { grid = -1; return; }
        if (hipFuncSetAttribute((const void*)fwd, hipFuncAttributeMaxDynamicSharedMemorySize, LDS_BYTES) != hipSuccess) { fprintf(stderr, "kernel_launch: hipFuncSetAttribute failed\n"); grid = -1; return; }
        if (hipOccupancyMaxActiveBlocksPerMultiprocessor(&per_cu, (const void*)fwd, NTHR, LDS_BYTES) != hipSuccess || per_cu < 1) { fprintf(stderr, "kernel_launch: occupancy query says %d blocks per CU\n", per_cu); }
        (void)hipGetLastError();
        grid = cus;
        if (grid > 256) grid = 256;
    }
    if (grid < 0) return;
    (void)hipMemsetAsync((char*)d_ws + WS_CTL, 0, CTL_BYTES, stream);
    Args a{};
    for (int i = 0; i < 23; ++i) a.in[i] = (const float*)d_in[i];
    a.out = (float*)d_out; a.ws = (unsigned char*)d_ws;
    constexpr int NPH = 2 + 9 * DEPTH;
#if MK_LAUNCHES_PER_PHASE
    for (int p = 0; p < NPH; ++p) { a.ph_lo = p; a.ph_hi = p + 1; hipLaunchKernelGGL(fwd, dim3(grid), dim3(NTHR), LDS_BYTES, stream, a); }
#else
    a.ph_lo = 0; a.ph_hi = NPH;
    hipLaunchKernelGGL(fwd, dim3(grid), dim3(NTHR), LDS_BYTES, stream, a);
#endif
    const hipError_t le = hipPeekAtLastError();
    if (le != hipSuccess) fprintf(stderr, "kernel_launch: launch failed: %s\n", hipGetErrorName(le));
}
```

```cpp
#include <hip/hip_runtime.h>
#include <cstdio>
#include <cstdint>
namespace pg8 {
#define PG8_LAS __attribute__((address_space(3)))
typedef unsigned short bf16_t;
typedef short bf16x8 __attribute__((ext_vector_type(8)));
typedef float f32x4 __attribute__((ext_vector_type(4)));
typedef float f32x2 __attribute__((ext_vector_type(2)));
typedef unsigned u32x4 __attribute__((ext_vector_type(4)));
typedef unsigned u32x2 __attribute__((ext_vector_type(2)));
constexpr int BM = 256, BK = 64, HALF = 128, HTB = HALF * BK * 2  , STAGE_BYTES = 8 * HTB, NXCD = 8, WGM = 8;

__host__ __device__ __forceinline__ int lds_byte(int r, int c) { const int st = (r >> 4) * 2 + (c >> 5), rr = r & 15, cc = c & 31, ob = rr * 64 + cc * 2; return st * 1024 + (ob ^ (((ob >> 9) & 1) << 5)); }
__host__ __device__ __forceinline__ void stage_rc(int b, int& R, int& C) { const int st = b / 1024, sb = b % 1024, swz = sb ^ (((sb >> 9) & 1) << 5); R = (st >> 1) * 16 + swz / 64; C = (st & 1) * 32 + (swz % 64) / 2; }
__host__ __device__ __forceinline__ int perm32(int rho) { const int n = rho >> 4, i = rho & 15; return 8 * (i >> 2) + 4 * n + (i & 3); }

struct Unit { int pm, pn; };
struct Gemm { const bf16_t* A; const bf16_t* Bt; int M, N, K; };

struct StaticOrder {
    int nM, nN, nwg, G, c;
    __host__ __device__ void init(int M, int N, int G_, int c_) { nM = M / BM; nN = N / BM; nwg = nM * nN; G = G_; c = c_; }
    __host__ __device__ bool next(int i, Unit& u) const {
        const long L = (long)i * G + c; if (L >= nwg) return false;
        int wgid = (int)L; { const int q = nwg / NXCD, r = nwg % NXCD, xcd = wgid % NXCD, off = wgid / NXCD; wgid = (xcd < r ? xcd * (q + 1) : r * (q + 1) + (xcd - r) * q) + off; }
        const int nig = WGM * nN, gid = wgid / nig, fm = gid * WGM, gsz = (nM - fm) < WGM ? (nM - fm) : WGM;
        u.pm = fm + ((wgid % nig) % gsz); u.pn = (wgid % nig) / gsz; return true;
    }
    __device__ __forceinline__ void a_ready(const Unit&) const {}
    __device__ __forceinline__ void done(const Unit&) const {}
};
struct GroupedOrder {
    int TM, TN, TMS, MOFF, BGS, nunits, G, c;
    __host__ __device__ void init(int NG, int TM_, int TMS_, int MOFF_, int TN_, int BGS_, int G_, int c_) { TM = TM_; TN = TN_; TMS = TMS_; MOFF = MOFF_; BGS = BGS_; nunits = NG * TM_ * TN_; G = G_; c = c_; }
    __host__ __device__ bool next(int i, Unit& u) const {
        const long L = (long)i * G + c; if (L >= nunits) return false;
        int wgid = (int)L; { const int q = nunits / NXCD, r = nunits % NXCD, xcd = wgid % NXCD, off = wgid / NXCD; wgid = (xcd < r ? xcd * (q + 1) : r * (q + 1) + (xcd - r) * q) + off; }
        const int per = TM * TN, e = wgid / per, w = wgid % per;
        const int nig = WGM * TN, gid = w / nig, fm = gid * WGM, gsz = (TM - fm) < WGM ? (TM - fm) : WGM;
        u.pm = e * TMS + MOFF + fm + ((w % nig) % gsz); u.pn = e * BGS + (w % nig) / gsz; return true;
    }
    __device__ __forceinline__ void a_ready(const Unit&) const {}
    __device__ __forceinline__ void done(const Unit&) const {}
};

__device__ __forceinline__ unsigned cvt_pk_bf16(float lo, float hi) { unsigned r; asm volatile("v_cvt_pk_bf16_f32 %0, %1, %2" : "=v"(r) : "v"(lo), "v"(hi)); return r; }
__device__ __forceinline__ f32x2 gelu_pk(f32x2 v) {
    f32x2 d; d.x = __builtin_fmaf(__builtin_fabsf(v.x), 0.2316418882f, 1.0f); d.y = __builtin_fmaf(__builtin_fabsf(v.y), 0.2316418882f, 1.0f);
    f32x2 t; t.x = __builtin_amdgcn_rcpf(d.x); t.y = __builtin_amdgcn_rcpf(d.y);
    f32x2 q = t * 0.5307027145f + (-0.7265760135f); q = q * t + 0.7107068705f; q = q * t + (-0.142248368f); q = q * t + 0.127414796f; q = q * t;
    const f32x2 s = (v * v) * (-0.72134752044f);
    f32x2 e; e.x = __builtin_amdgcn_exp2f(s.x); e.y = __builtin_amdgcn_exp2f(s.y);
    const f32x2 c = q * e;
    float rx, ry; asm("v_max_f32 %0, 0, %1" : "=v"(rx) : "v"(v.x)); asm("v_max_f32 %0, 0, %1" : "=v"(ry) : "v"(v.y));
    f32x2 o; o.x = __builtin_fmaf(-__builtin_fabsf(v.x), c.x, rx); o.y = __builtin_fmaf(-__builtin_fabsf(v.y), c.y, ry); return o;
}
__device__ __forceinline__ f32x4 gelu4(f32x4 v) { const f32x2 a = gelu_pk((f32x2){v[0], v[1]}), b = gelu_pk((f32x2){v[2], v[3]}); return (f32x4){a.x, a.y, b.x, b.y}; }

template <class Epi, class Sched, bool ALIGN_EPI = true, bool SP2 = true>
__device__ __forceinline__ void gemm_phase(PG8_LAS unsigned char* lds, const Gemm g, const Sched& S, const Epi& E) {
    int tid = threadIdx.x; asm volatile("" : "+v"(tid));
    const int wid = __builtin_amdgcn_readfirstlane(tid >> 6), lane = tid & 63, wr = wid >> 2, wc = wid & 3, fr = lane & 15, fq = lane >> 4;
    const int K = g.K, nt = K / BK;
    unsigned voffA[2], voffB[2];
#pragma unroll
    for (int i = 0; i < 2; ++i) { int R, C; stage_rc(tid * 16 + i * 8192, R, C); const int Rb = Epi::PERM ? ((R & ~31) + perm32(R & 31)) : R;
        voffA[i] = (unsigned)(R * K + C) * 2u; voffB[i] = (unsigned)(Rb * K + C) * 2u; }
    const size_t kstep = (size_t)(BK * 2);
    const size_t hstep = (size_t)HALF * K * 2;
    const size_t tstep = 2 * hstep;
    const unsigned ldsw = (unsigned)wid * 1024u;
    const int aoff = lds_byte(wr * 64 + fr, fq * 8), boff = lds_byte(wc * 32 + fr, fq * 8);
#define PG8_SA(b, h) (((b) * 2 + (h)) * HTB)
#define PG8_SB(b, h) ((4 + (b) * 2 + (h)) * HTB)
#define PG8_STAGE(bufoff, gbase, voff) do { _Pragma("unroll") for (int _i = 0; _i < 2; ++_i) \
        __builtin_amdgcn_global_load_lds((const unsigned*)((const char*)(gbase) + (voff)[_i]), (PG8_LAS unsigned*)(lds + (bufoff) + ldsw + _i * 8192), 16, 0, 0); } while (0)
#define PG8_LDA(dst, b, h) do { _Pragma("unroll") for (int m = 0; m < 4; ++m) _Pragma("unroll") for (int k = 0; k < 2; ++k) dst[m][k] = *(const PG8_LAS bf16x8*)(lds + PG8_SA(b, h) + aoff + m * 2048 + k * 1024); } while (0)
#define PG8_LDB(dst, b, h) do { _Pragma("unroll") for (int n = 0; n < 2; ++n) _Pragma("unroll") for (int k = 0; k < 2; ++k) dst[n][k] = *(const PG8_LAS bf16x8*)(lds + PG8_SB(b, h) + boff + n * 2048 + k * 1024); } while (0)
#define PG8_MMA(ai, bj, At, Bt) do { __builtin_amdgcn_s_setprio(1); _Pragma("unroll") for (int m = 0; m < 4; ++m) _Pragma("unroll") for (int n = 0; n < 2; ++n) _Pragma("unroll") for (int k = 0; k < 2; ++k) \
        acc[ai][bj][m][n] = __builtin_amdgcn_mfma_f32_16x16x32_bf16(Bt[n][k], At[m][k], acc[ai][bj][m][n], 0, 0, 0); __builtin_amdgcn_s_setprio(0); } while (0)
#define PG8_WAIT_V(n) asm volatile("s_waitcnt vmcnt(" #n ")" ::: "memory")
#define PG8_WAIT_L(n) asm volatile("s_waitcnt lgkmcnt(" #n ")" ::: "memory")
#define PG8_BAR __builtin_amdgcn_s_barrier()
#define PG8_SCHED __builtin_amdgcn_sched_barrier(0)
    Unit cur, nxt; int ui = 0;
    if (!S.next(0, cur)) return;
    f32x4 acc[2][2][4][2];
#pragma unroll
    for (int a = 0; a < 2; ++a)
#pragma unroll
        for (int b = 0; b < 2; ++b)
#pragma unroll
            for (int m = 0; m < 4; ++m)
#pragma unroll
                for (int n = 0; n < 2; ++n) acc[a][b][m][n] = (f32x4){0.f, 0.f, 0.f, 0.f};
    bf16x8 At[4][2], B0[2][2], B1[2][2];
    const char* cA = (const char*)g.A + (size_t)cur.pm * tstep; const char* cB = (const char*)g.Bt + (size_t)cur.pn * tstep;
    S.a_ready(cur);
    if constexpr (SP2) {
        PG8_STAGE(PG8_SB(0, 0), cB, voffB); PG8_STAGE(PG8_SB(0, 1), cB + hstep, voffB); PG8_STAGE(PG8_SA(0, 0), cA, voffA); PG8_STAGE(PG8_SA(0, 1), cA + hstep, voffA);
        if (wr == 1) PG8_BAR;
        PG8_WAIT_V(2); PG8_BAR;
        PG8_STAGE(PG8_SB(1, 0), cB + kstep, voffB); PG8_STAGE(PG8_SA(1, 0), cA + kstep, voffA); PG8_STAGE(PG8_SB(1, 1), cB + hstep + kstep, voffB);
        PG8_WAIT_V(6); PG8_BAR;
    } else {
        PG8_STAGE(PG8_SB(0, 0), cB, voffB); PG8_STAGE(PG8_SA(0, 0), cA, voffA); PG8_STAGE(PG8_SB(0, 1), cB + hstep, voffB); PG8_STAGE(PG8_SA(0, 1), cA + hstep, voffA);
        if (wr == 1) PG8_BAR;
        PG8_WAIT_V(4); PG8_BAR;
        PG8_STAGE(PG8_SB(1, 0), cB + kstep, voffB); PG8_STAGE(PG8_SA(1, 0), cA + kstep, voffA); PG8_STAGE(PG8_SB(1, 1), cB + hstep + kstep, voffB);
        PG8_WAIT_V(6); PG8_BAR;
    }
    for (;;) {
        const bool has_next = S.next(ui + 1, nxt);
        const char* nA = has_next ? (const char*)g.A + (size_t)nxt.pm * tstep : cA; const char* nB = has_next ? (const char*)g.Bt + (size_t)nxt.pn * tstep : cB;
        for (int t = 0; t < nt; t += 2) {
            const bool last = (t == nt - 2);
            const char* a1 = cA + (size_t)(t + 1) * kstep;
            const char* a2 = last ? nA : cA + (size_t)(t + 2) * kstep; const char* b2 = last ? nB : cB + (size_t)(t + 2) * kstep;
            const char* a3 = a2 + kstep; const char* b3 = b2 + kstep;
            if (last && has_next) S.a_ready(nxt);
            if constexpr (SP2) {
            PG8_LDB(B0, 0, 0); PG8_LDB(B1, 0, 1); PG8_SCHED; PG8_LDA(At, 0, 0); PG8_STAGE(PG8_SA(1, 1), a1 + hstep, voffA);
            PG8_WAIT_V(8); PG8_WAIT_L(0); PG8_BAR; PG8_MMA(0, 0, At, B0); PG8_MMA(0, 1, At, B1); PG8_BAR; PG8_SCHED;
            PG8_LDA(At, 0, 1); PG8_STAGE(PG8_SB(0, 0), b2, voffB); PG8_STAGE(PG8_SB(0, 1), b2 + hstep, voffB); PG8_STAGE(PG8_SA(0, 0), a2, voffA);
            PG8_WAIT_V(8); PG8_WAIT_L(0); PG8_BAR; PG8_MMA(1, 0, At, B0); PG8_MMA(1, 1, At, B1); PG8_BAR; PG8_SCHED;
            PG8_LDB(B0, 1, 0); PG8_LDB(B1, 1, 1); PG8_SCHED; PG8_LDA(At, 1, 0); PG8_STAGE(PG8_SA(0, 1), a2 + hstep, voffA);
            PG8_WAIT_V(8); PG8_WAIT_L(0); PG8_BAR; PG8_MMA(0, 0, At, B0); PG8_MMA(0, 1, At, B1); PG8_BAR; PG8_SCHED;
            PG8_LDA(At, 1, 1); PG8_STAGE(PG8_SB(1, 0), b3, voffB); PG8_STAGE(PG8_SB(1, 1), b3 + hstep, voffB); PG8_STAGE(PG8_SA(1, 0), a3, voffA);
            PG8_WAIT_V(8); PG8_WAIT_L(0); PG8_BAR; PG8_MMA(1, 0, At, B0); PG8_MMA(1, 1, At, B1); PG8_BAR; PG8_SCHED;
            } else {
            PG8_LDB(B0, 0, 0); PG8_SCHED; PG8_LDA(At, 0, 0); PG8_STAGE(PG8_SA(1, 1), a1 + hstep, voffA);
            PG8_WAIT_L(8); PG8_BAR; PG8_WAIT_L(0); PG8_MMA(0, 0, At, B0); PG8_BAR; PG8_SCHED;
            PG8_LDB(B1, 0, 1); PG8_STAGE(PG8_SB(0, 0), b2, voffB);
            PG8_BAR; PG8_WAIT_L(0); PG8_MMA(0, 1, At, B1); PG8_BAR;
            PG8_LDA(At, 0, 1); PG8_STAGE(PG8_SA(0, 0), a2, voffA);
            PG8_BAR; PG8_WAIT_L(0); PG8_MMA(1, 0, At, B0); PG8_BAR; PG8_SCHED;
            PG8_STAGE(PG8_SB(0, 1), b2 + hstep, voffB);
            PG8_WAIT_V(6); PG8_BAR; PG8_MMA(1, 1, At, B1); PG8_BAR;
            PG8_LDB(B0, 1, 0); PG8_SCHED; PG8_LDA(At, 1, 0); PG8_STAGE(PG8_SA(0, 1), a2 + hstep, voffA);
            PG8_WAIT_L(8); PG8_BAR; PG8_WAIT_L(0); PG8_MMA(0, 0, At, B0); PG8_BAR; PG8_SCHED;
            PG8_LDB(B1, 1, 1); PG8_STAGE(PG8_SB(1, 0), b3, voffB);
            PG8_BAR; PG8_WAIT_L(0); PG8_MMA(0, 1, At, B1); PG8_BAR;
            PG8_LDA(At, 1, 1); PG8_STAGE(PG8_SA(1, 0), a3, voffA);
            PG8_BAR; PG8_WAIT_L(0); PG8_MMA(1, 0, At, B0); PG8_BAR; PG8_SCHED;
            PG8_STAGE(PG8_SB(1, 1), b3 + hstep, voffB);
            PG8_WAIT_V(6); PG8_BAR; PG8_MMA(1, 1, At, B1); PG8_BAR;
                    }
        }
        if constexpr (ALIGN_EPI) { if (wr == 0) PG8_BAR; }
        E(acc, cur, wr, wc, fr, fq); S.done(cur);
#ifdef INPROJ_EPI2
        if constexpr (Epi::TWICE) { asm volatile("" ::: "memory"); E(acc, cur, wr, wc, fr, fq); }
#endif
        if (!has_next) break;
#pragma unroll
        for (int a = 0; a < 2; ++a)
#pragma unroll
            for (int b = 0; b < 2; ++b)
#pragma unroll
                for (int m = 0; m < 4; ++m)
#pragma unroll
                    for (int n = 0; n < 2; ++n) acc[a][b][m][n] = (f32x4){0.f, 0.f, 0.f, 0.f};
        cur = nxt; cA = nA; cB = nB; ++ui;
        if constexpr (ALIGN_EPI) { if (wr == 1) PG8_BAR; }
    }
    PG8_WAIT_V(0);
    if constexpr (!ALIGN_EPI) { if (wr == 0) PG8_BAR; }
    PG8_BAR;
#undef PG8_SA
#undef PG8_SB
#undef PG8_STAGE
#undef PG8_LDA
#undef PG8_LDB
#undef PG8_MMA
#undef PG8_WAIT_V
#undef PG8_WAIT_L
#undef PG8_BAR
#undef PG8_SCHED
}

template <class Epi, class Sched, int MAXU>
__device__ __forceinline__ void gemm_phase_gather(PG8_LAS unsigned char* lds, const Gemm g, const Sched& S, const Epi& E, const int* __restrict__ rowsrc, PG8_LAS unsigned short* gtab) {
    int tid = threadIdx.x; asm volatile("" : "+v"(tid));
    const int wid = __builtin_amdgcn_readfirstlane(tid >> 6), lane = tid & 63, wr = wid >> 2, wc = wid & 3, fr = lane & 15, fq = lane >> 4;
    const int K = g.K, nt = K / BK;
    Unit cur, nxt; int ui = 0;
    if (!S.next(0, cur)) return;
    { int idx[MAXU];
#pragma unroll
      for (int i = 0; i < MAXU; ++i) { Unit u; const bool have = S.next(i, u); idx[i] = (have && tid < 256) ? rowsrc[u.pm * 256 + tid] : 0; }
#pragma unroll
      for (int i = 0; i < MAXU; ++i) { if (tid < 256) gtab[i * 256 + tid] = (unsigned short)idx[i]; }
      asm volatile("s_waitcnt vmcnt(0) lgkmcnt(0)" ::: "memory"); __builtin_amdgcn_s_barrier(); asm volatile("" ::: "memory"); }
    unsigned voffB[2]; int RA[2], CA[2];
#pragma unroll
    for (int i = 0; i < 2; ++i) { int R, C; stage_rc(tid * 16 + i * 8192, R, C); const int Rb = Epi::PERM ? ((R & ~31) + perm32(R & 31)) : R;
        RA[i] = R; CA[i] = C * 2; voffB[i] = (unsigned)(Rb * K + C) * 2u; }
    const size_t kstep = (size_t)(BK * 2);
    const size_t hstep = (size_t)HALF * K * 2;
    const size_t tstep = 2 * hstep;
    const unsigned ldsw = (unsigned)wid * 1024u;
    const int aoff = lds_byte(wr * 64 + fr, fq * 8), boff = lds_byte(wc * 32 + fr, fq * 8);
    const unsigned rowb = (unsigned)K * 2u;
#define PG8_SA(b, h) (((b) * 2 + (h)) * HTB)
#define PG8_SB(b, h) ((4 + (b) * 2 + (h)) * HTB)
#define PG8_STAGE(bufoff, gbase, voff) do { _Pragma("unroll") for (int _i = 0; _i < 2; ++_i) \
        __builtin_amdgcn_global_load_lds((const unsigned*)((const char*)(gbase) + (voff)[_i]), (PG8_LAS unsigned*)(lds + (bufoff) + ldsw + _i * 8192), 16, 0, 0); } while (0)
#define PG8_LDA(dst, b, h) do { _Pragma("unroll") for (int m = 0; m < 4; ++m) _Pragma("unroll") for (int k = 0; k < 2; ++k) dst[m][k] = *(const PG8_LAS bf16x8*)(lds + PG8_SA(b, h) + aoff + m * 2048 + k * 1024); } while (0)
#define PG8_LDB(dst, b, h) do { _Pragma("unroll") for (int n = 0; n < 2; ++n) _Pragma("unroll") for (int k = 0; k < 2; ++k) dst[n][k] = *(const PG8_LAS bf16x8*)(lds + PG8_SB(b, h) + boff + n * 2048 + k * 1024); } while (0)
#define PG8_MMA(ai, bj, At, Bt) do { __builtin_amdgcn_s_setprio(1); _Pragma("unroll") for (int m = 0; m < 4; ++m) _Pragma("unroll") for (int n = 0; n < 2; ++n) _Pragma("unroll") for (int k = 0; k < 2; ++k) \
        acc[ai][bj][m][n] = __builtin_amdgcn_mfma_f32_16x16x32_bf16(Bt[n][k], At[m][k], acc[ai][bj][m][n], 0, 0, 0); __builtin_amdgcn_s_setprio(0); } while (0)
#define PG8_WAIT_V(n) asm volatile("s_waitcnt vmcnt(" #n ")" ::: "memory")
#define PG8_WAIT_L(n) asm volatile("s_waitcnt lgkmcnt(" #n ")" ::: "memory")
#define PG8_BAR __builtin_amdgcn_s_barrier()
#define PG8_SCHED __builtin_amdgcn_sched_barrier(0)
#define PG8_GOFF(dst, ORD) do { _Pragma("unroll") for (int _h = 0; _h < 2; ++_h) _Pragma("unroll") for (int _i = 0; _i < 2; ++_i) \
        dst[_h][_i] = (unsigned)gtab[(ORD) * 256 + _h * HALF + RA[_i]] * rowb + (unsigned)CA[_i]; } while (0)
    f32x4 acc[2][2][4][2];
#pragma unroll
    for (int a = 0; a < 2; ++a)
#pragma unroll
        for (int b = 0; b < 2; ++b)
#pragma unroll
            for (int m = 0; m < 4; ++m)
#pragma unroll
                for (int n = 0; n < 2; ++n) acc[a][b][m][n] = (f32x4){0.f, 0.f, 0.f, 0.f};
    bf16x8 At[4][2], B0[2][2], B1[2][2];
    unsigned vAc[2][2], vAn[2][2];
    PG8_GOFF(vAc, 0);
#pragma unroll
    for (int h = 0; h < 2; ++h)
#pragma unroll
        for (int i = 0; i < 2; ++i) vAn[h][i] = vAc[h][i];
    const char* gA = (const char*)g.A;
    const char* cB = (const char*)g.Bt + (size_t)cur.pn * tstep;
    PG8_STAGE(PG8_SB(0, 0), cB, voffB); PG8_STAGE(PG8_SB(0, 1), cB + hstep, voffB); PG8_STAGE(PG8_SA(0, 0), gA, vAc[0]); PG8_STAGE(PG8_SA(0, 1), gA, vAc[1]);
    if (wr == 1) PG8_BAR;
    PG8_WAIT_V(2); PG8_BAR;
    PG8_STAGE(PG8_SB(1, 0), cB + kstep, voffB); PG8_STAGE(PG8_SA(1, 0), gA + kstep, vAc[0]); PG8_STAGE(PG8_SB(1, 1), cB + hstep + kstep, voffB);
    PG8_WAIT_V(6); PG8_BAR;
    for (;;) {
        const bool has_next = S.next(ui + 1, nxt);
        const char* nB = has_next ? (const char*)g.Bt + (size_t)nxt.pn * tstep : cB;
        for (int t = 0; t < nt; t += 2) {
            const bool last = (t == nt - 2);
            if (last) { if (has_next) { PG8_GOFF(vAn, ui + 1); } }
            const char* ka1 = gA + (size_t)(t + 1) * kstep;
            const char* ka2 = last ? gA : gA + (size_t)(t + 2) * kstep; const char* b2 = last ? nB : cB + (size_t)(t + 2) * kstep;
            const char* ka3 = ka2 + kstep; const char* b3 = b2 + kstep;
            unsigned x2[2][2];
#pragma unroll
            for (int h = 0; h < 2; ++h)
#pragma unroll
                for (int i = 0; i < 2; ++i) x2[h][i] = last ? vAn[h][i] : vAc[h][i];
            PG8_LDB(B0, 0, 0); PG8_LDB(B1, 0, 1); PG8_SCHED; PG8_LDA(At, 0, 0); PG8_STAGE(PG8_SA(1, 1), ka1, vAc[1]);
            PG8_WAIT_V(8); PG8_WAIT_L(0); PG8_BAR; PG8_MMA(0, 0, At, B0); PG8_MMA(0, 1, At, B1); PG8_BAR; PG8_SCHED;
            PG8_LDA(At, 0, 1); PG8_STAGE(PG8_SB(0, 0), b2, voffB); PG8_STAGE(PG8_SB(0, 1), b2 + hstep, voffB); PG8_STAGE(PG8_SA(0, 0), ka2, x2[0]);
            PG8_WAIT_V(8); PG8_WAIT_L(0); PG8_BAR; PG8_MMA(1, 0, At, B0); PG8_MMA(1, 1, At, B1); PG8_BAR; PG8_SCHED;
            PG8_LDB(B0, 1, 0); PG8_LDB(B1, 1, 1); PG8_SCHED; PG8_LDA(At, 1, 0); PG8_STAGE(PG8_SA(0, 1), ka2, x2[1]);
            PG8_WAIT_V(8); PG8_WAIT_L(0); PG8_BAR; PG8_MMA(0, 0, At, B0); PG8_MMA(0, 1, At, B1); PG8_BAR; PG8_SCHED;
            PG8_LDA(At, 1, 1); PG8_STAGE(PG8_SB(1, 0), b3, voffB); PG8_STAGE(PG8_SB(1, 1), b3 + hstep, voffB); PG8_STAGE(PG8_SA(1, 0), ka3, x2[0]);
            PG8_WAIT_V(8); PG8_WAIT_L(0); PG8_BAR; PG8_MMA(1, 0, At, B0); PG8_MMA(1, 1, At, B1); PG8_BAR; PG8_SCHED;
        }
        if (wr == 0) PG8_BAR;
        E(acc, cur, wr, wc, fr, fq); S.done(cur);
        if (!has_next) break;
#pragma unroll
        for (int a = 0; a < 2; ++a)
#pragma unroll
            for (int b = 0; b < 2; ++b)
#pragma unroll
                for (int m = 0; m < 4; ++m)
#pragma unroll
                    for (int n = 0; n < 2; ++n) acc[a][b][m][n] = (f32x4){0.f, 0.f, 0.f, 0.f};
        cur = nxt; cB = nB; ++ui;
#pragma unroll
        for (int h = 0; h < 2; ++h)
#pragma unroll
            for (int i = 0; i < 2; ++i) vAc[h][i] = vAn[h][i];
        if (wr == 1) PG8_BAR;
    }
    PG8_WAIT_V(0);
    PG8_BAR;
#undef PG8_GOFF
#undef PG8_SA
#undef PG8_SB
#undef PG8_STAGE
#undef PG8_LDA
#undef PG8_LDB
#undef PG8_MMA
#undef PG8_WAIT_V
#undef PG8_WAIT_L
#undef PG8_BAR
#undef PG8_SCHED
}
}
#define XB_TMO      128
#define XB_XCNT(j)  (256  + 64 * (j))
#define XB_XSUB(j)  (1280 + 64 * (j))
#define XB_XGEN(j)  (2304 + 64 * (j))
#define XB_TOP      3328
#define XB_TOPGEN   3392
#define XCD_BAR_WORDS 3456
#define XB_SPIN_CAP (1u << 22)
#define LAS __attribute__((address_space(3)))

__device__ __forceinline__ unsigned xb_ld(unsigned* p)              { return __hip_atomic_load(p, __ATOMIC_RELAXED, __HIP_MEMORY_SCOPE_AGENT); }
__device__ __forceinline__ unsigned xb_add(unsigned* p, unsigned v) { return __hip_atomic_fetch_add(p, v, __ATOMIC_RELAXED, __HIP_MEMORY_SCOPE_AGENT); }
__device__ __forceinline__ unsigned xb_xcc_id() { return (unsigned)__builtin_amdgcn_s_getreg((3 << 11) | 20) & 0xFu; }
#define XB_SPIN(cond, bar) do { unsigned _sp = 0; while (cond) { __builtin_amdgcn_s_sleep(1); \
    if ((++_sp & 255u) == 0u) { if (xb_ld(&(bar)[XB_TMO])) break; if (_sp > XB_SPIN_CAP) { atomicAdd(&(bar)[XB_TMO], 1u); break; } } } } while (0)

struct XcdBarrier {
    unsigned* bar; unsigned x;
    volatile LAS unsigned* st;
};
__device__ __forceinline__ XcdBarrier xcd_barrier_post(unsigned* bar, volatile LAS unsigned* st) {
    XcdBarrier b; b.bar = bar; b.x = xb_xcc_id(); b.st = st;
    if (threadIdx.x == 0) (void)xb_add(&bar[XB_XCNT(b.x)], 1u);
    return b;
}
__device__ __forceinline__ void xcd_barrier_complete(unsigned* bar, unsigned x, unsigned& nloc, unsigned& nx) {
    const unsigned G = gridDim.x * gridDim.y * gridDim.z;
    unsigned sum, cnt, mine, sp = 0u;
    for (;;) {
        sum = 0u; cnt = 0u; mine = 0u;
#pragma unroll
        for (unsigned j = 0; j < 16; ++j) { const unsigned c = xb_ld(&bar[XB_XCNT(j)]); sum += c; cnt += (c > 0u) ? 1u : 0u; mine = (j == x) ? c : mine; }
        if (sum == G) break;
        __builtin_amdgcn_s_sleep(1);
        if ((++sp & 255u) == 0u) { if (xb_ld(&bar[XB_TMO])) break; if (sp > XB_SPIN_CAP) { atomicAdd(&bar[XB_TMO], 1u); break; } }
    }
    nloc = mine > 0u ? mine : 1u; nx = cnt > 0u ? cnt : 1u;
}
__device__ __forceinline__ void xcd_barrier(const XcdBarrier& b) {
    asm volatile("s_waitcnt vmcnt(0)" ::: "memory");
    __syncthreads();
    if (threadIdx.x == 0) {
        unsigned* bar = b.bar;
        __builtin_amdgcn_s_waitcnt(0);
        unsigned nloc = b.st[0], nx = b.st[1];
        if (nloc == 0u) { xcd_barrier_complete(bar, b.x, nloc, nx); b.st[0] = nloc; b.st[1] = nx; }
        const unsigned old = xb_add(&bar[XB_XSUB(b.x)], 1u);
        const unsigned gen = old / nloc;
        if (old + 1u == (gen + 1u) * nloc) {
            __builtin_amdgcn_fence(__ATOMIC_RELEASE, "agent");
            asm volatile("s_waitcnt vmcnt(0)" ::: "memory");
            const unsigned og = xb_add(&bar[XB_TOP], 1u);
            const unsigned tg = og / nx;
            if (og + 1u == (tg + 1u) * nx) xb_add(&bar[XB_TOPGEN], 1u);
            else XB_SPIN(xb_ld(&bar[XB_TOPGEN]) == tg, bar);
            __builtin_amdgcn_fence(__ATOMIC_ACQUIRE, "agent");
            xb_add(&bar[XB_XGEN(b.x)], 1u);
            asm volatile("s_waitcnt vmcnt(0)" ::: "memory");
        } else {
            XB_SPIN(xb_ld(&bar[XB_XGEN(b.x)]) == gen, bar);
            __builtin_amdgcn_fence(__ATOMIC_ACQUIRE, "agent");
            asm volatile("s_waitcnt vmcnt(0)" ::: "memory");
        }
    }
    __syncthreads();
}
namespace att {
typedef unsigned short bf16_t;
using bf16x8 = __attribute__((ext_vector_type(8))) short;
using s16x4  = __attribute__((ext_vector_type(4))) short;
using f32x16 = __attribute__((ext_vector_type(16))) float;
using u32x4  = __attribute__((ext_vector_type(4))) unsigned;
constexpr int NW = 8, QBLK = 32, KVBLK = 64;
constexpr int LDR = 512;
constexpr float THR = 8.f;
constexpr int SHM_V = KVBLK * 128 * 2, SHM_K = KVBLK * 64 * 2, NBUF = 3, WS_OFF = NBUF * (SHM_V + SHM_K), SHM_ATTN = WS_OFF + NW * 64 * 4;
#define KSWZ(row, colB) ((row) * 128 + ((colB) ^ ((((row) >> 1) & 7) << 4)))
#define SBAR() __builtin_amdgcn_sched_barrier(0)
__device__ __forceinline__ int crow(int r, int hi) { return (r & 3) + 8 * (r >> 2) + 4 * hi; }
__device__ __forceinline__ unsigned cvtpk(float lo, float hi) { unsigned r; asm volatile("v_cvt_pk_bf16_f32 %0, %1, %2" : "=v"(r) : "v"(lo), "v"(hi)); return r; }

template <int CTRL> __device__ __forceinline__ float adpp(float x) { return __builtin_bit_cast(float, __builtin_amdgcn_mov_dpp(__builtin_bit_cast(int, x), CTRL, 0xf, 0xf, true)); }
__device__ __forceinline__ void partialSM(f32x16& p0, f32x16& p1, float& m_reg, float& mn, float& alpha) {
  constexpr float C = 1.4426950408889634f;
  float pmax = p0[0];
#pragma unroll
  for (int r = 1; r < 16; ++r) pmax = fmaxf(pmax, p0[r]);
#pragma unroll
  for (int r = 0; r < 16; ++r) pmax = fmaxf(pmax, p1[r]);
  { auto rr = __builtin_amdgcn_permlane32_swap(__float_as_uint(pmax), __float_as_uint(pmax), false, false);
    pmax = fmaxf(__uint_as_float(rr[0]), __uint_as_float(rr[1])); }
  if (__builtin_expect(__all(pmax - m_reg <= THR), 1)) { mn = m_reg; alpha = 1.f; }
  else { mn = fmaxf(m_reg, pmax); alpha = __builtin_amdgcn_exp2f((m_reg - mn) * C); m_reg = mn; }
  float mnC = -mn * C;
#pragma unroll
  for (int r = 0; r < 16; ++r) p0[r] = fmaf(p0[r], C, mnC);
#pragma unroll
  for (int r = 0; r < 16; ++r) p1[r] = fmaf(p1[r], C, mnC);
#pragma unroll
  for (int r = 0; r < 16; ++r) p0[r] = __builtin_amdgcn_exp2f(p0[r]);
}
__device__ __forceinline__ float psm_max0(const f32x16& p0) {
  float pmax = p0[0];
#pragma unroll
  for (int r = 1; r < 16; ++r) pmax = fmaxf(pmax, p0[r]);
  return pmax;
}
__device__ __forceinline__ void psm_max1(const f32x16& p1, float pmax, float& m_reg, float& mn, float& alpha) {
  constexpr float C = 1.4426950408889634f;
#pragma unroll
  for (int r = 0; r < 16; ++r) pmax = fmaxf(pmax, p1[r]);
  { auto rr = __builtin_amdgcn_permlane32_swap(__float_as_uint(pmax), __float_as_uint(pmax), false, false);
    pmax = fmaxf(__uint_as_float(rr[0]), __uint_as_float(rr[1])); }
  if (__builtin_expect(__all(pmax - m_reg <= THR), 1)) { mn = m_reg; alpha = 1.f; }
  else { mn = fmaxf(m_reg, pmax); alpha = __builtin_amdgcn_exp2f((m_reg - mn) * C); m_reg = mn; }
}
__device__ __forceinline__ void psm_scale(f32x16& p0, f32x16& p1, float mn) {
  constexpr float C = 1.4426950408889634f; const float mnC = -mn * C;
#pragma unroll
  for (int r = 0; r < 16; ++r) p0[r] = fmaf(p0[r], C, mnC);
#pragma unroll
  for (int r = 0; r < 16; ++r) p1[r] = fmaf(p1[r], C, mnC);
}
__device__ __forceinline__ void psm_exp0(f32x16& p0) {
#pragma unroll
  for (int r = 0; r < 16; ++r) p0[r] = __builtin_amdgcn_exp2f(p0[r]);
}
__device__ __forceinline__ void finishSM(f32x16& p0, f32x16& p1, float alpha, float& l_reg, bf16x8& pa0, bf16x8& pa1, bf16x8& pa2, bf16x8& pa3) {
#pragma unroll
  for (int r = 0; r < 16; ++r) p1[r] = __builtin_amdgcn_exp2f(p1[r]);
  float ps = 0;
#pragma unroll
  for (int r = 0; r < 16; ++r) ps += p0[r];
#pragma unroll
  for (int r = 0; r < 16; ++r) ps += p1[r];
  { auto rr = __builtin_amdgcn_permlane32_swap(__float_as_uint(ps), __float_as_uint(ps), false, false);
    ps = __uint_as_float(rr[0]) + __uint_as_float(rr[1]); }
  l_reg = l_reg * alpha + ps;
#define PK4(P, BASE, OUT) do { unsigned a0 = cvtpk(P[BASE + 0], P[BASE + 1]), a1 = cvtpk(P[BASE + 2], P[BASE + 3]);   \
    unsigned b0 = cvtpk(P[BASE + 4], P[BASE + 5]), b1 = cvtpk(P[BASE + 6], P[BASE + 7]);                              \
    auto r0 = __builtin_amdgcn_permlane32_swap(a0, b0, false, false); auto r1 = __builtin_amdgcn_permlane32_swap(a1, b1, false, false); \
    u32x4 w = {r0[0], r1[0], r0[1], r1[1]}; OUT = *reinterpret_cast<bf16x8*>(&w); } while (0)
  PK4(p0, 0, pa0); PK4(p0, 8, pa1); PK4(p1, 0, pa2); PK4(p1, 8, pa3);
#undef PK4
}
__device__ __forceinline__ void qkt(f32x16& p0, f32x16& p1, const char* Ks, const bf16x8 (&qr)[4], int r32, int hi) {
  p0 = f32x16{}; p1 = f32x16{};
#pragma unroll
  for (int d0 = 0; d0 < 4; ++d0) { const int cb = (d0 * 16 + hi * 8) * 2;
    bf16x8 b0 = *reinterpret_cast<const bf16x8*>(Ks + KSWZ(r32, cb));
    bf16x8 b1 = *reinterpret_cast<const bf16x8*>(Ks + KSWZ(32 + r32, cb));
    p0 = __builtin_amdgcn_mfma_f32_32x32x16_bf16(b0, qr[d0], p0, 0, 0, 0);
    p1 = __builtin_amdgcn_mfma_f32_32x32x16_bf16(b1, qr[d0], p1, 0, 0, 0); }
}
__device__ __forceinline__ int v_st(int k, int c) { const int kk = (k & ~0xC) | ((k & 4) << 1) | ((k & 8) >> 1); return ((kk >> 3) * 4 + (c >> 5)) * 512 + ((kk & 7) * 32 + (c & 31)) * 2; }
__device__ __forceinline__ int v_rd_base(int lane) { return ((lane & 3) << 3) | (((lane >> 2) & 3) << 6) | (((lane >> 4) & 1) << 5) | (((lane >> 5) & 1) << 8); }
constexpr int v_rd_off(int d0, int ks, int half) { return d0 * 512 + ks * 4096 + half * 2048; }
template <int OFF> __device__ __forceinline__ s16x4 tr_read(int vb) {
  s16x4 r; asm volatile("ds_read_b64_tr_b16 %0, %1 offset:%2" : "=&v"(r) : "v"(vb), "i"(OFF) : "memory"); return r;
}
template <int D0> __device__ __forceinline__ void pv_one(f32x16& od, int vb, bf16x8 pa0, bf16x8 pa1, bf16x8 pa2, bf16x8 pa3) {
  const s16x4 l0 = tr_read<v_rd_off(D0, 0, 0)>(vb), h0 = tr_read<v_rd_off(D0, 0, 1)>(vb), l1 = tr_read<v_rd_off(D0, 1, 0)>(vb), h1 = tr_read<v_rd_off(D0, 1, 1)>(vb);
  const s16x4 l2 = tr_read<v_rd_off(D0, 2, 0)>(vb), h2 = tr_read<v_rd_off(D0, 2, 1)>(vb), l3 = tr_read<v_rd_off(D0, 3, 0)>(vb), h3 = tr_read<v_rd_off(D0, 3, 1)>(vb);
  asm volatile("s_waitcnt lgkmcnt(0)" ::: "memory"); SBAR();
#define PK(L, H) (bf16x8){L[0], L[1], L[2], L[3], H[0], H[1], H[2], H[3]}
  od = __builtin_amdgcn_mfma_f32_32x32x16_bf16(pa0, PK(l0, h0), od, 0, 0, 0);
  od = __builtin_amdgcn_mfma_f32_32x32x16_bf16(pa1, PK(l1, h1), od, 0, 0, 0);
  od = __builtin_amdgcn_mfma_f32_32x32x16_bf16(pa2, PK(l2, h2), od, 0, 0, 0);
  od = __builtin_amdgcn_mfma_f32_32x32x16_bf16(pa3, PK(l3, h3), od, 0, 0, 0);
#undef PK
}
__device__ __forceinline__ void pv_d0(f32x16 (&o)[4], int vb, bf16x8 pa0, bf16x8 pa1, bf16x8 pa2, bf16x8 pa3) {
  pv_one<0>(o[0], vb, pa0, pa1, pa2, pa3); pv_one<1>(o[1], vb, pa0, pa1, pa2, pa3); pv_one<2>(o[2], vb, pa0, pa1, pa2, pa3); pv_one<3>(o[3], vb, pa0, pa1, pa2, pa3);
}

__device__ __forceinline__ void pv_psm(f32x16 (&o)[4], int vb, bf16x8 pa0, bf16x8 pa1, bf16x8 pa2, bf16x8 pa3, f32x16& p0, f32x16& p1, float& m_reg, float& mn, float& alpha) {
  pv_one<0>(o[0], vb, pa0, pa1, pa2, pa3); const float pm0 = psm_max0(p0);
  pv_one<1>(o[1], vb, pa0, pa1, pa2, pa3); psm_max1(p1, pm0, m_reg, mn, alpha);
  pv_one<2>(o[2], vb, pa0, pa1, pa2, pa3); psm_scale(p0, p1, mn);
  pv_one<3>(o[3], vb, pa0, pa1, pa2, pa3); psm_exp0(p0);
}

__device__ __forceinline__ void attn_pass(const bf16_t* __restrict__ Qb, const bf16_t* __restrict__ Kh, const bf16_t* __restrict__ Vh, int seq, char* lds, f32x16 (&o)[4], float& l_out) {
  int tid = threadIdx.x; asm volatile("" : "+v"(tid));
  const int wid = tid >> 6, lane = tid & 63, r32 = lane & 31, hi = lane >> 5;
  char* V_lds = lds; char* K_lds = lds + NBUF * SHM_V;
  float* ws = (float*)(lds + WS_OFF) + wid * 64; float* al_l = ws + 32;
  float m_reg = -1e30f, l_reg = 0; bf16x8 qr[4];
#pragma unroll
  for (int d = 0; d < 4; ++d) o[d] = f32x16{};
  const bf16_t* Qw = Qb + (long)(wid * QBLK + r32) * LDR + hi * 8;
#pragma unroll
  for (int d0 = 0; d0 < 4; ++d0) qr[d0] = *reinterpret_cast<const bf16x8*>(Qw + d0 * 16);
  const int sr = tid >> 4, sc = (tid & 15) * 8, vst0 = v_st(sr, sc), vst1 = v_st(32 + sr, sc);
  const int kr = tid >> 3, kc = (tid & 7) * 8, kst = KSWZ(kr, kc * 2);
  const int vb0 = (int)(uintptr_t)V_lds + v_rd_base(lane);
  struct { bf16x8 vs0, vs1, ks0; } sr_[2];
#define SLOAD(i, k0) do { sr_[i].vs0 = *reinterpret_cast<const bf16x8*>(&Vh[(long)((k0) + sr) * LDR + sc]); sr_[i].vs1 = *reinterpret_cast<const bf16x8*>(&Vh[(long)((k0) + 32 + sr) * LDR + sc]); \
    sr_[i].ks0 = *reinterpret_cast<const bf16x8*>(&Kh[(long)((k0) + kr) * LDR + kc]); } while (0)
#define SWRITE(b, i) do { *(bf16x8*)(V_lds + (b) * SHM_V + vst0) = sr_[i].vs0; *(bf16x8*)(V_lds + (b) * SHM_V + vst1) = sr_[i].vs1; \
    *(bf16x8*)(K_lds + (b) * SHM_K + kst) = sr_[i].ks0; } while (0)
#define SWAIT() asm volatile("s_waitcnt vmcnt(3)" ::: "memory")
#define RESC(a) do { if (__any((a) < 1.f)) { if (hi == 0) al_l[r32] = (a); asm volatile("s_waitcnt lgkmcnt(0)" ::: "memory"); \
    _Pragma("unroll") for (int d = 0; d < 4; ++d) _Pragma("unroll") for (int r = 0; r < 16; ++r) o[d][r] *= al_l[crow(r, hi)]; } } while (0)
#define ROT() do { const int t_ = bprev; bprev = bcur; bcur = bnext; bnext = t_; } while (0)
  f32x16 pA0, pA1, pB0, pB1; float mnA, mnB, alA, alB; bf16x8 pa0, pa1, pa2, pa3; const int NT = seq / KVBLK;
  constexpr int SE = 0, SO = 1;
  SLOAD(SE, 0); asm volatile("s_waitcnt vmcnt(0)" ::: "memory"); SWRITE(0, SE);
  SLOAD(SO, KVBLK); if (2 < NT) SLOAD(SE, 2 * KVBLK);
  __syncthreads();
  qkt(pA0, pA1, K_lds, qr, r32, hi); partialSM(pA0, pA1, m_reg, mnA, alA);
  SWAIT(); SWRITE(1, SO);
  int bprev = 0, bcur = 1, bnext = 2;
  for (int j = 1; j + 1 < NT; j += 2) {
    __syncthreads();
    SBAR(); qkt(pB0, pB1, K_lds + bcur * SHM_K, qr, r32, hi);
#ifdef ATT_X1
    asm volatile("" : "+v"(pB0), "+v"(pB1)); qkt(pB0, pB1, K_lds + bcur * SHM_K, qr, r32, hi);
#endif
    finishSM(pA0, pA1, alA, l_reg, pa0, pa1, pa2, pa3); SBAR();
#ifdef ATT_X2
    { bf16x8 z = {0,0,0,0,0,0,0,0}; asm volatile("" : "+v"(z)); pv_d0(o, vb0 + bprev * (int)SHM_V, z, z, z, z); }
#endif
    SLOAD(SO, (j + 2) * KVBLK); SBAR();
    pv_psm(o, vb0 + bprev * (int)SHM_V, pa0, pa1, pa2, pa3, pB0, pB1, m_reg, mnB, alB);
    SWAIT(); SWRITE(bnext, SE);
    RESC(alB); ROT();
    __syncthreads();
    SBAR(); qkt(pA0, pA1, K_lds + bcur * SHM_K, qr, r32, hi);
#ifdef ATT_X1
    asm volatile("" : "+v"(pA0), "+v"(pA1)); qkt(pA0, pA1, K_lds + bcur * SHM_K, qr, r32, hi);
#endif
    finishSM(pB0, pB1, alB, l_reg, pa0, pa1, pa2, pa3); SBAR();
#ifdef ATT_X2
    { bf16x8 z = {0,0,0,0,0,0,0,0}; asm volatile("" : "+v"(z)); pv_d0(o, vb0 + bprev * (int)SHM_V, z, z, z, z); }
#endif
    SLOAD(SE, (j + 3 < NT ? j + 3 : NT - 1) * KVBLK); SBAR();
    pv_psm(o, vb0 + bprev * (int)SHM_V, pa0, pa1, pa2, pa3, pA0, pA1, m_reg, mnA, alA);
    SWAIT(); SWRITE(bnext, SO);
    RESC(alA); ROT();
  }
  __syncthreads();
  SBAR(); qkt(pB0, pB1, K_lds + bcur * SHM_K, qr, r32, hi);
  finishSM(pA0, pA1, alA, l_reg, pa0, pa1, pa2, pa3); SBAR();
  pv_psm(o, vb0 + bprev * (int)SHM_V, pa0, pa1, pa2, pa3, pB0, pB1, m_reg, mnB, alB);
  RESC(alB);
  finishSM(pB0, pB1, alB, l_reg, pa0, pa1, pa2, pa3); SBAR();
  pv_d0(o, vb0 + bcur * (int)SHM_V, pa0, pa1, pa2, pa3);
  l_out = l_reg;
#undef SLOAD
#undef SWRITE
#undef SWAIT
#undef RESC
#undef ROT
}

__device__ __forceinline__ void attn_unit(const bf16_t* QB, const bf16_t* KB, const bf16_t* VB, float* OS, bf16_t* CAT, const float* subg, float lam, float outscale,
                                          int h, long row_q0, long row_k0, int nkeys, char* lds) {
  int tid = threadIdx.x; asm volatile("" : "+v"(tid));
  const int wid = tid >> 6, lane = tid & 63, r32 = lane & 31, hi = lane >> 5;
  float* li_l = (float*)(lds + WS_OFF) + wid * 64;
  float* OSu = OS + row_q0 * 512 + h * 128;
  bf16_t* CATu = CAT + row_q0 * 1024 + h * 128;
  {
    f32x16 o[4]; float l_reg;
    attn_pass(QB + row_q0 * LDR + h * 64, KB + row_k0 * LDR + h * 64, VB + row_k0 * LDR + h * 128, nkeys, lds, o, l_reg);
    if (hi == 0) li_l[r32] = l_reg;
    asm volatile("s_waitcnt lgkmcnt(0)" ::: "memory");
    int ob = (wid * QBLK + 4 * hi) * 512 + r32; asm volatile("" : "+v"(ob));
#pragma unroll
    for (int r = 0; r < 16; ++r) { const int oo = ob + ((r & 3) + 8 * (r >> 2)) * 512; const float rl = __builtin_amdgcn_rcpf(li_l[crow(r, hi)]);
#pragma unroll
      for (int d0 = 0; d0 < 4; ++d0) OSu[oo + d0 * 32] = o[d0][r] * rl; }
    asm volatile("s_waitcnt vmcnt(0)" ::: "memory");
    __syncthreads();
  }
  {
    f32x16 o[4]; float l_reg;
    attn_pass(QB + row_q0 * LDR + 256 + h * 64, KB + row_k0 * LDR + 256 + h * 64, VB + row_k0 * LDR + h * 128, nkeys, lds, o, l_reg);
    if (hi == 0) li_l[r32] = l_reg;
    asm volatile("s_waitcnt lgkmcnt(0)" ::: "memory");
    float ss[16];
    int ob = (wid * QBLK + 4 * hi) * 512 + r32; asm volatile("" : "+v"(ob));
#pragma unroll
    for (int r = 0; r < 16; ++r) { const int oo = ob + ((r & 3) + 8 * (r >> 2)) * 512; float s = 0.f; const float rl = lam * __builtin_amdgcn_rcpf(li_l[crow(r, hi)]);
#pragma unroll
      for (int d0 = 0; d0 < 4; ++d0) { const float v = OSu[oo + d0 * 32] - o[d0][r] * rl; o[d0][r] = v; s += v * v; }
      s += adpp<0xB1>(s); s += adpp<0x4E>(s); s += adpp<0x141>(s); s += adpp<0x128>(s);
      { auto s2 = __builtin_amdgcn_permlane16_swap(__float_as_uint(s), __float_as_uint(s), false, false); s = __uint_as_float(s2[0]) + __uint_as_float(s2[1]); }
      ss[r] = __builtin_amdgcn_rsqf(s * (1.0f / 128.0f) + 1e-6f) * outscale;
      if ((r & 3) == 3) asm volatile("" ::: "memory"); }
    float gs[4];
#pragma unroll
    for (int d0 = 0; d0 < 4; ++d0) gs[d0] = subg[d0 * 32 + r32];
    int cbo = (wid * QBLK + 4 * hi) * 1024 + r32; asm volatile("" : "+v"(cbo));
#pragma unroll
    for (int r = 0; r < 16; ++r) { const int co = cbo + ((r & 3) + 8 * (r >> 2)) * 1024;
#pragma unroll
      for (int d0 = 0; d0 < 4; ++d0) CATu[co + d0 * 32] = (bf16_t)(cvtpk(o[d0][r] * ss[r] * gs[d0], 0.f) & 0xffffu); }
    asm volatile("s_waitcnt vmcnt(0)" ::: "memory");
    __syncthreads();
  }
}
#undef KSWZ
#undef SBAR
}
typedef unsigned short bf16_t;
typedef float f32x4 __attribute__((ext_vector_type(4)));
typedef float f32x2 __attribute__((ext_vector_type(2)));
typedef unsigned u32x4 __attribute__((ext_vector_type(4)));
typedef unsigned u32x2 __attribute__((ext_vector_type(2)));
typedef short bf16x8 __attribute__((ext_vector_type(8)));

constexpr int D = 1024, NB = 8, SEQ = 4096, DEPTH = 4, CTXL = 256;
constexpr int RPB = CTXL + SEQ;
constexpr int RT = NB * RPB;
constexpr int PROJ = 2560, NE = 16, FF = 2048;
constexpr int CAP_L = 512, CAP_C = 32;
constexpr int ER = NB * CAP_L + NB * CAP_C;
constexpr int NWAVES = 8, NTHR = 512;
constexpr float EPS = 1e-6f;

constexpr size_t al256(size_t x) { return (x + 255) / 256 * 256; }
constexpr size_t WS_CTL   = 0;
constexpr size_t CTL_BYTES = 1u << 16;
constexpr size_t WS_MOD   = WS_CTL + CTL_BYTES;
constexpr size_t WS_ROPEC = al256(WS_MOD + (size_t)DEPTH * 9 * 6 * D * 4);
constexpr size_t WS_ROPES = WS_ROPEC + 64 * 16 * 4;
constexpr size_t WS_LAM   = WS_ROPES + 64 * 16 * 4;
constexpr size_t WS_SGUW  = al256(WS_LAM + 256);
constexpr size_t WS_XR    = al256(WS_SGUW + (size_t)DEPTH * 8 * 128 * 128 * 2);
constexpr size_t WS_HA    = al256(WS_XR + (size_t)RT * D * 4);
constexpr size_t WS_QB    = al256(WS_HA + (size_t)RT * D * 2);
constexpr size_t WS_KB    = al256(WS_QB + (size_t)RT * 512 * 2);
constexpr size_t WS_VB    = al256(WS_KB + (size_t)RT * 512 * 2);
constexpr size_t WS_UB    = al256(WS_VB + (size_t)RT * 512 * 2);
constexpr size_t WS_GVB   = al256(WS_UB + (size_t)RT * 512 * 2);
constexpr size_t WS_CAT   = al256(WS_GVB + (size_t)RT * 512 * 2);
constexpr size_t WS_OS    = al256(WS_CAT + (size_t)RT * D * 2);
constexpr size_t WS_AFF   = al256(WS_OS + (size_t)RT * 512 * 4);
constexpr size_t WS_INV   = al256(WS_AFF + (size_t)RT * 16 * 4);
constexpr size_t WS_RSRC  = al256(WS_INV + (size_t)RT * 16 * 4);
constexpr size_t WS_XS    = al256(WS_RSRC + (size_t)NE * ER * 4);
constexpr size_t WS_HID   = al256(WS_XS + (size_t)NE * ER * D * 2);
constexpr size_t WS_Y     = al256(WS_HID + (size_t)NE * ER * FF * 2);
constexpr size_t WS_WIN   = al256(WS_Y + (size_t)NE * ER * D * 2);
constexpr size_t WS_WOUT  = al256(WS_WIN + (size_t)DEPTH * PROJ * D * 2);
constexpr size_t WS_WGU   = al256(WS_WOUT + (size_t)DEPTH * D * D * 2);
constexpr size_t WS_WD    = al256(WS_WGU + (size_t)DEPTH * NE * 2 * FF * D * 2);
constexpr size_t WS_END   = al256(WS_WD + (size_t)DEPTH * NE * D * FF * 2);

constexpr int LDS_MISC = 147456 - 256;
constexpr int LDS_BYTES = 147456;

__device__ __forceinline__ unsigned f2bf(float f) { unsigned u = __builtin_bit_cast(unsigned, f); return (u + 0x7fffu + ((u >> 16) & 1u)) >> 16; }
__device__ __forceinline__ unsigned pk2(float lo, float hi) { return pg8::cvt_pk_bf16(lo, hi); }
__device__ __forceinline__ float bf2f(unsigned h) { return __builtin_bit_cast(float, h << 16); }
template <int CTRL> __device__ __forceinline__ float dpp(float x) { return __builtin_bit_cast(float, __builtin_amdgcn_mov_dpp(__builtin_bit_cast(int, x), CTRL, 0xf, 0xf, true)); }
constexpr int DPP_XOR1 = 0xB1, DPP_XOR2 = 0x4E, DPP_HMIR = 0x141, DPP_XOR8 = 0x128;
__device__ __forceinline__ float xrow16_sum(float x) {
    auto s = __builtin_amdgcn_permlane16_swap(__float_as_uint(x), __float_as_uint(x), false, false); x = __uint_as_float(s[0]) + __uint_as_float(s[1]);
    auto t = __builtin_amdgcn_permlane32_swap(__float_as_uint(x), __float_as_uint(x), false, false); return __uint_as_float(t[0]) + __uint_as_float(t[1]);
}
__device__ __forceinline__ float xrow16_max(float x) {
    auto s = __builtin_amdgcn_permlane16_swap(__float_as_uint(x), __float_as_uint(x), false, false); x = fmaxf(__uint_as_float(s[0]), __uint_as_float(s[1]));
    auto t = __builtin_amdgcn_permlane32_swap(__float_as_uint(x), __float_as_uint(x), false, false); return fmaxf(__uint_as_float(t[0]), __uint_as_float(t[1]));
}
__device__ __forceinline__ float wave_sum(float v) {
    v += dpp<DPP_XOR1>(v); v += dpp<DPP_XOR2>(v); v += dpp<DPP_HMIR>(v); v += dpp<DPP_XOR8>(v);
    return xrow16_sum(v);
}
#define LDS_WAIT() asm volatile("s_waitcnt lgkmcnt(0)" ::: "memory")

__constant__ double kFreq[16] = {1.0, 0.56234132519034908, 0.31622776601683794, 0.17782794100389228,
                                 0.1, 0.056234132519034908, 0.031622776601683794, 0.017782794100389228,
                                 0.01, 0.0056234132519034908, 0.0031622776601683794, 0.0017782794100389228,
                                 0.001, 0.00056234132519034908, 0.00031622776601683794, 0.00017782794100389228};
__constant__ float kLamInit[4] = {0.2f, 0.35550906759096926f, 0.47071301834358416f, 0.5560582041556405f};

__device__ __forceinline__ void sincos_d(double a, double& s, double& c) {
    const double TWO_OVER_PI = 0.63661977236758134308, PIO2_HI = 1.57079632679489655800e+00, PIO2_LO = 6.12323399573676603587e-17;
    const double kf = __builtin_rint(a * TWO_OVER_PI); const int k = (int)kf;
    const double r = (a - kf * PIO2_HI) - kf * PIO2_LO, r2 = r * r;
    double sp = -1.0 / 1307674368000.0; sp = sp * r2 + 1.0 / 6227020800.0; sp = sp * r2 - 1.0 / 39916800.0; sp = sp * r2 + 1.0 / 362880.0; sp = sp * r2 - 1.0 / 5040.0; sp = sp * r2 + 1.0 / 120.0; sp = sp * r2 - 1.0 / 6.0; sp = sp * r2 + 1.0;
    const double sr = sp * r;
    double cp = 1.0 / 20922789888000.0; cp = cp * r2 - 1.0 / 87178291200.0; cp = cp * r2 + 1.0 / 479001600.0; cp = cp * r2 - 1.0 / 3628800.0; cp = cp * r2 + 1.0 / 40320.0; cp = cp * r2 - 1.0 / 720.0; cp = cp * r2 + 1.0 / 24.0; cp = cp * r2 - 0.5; cp = cp * r2 + 1.0;
    const int q = k & 3;
    s = (q == 0) ? sr : (q == 1) ? cp : (q == 2) ? -sr : -cp;
    c = (q == 0) ? cp : (q == 1) ? -sr : (q == 2) ? -cp : sr;
}


__device__ __forceinline__ unsigned long long lds_ptr(LAS unsigned long long* tab, int i) {
    const unsigned long long v = tab[i];
    const unsigned lo = __builtin_amdgcn_readfirstlane((unsigned)v), hi = __builtin_amdgcn_readfirstlane((unsigned)(v >> 32));
    return ((unsigned long long)hi << 32) | lo;
}
struct Args { const float* in[23]; float* out; unsigned char* ws; int ph_lo, ph_hi; };
enum { I_X = 0, I_C, I_CTX, I_CCTX, I_WADA, I_BADA, I_N1G, I_N2G, I_WIN, I_WOUT, I_LQ1, I_LK1, I_LQ2, I_LK2, I_SUBG, I_SGUNG, I_SGUW, I_SGUB, I_WR, I_WG, I_WU, I_WDN, I_NFG };

__device__ __forceinline__ void transpose_item(const float* __restrict__ W, int N, int k0, int n0, bf16_t* __restrict__ WT, int K, int drow0, LAS float* scr, int lane) {
    float t[32];
#pragma unroll
    for (int i = 0; i < 32; ++i) { const int kk = 2 * i + (lane >> 5); t[i] = __builtin_nontemporal_load(&W[(size_t)(k0 + kk) * N + n0 + (lane & 31)]); }
#pragma unroll
    for (int i = 0; i < 32; ++i) { const int kk = 2 * i + (lane >> 5); scr[kk * 33 + (lane & 31)] = t[i]; }
    LDS_WAIT(); asm volatile("" ::: "memory");
    const int c = lane & 7;
#pragma unroll
    for (int j = 0; j < 4; ++j) { const int n = (lane >> 3) + 8 * j; const LAS float* s = scr + (8 * c) * 33 + n;
        u32x4 o; o.x = pk2(s[0 * 33], s[1 * 33]); o.y = pk2(s[2 * 33], s[3 * 33]); o.z = pk2(s[4 * 33], s[5 * 33]); o.w = pk2(s[6 * 33], s[7 * 33]);
        __builtin_nontemporal_store(o, (u32x4*)(WT + (size_t)(drow0 + n) * K + k0 + 8 * c)); }
    LDS_WAIT(); asm volatile("" ::: "memory");
}

__device__ __forceinline__ void row_load(const float* p, int lane, f32x4 (&v)[4]) {
    const f32x4* xr = (const f32x4*)p + lane;
#pragma unroll
    for (int j = 0; j < 4; ++j) v[j] = xr[64 * j];
}
__device__ __forceinline__ void row_store(float* p, int lane, const f32x4 (&v)[4]) {
    f32x4* xr = (f32x4*)p + lane;
#pragma unroll
    for (int j = 0; j < 4; ++j) xr[64 * j] = v[j];
}
__device__ __forceinline__ void row_load_bf(const bf16_t* p, int lane, f32x4 (&v)[4]) {
    const u32x2* xr = (const u32x2*)p + lane; u32x2 t[4];
#pragma unroll
    for (int j = 0; j < 4; ++j) t[j] = xr[64 * j];
#pragma unroll
    for (int j = 0; j < 4; ++j) v[j] = (f32x4){bf2f(t[j].x & 0xffffu), bf2f(t[j].x >> 16), bf2f(t[j].y & 0xffffu), bf2f(t[j].y >> 16)};
}
__device__ __forceinline__ void row_store_bf(bf16_t* p, int lane, const f32x4 (&v)[4]) {
    u32x2* xr = (u32x2*)p + lane;
#pragma unroll
    for (int j = 0; j < 4; ++j) { u32x2 w; w.x = pk2(v[j].x, v[j].y); w.y = pk2(v[j].z, v[j].w); xr[64 * j] = w; }
}
__device__ __forceinline__ float row_rstd(const f32x4 (&v)[4]) {
    float s = 0.f;
#pragma unroll
    for (int j = 0; j < 4; ++j) s += (v[j].x * v[j].x + v[j].y * v[j].y) + (v[j].z * v[j].z + v[j].w * v[j].w);
    return __builtin_amdgcn_rsqf(wave_sum(s) * (1.0f / D) + EPS);
}
__device__ __forceinline__ void norm_mod(f32x4 (&v)[4], const float* g, const float* sh, const float* sc, bf16_t* orow, int lane) {
    const float rstd = row_rstd(v);
    unsigned long long* o8 = (unsigned long long*)orow + lane;
#pragma unroll
    for (int j = 0; j < 4; ++j) {
        const f32x4 gg = ((const f32x4*)g)[lane + 64 * j], ss = ((const f32x4*)sh)[lane + 64 * j], cc = ((const f32x4*)sc)[lane + 64 * j];
        v[j] = (v[j] * rstd) * gg * (1.0f + cc) + ss;
        o8[64 * j] = (unsigned long long)pk2(v[j].x, v[j].y) | ((unsigned long long)pk2(v[j].z, v[j].w) << 32);
    }
}


__device__ __forceinline__ void load_mod(const float* g, const float* sh, const float* sc, int lane, f32x4 (&A)[4], f32x4 (&SH)[4]) {
#pragma unroll
    for (int j = 0; j < 4; ++j) { const f32x4 gg = ((const f32x4*)g)[lane + 64 * j], cc = ((const f32x4*)sc)[lane + 64 * j]; A[j] = gg * (1.0f + cc); SH[j] = ((const f32x4*)sh)[lane + 64 * j]; }
}
__device__ __forceinline__ void norm_mod2(f32x4 (&v)[4], const f32x4 (&A)[4], const f32x4 (&SH)[4], bf16_t* orow, int lane) {
    const float rstd = row_rstd(v);
    unsigned long long* o8 = (unsigned long long*)orow + lane;
#pragma unroll
    for (int j = 0; j < 4; ++j) { v[j] = (v[j] * rstd) * A[j] + SH[j];
        o8[64 * j] = (unsigned long long)pk2(v[j].x, v[j].y) | ((unsigned long long)pk2(v[j].z, v[j].w) << 32); }
}

__device__ __forceinline__ void norm_mod_lds(f32x4 (&v)[4], const LAS float* A, const LAS float* SH, bf16_t* orow, int lane) {
    const float rstd = row_rstd(v);
    unsigned long long* o8 = (unsigned long long*)orow + lane;
#pragma unroll
    for (int j = 0; j < 4; ++j) { v[j] = (v[j] * rstd) * *(const LAS f32x4*)(A + (lane + 64 * j) * 4) + *(const LAS f32x4*)(SH + (lane + 64 * j) * 4);
        o8[64 * j] = (unsigned long long)pk2(v[j].x, v[j].y) | ((unsigned long long)pk2(v[j].z, v[j].w) << 32); }
}

__device__ __forceinline__ float reduce16(const float (&p)[16], int lane) {
    float q8[8], q4[4], q2[2];
#pragma unroll
    for (int i = 0; i < 8; ++i) { auto rr = __builtin_amdgcn_permlane32_swap(__float_as_uint(p[i]), __float_as_uint(p[i + 8]), false, false); q8[i] = __uint_as_float(rr[0]) + __uint_as_float(rr[1]); }
    { const bool up = (lane & 16) != 0;
#pragma unroll
      for (int i = 0; i < 4; ++i) { const float snd = up ? q8[i] : q8[i + 4], kp = up ? q8[i + 4] : q8[i]; q4[i] = kp + __shfl_xor(snd, 16); } }
    { const bool up = (lane & 8) != 0;
#pragma unroll
      for (int i = 0; i < 2; ++i) { const float snd = up ? q4[i] : q4[i + 2], kp = up ? q4[i + 2] : q4[i]; q2[i] = kp + dpp<DPP_XOR8>(snd); } }
    float r;
    { const bool up = (lane & 4) != 0; const float snd = up ? q2[0] : q2[1], kp = up ? q2[1] : q2[0]; r = kp + dpp<DPP_HMIR>(snd); }
    r += dpp<DPP_XOR2>(r); r += dpp<DPP_XOR1>(r);
    return r;
}
__device__ __forceinline__ int lane_expert(int lane) { return ((lane >> 5) & 1) * 8 + ((lane >> 4) & 1) * 4 + ((lane >> 3) & 1) * 2 + ((lane >> 2) & 1); }

struct EpiInProj {
    static constexpr bool PERM = false, TWICE = true;
    bf16_t *Q, *Kb, *V, *U, *GV; const float *ropeC, *ropeS;
    __device__ __forceinline__ void operator()(const pg8::f32x4 (&acc)[2][2][4][2], const pg8::Unit& u, int wr, int wc, int fr_, int fq_) const {
        int fr = fr_, fq = fq_; asm volatile("" : "+v"(fr), "+v"(fq));
        const int type = u.pn >> 1;
        bf16_t* base = type == 0 ? Q : type == 1 ? Kb : type == 2 ? V : type == 3 ? U : GV;
        const int col0 = (u.pn & 1) * 256 + wc * 32 + 4 * fq;
        const int row0 = u.pm * 256 + wr * 64 + fr;
        const bool lat = (u.pm % 17) != 0;
        const float qs = (type == 0) ? 0.125f : 1.0f;
        if (type <= 1) {
            f32x4 csT[4], snT[4];
            const bool colax = (wc & 1) != 0;
#pragma unroll
            for (int t = 0; t < 4; ++t) { csT[t] = (f32x4){1.f, 1.f, 1.f, 1.f}; snT[t] = (f32x4){0.f, 0.f, 0.f, 0.f}; }
            if (lat) {
                if (colax) {
#pragma unroll
                    for (int m = 0; m < 4; ++m) { const int pos = m * 16 + fr; csT[m] = *(const f32x4*)(ropeC + pos * 16 + 4 * fq); snT[m] = *(const f32x4*)(ropeS + pos * 16 + 4 * fq); }
                } else {
#pragma unroll
                    for (int ai = 0; ai < 2; ++ai) { const int pos = (((row0 + ai * 128) % RPB) - CTXL) >> 6; csT[ai] = *(const f32x4*)(ropeC + pos * 16 + 4 * fq); snT[ai] = *(const f32x4*)(ropeS + pos * 16 + 4 * fq); }
                }
            }
            asm volatile("" ::: "memory");
#pragma unroll
            for (int ai = 0; ai < 2; ++ai)
#pragma unroll
                for (int m = 0; m < 4; ++m) {
                    const int row = row0 + ai * 128 + m * 16;
                    const f32x4 cs = colax ? csT[m] : csT[ai], sn = colax ? snT[m] : snT[ai];
                    bf16_t* rowp = base + (size_t)row * 512 + col0;
#pragma unroll
                    for (int bj = 0; bj < 2; ++bj) {
                        const f32x4 t0 = acc[ai][bj][m][0], t1 = acc[ai][bj][m][1];
                        const f32x4 o0 = (t0 * cs - t1 * sn) * qs, o1 = (t1 * cs + t0 * sn) * qs;
                        u32x2 w0, w1; w0.x = pk2(o0[0], o0[1]); w0.y = pk2(o0[2], o0[3]); w1.x = pk2(o1[0], o1[1]); w1.y = pk2(o1[2], o1[3]);
                        *(u32x2*)(rowp + bj * 128) = w0; *(u32x2*)(rowp + bj * 128 + 16) = w1;
                    }
                }
        } else if (type == 2) {
#pragma unroll
            for (int ai = 0; ai < 2; ++ai)
#pragma unroll
                for (int m = 0; m < 4; ++m) {
                    bf16_t* rowp = base + (size_t)(row0 + ai * 128 + m * 16) * 512 + col0;
#pragma unroll
                    for (int bj = 0; bj < 2; ++bj)
#pragma unroll
                        for (int n = 0; n < 2; ++n) {
                            const f32x4 v = acc[ai][bj][m][n];
                            u32x2 w; w.x = pk2(v[0], v[1]); w.y = pk2(v[2], v[3]);
                            *(u32x2*)(rowp + bj * 128 + n * 16) = w;
                        }
                }
        } else {
#pragma unroll
            for (int ai = 0; ai < 2; ++ai)
#pragma unroll
                for (int m = 0; m < 4; ++m) {
                    bf16_t* rowp = base + (size_t)(row0 + ai * 128 + m * 16) * 512 + col0;
                    u32x2 w[2][2];
#pragma unroll
                    for (int bj = 0; bj < 2; ++bj)
#pragma unroll
                        for (int n = 0; n < 2; ++n) {
                            f32x4 v = acc[ai][bj][m][n];
#ifdef GELU_X2
                            { f32x4 t_ = pg8::gelu4(v * 1.0001f); asm volatile("" :: "v"(t_)); }
#endif
                            v = pg8::gelu4(v);
                            w[bj][n].x = pk2(v[0], v[1]); w[bj][n].y = pk2(v[2], v[3]);
                        }
#pragma unroll
                    for (int bj = 0; bj < 2; ++bj)
#pragma unroll
                        for (int n = 0; n < 2; ++n) *(u32x2*)(rowp + bj * 128 + n * 16) = w[bj][n];
                }
        }
    }
};
struct EpiOutProj {
    static constexpr bool PERM = true, TWICE = false;
    bf16_t* XR; const float* modl; float scale;
    __device__ __forceinline__ void operator()(const pg8::f32x4 (&acc)[2][2][4][2], const pg8::Unit& u, int wr, int wc, int fr_, int fq_) const {
        int fr = fr_, fq = fq_; asm volatile("" : "+v"(fr), "+v"(fq));
        const int b = u.pm / 17; const int mrow = (u.pm % 17) == 0 ? 8 : b;
        const int col0 = u.pn * 256 + wc * 32 + 8 * fq, row0 = u.pm * 256 + wr * 64 + fr;
        const float* gp = modl + (size_t)mrow * 6144 + 2 * D + col0;
        f32x4 gv[2][2];
#pragma unroll
        for (int bj = 0; bj < 2; ++bj)
#pragma unroll
            for (int n = 0; n < 2; ++n) gv[bj][n] = *(const f32x4*)(gp + bj * 128 + n * 4);
#pragma unroll
        for (int ai = 0; ai < 2; ++ai) {
            u32x4 xv[4][2];
#pragma unroll
            for (int m = 0; m < 4; ++m)
#pragma unroll
                for (int bj = 0; bj < 2; ++bj) xv[m][bj] = *(const u32x4*)(XR + (size_t)(row0 + ai * 128 + m * 16) * D + col0 + bj * 128);
            asm volatile("" ::: "memory");
#pragma unroll
            for (int m = 0; m < 4; ++m)
#pragma unroll
                for (int bj = 0; bj < 2; ++bj) {
                    const u32x4 x = xv[m][bj];
                    const f32x4 x0 = (f32x4){bf2f(x.x & 0xffffu), bf2f(x.x >> 16), bf2f(x.y & 0xffffu), bf2f(x.y >> 16)}, x1 = (f32x4){bf2f(x.z & 0xffffu), bf2f(x.z >> 16), bf2f(x.w & 0xffffu), bf2f(x.w >> 16)};
                    const f32x4 o0 = x0 + gv[bj][0] * acc[ai][bj][m][0], o1 = x1 + gv[bj][1] * acc[ai][bj][m][1];
                    u32x4 w; w.x = pk2(o0.x, o0.y); w.y = pk2(o0.z, o0.w); w.z = pk2(o1.x, o1.y); w.w = pk2(o1.z, o1.w);
                    *(u32x4*)(XR + (size_t)(row0 + ai * 128 + m * 16) * D + col0 + bj * 128) = w;
                }
            asm volatile("" ::: "memory");
        }
    }
};
struct EpiGateUp {
    static constexpr bool PERM = true;
    bf16_t* HID;
    __device__ __forceinline__ void operator()(const pg8::f32x4 (&acc)[2][2][4][2], const pg8::Unit& u, int wr, int wc, int fr_, int fq_) const {
        int fr = fr_, fq = fq_; asm volatile("" : "+v"(fr), "+v"(fq));
        const int j = u.pn & 15; const int col0 = j * 128 + wc * 32 + 8 * fq, row0 = u.pm * 256 + wr * 64 + fr;
#pragma unroll
        for (int ai = 0; ai < 2; ++ai)
#pragma unroll
            for (int m = 0; m < 4; ++m) {
                float hv[8];
#pragma unroll
                for (int n = 0; n < 2; ++n)
#pragma unroll
                    for (int i = 0; i < 4; ++i) { const float gt = acc[ai][0][m][n][i], up = acc[ai][1][m][n][i];
                        hv[n * 4 + i] = gt * __builtin_amdgcn_rcpf(1.0f + __expf(-gt)) * up; }
                u32x4 w; w.x = pk2(hv[0], hv[1]); w.y = pk2(hv[2], hv[3]); w.z = pk2(hv[4], hv[5]); w.w = pk2(hv[6], hv[7]);
                *(u32x4*)(HID + (size_t)(row0 + ai * 128 + m * 16) * FF + col0) = w;
            }
    }
};
struct EpiDown {
    static constexpr bool PERM = true, TWICE = false;
    bf16_t* Y;
    __device__ __forceinline__ void operator()(const pg8::f32x4 (&acc)[2][2][4][2], const pg8::Unit& u, int wr, int wc, int fr_, int fq_) const {
        int fr = fr_, fq = fq_; asm volatile("" : "+v"(fr), "+v"(fq));
        const int col0 = (u.pn & 3) * 256 + wc * 32 + 8 * fq, row0 = u.pm * 256 + wr * 64 + fr;
#pragma unroll
        for (int ai = 0; ai < 2; ++ai)
#pragma unroll
            for (int m = 0; m < 4; ++m) { bf16_t* rowp = Y + (size_t)(row0 + ai * 128 + m * 16) * D + col0;
#pragma unroll
                for (int bj = 0; bj < 2; ++bj) { const f32x4 v0 = acc[ai][bj][m][0], v1 = acc[ai][bj][m][1];
                    u32x4 w; w.x = pk2(v0[0], v0[1]); w.y = pk2(v0[2], v0[3]); w.z = pk2(v1[0], v1[1]); w.w = pk2(v1[2], v1[3]);
                    *(u32x4*)(rowp + bj * 128) = w; } }
    }
};

#define GAS1 __attribute__((address_space(1)))
#define INP(i) ((const float*)(GAS1 const float*)lds_ptr(ptab, (i)))
#define MOD   ((float*)(ws + WS_MOD))
#define ROPEC ((float*)(ws + WS_ROPEC))
#define ROPES ((float*)(ws + WS_ROPES))
#define LAMV  ((float*)(ws + WS_LAM))
#define SGUW  ((bf16_t*)(ws + WS_SGUW))
#define XR    ((bf16_t*)(ws + WS_XR))
#define HA    ((bf16_t*)(ws + WS_HA))
#define QB    ((bf16_t*)(ws + WS_QB))
#define KB    ((bf16_t*)(ws + WS_KB))
#define VB    ((bf16_t*)(ws + WS_VB))
#define UB    ((bf16_t*)(ws + WS_UB))
#define GVB   ((bf16_t*)(ws + WS_GVB))
#define CAT   ((bf16_t*)(ws + WS_CAT))
#define OS    ((float*)(ws + WS_OS))
#define AFF   ((float*)(ws + WS_AFF))
#define INV   ((int*)(ws + WS_INV))
#define RSRC  ((int*)(ws + WS_RSRC))
#define XS    ((bf16_t*)(ws + WS_XS))
#define HID   ((bf16_t*)(ws + WS_HID))
#define Y     ((bf16_t*)(ws + WS_Y))
#define WIN   ((bf16_t*)(ws + WS_WIN))
#define WOUT  ((bf16_t*)(ws + WS_WOUT))
#define WGU   ((bf16_t*)(ws + WS_WGU))
#define WD    ((bf16_t*)(ws + WS_WD))
#define modl  (MOD + (size_t)l * 9 * 6144)
#define PIN_WS() unsigned char* const ws = (unsigned char*)(GAS1 unsigned char*)lds_ptr(ptab, 24)
#define PIN_IDS2() int tid = threadIdx.x; asm volatile("" : "+v"(tid)); const int lane = tid & 63, wave = __builtin_amdgcn_readfirstlane(tid >> 6)
#define PIN_IDS() int tid = threadIdx.x; asm volatile("" : "+v"(tid)); const int lane = tid & 63, wave = __builtin_amdgcn_readfirstlane(tid >> 6), gw = bx * NWAVES + wave; (void)lane; (void)gw; PIN_WS()
#ifndef PH_MASK
#define PH_MASK 0x7ff
#endif
#define INR(k) (lo <= (k) && (k) < hi)
#define IN(k) (((PH_MASK >> (k)) & 1) && INR(k))
#define INL(c) (((PH_MASK >> (2 + (c))) & 1) && INR(pb + (c)))
#ifndef PH_DUP
#define PH_DUP 0
#endif
#define REPS(c) (((PH_DUP >> (c)) & 1) ? 2 : 1)
#define SEAM(k) do { if (INR(k) && INR((k) + 1)) xcd_barrier(bar); } while (0)

constexpr size_t CTL_QUEUE = 16384;
__device__ __forceinline__ int queue_pull(unsigned* ctr, volatile LAS unsigned* slot, int tid) {
    __syncthreads();
    if (tid == 0) *slot = __hip_atomic_fetch_add(ctr, 1u, __ATOMIC_RELAXED, __HIP_MEMORY_SCOPE_AGENT);
    __syncthreads();
    return __builtin_amdgcn_readfirstlane((int)*slot);
}
constexpr int IT_IN = 16 * 80, IT_OUT = 16 * 32, IT_E = 1024, IT_L = IT_IN + IT_OUT + NE * 3 * IT_E;
__device__ __forceinline__ void convert_range(LAS unsigned long long* ptab, unsigned char* ws, LAS unsigned char* ldsl, int l, int it0, int it1, int rank, int nranks, int wave, int lane) {
    LAS float* scr = (LAS float*)(ldsl + 65536 + wave * 8704);
#pragma unroll 1
    for (int it = it0 + rank; it < it1; it += nranks) {
        int r = it;
        if (r < IT_IN) { const int kb = r / 80, nb = r % 80; transpose_item(INP(I_WIN) + (size_t)l * D * PROJ, PROJ, kb * 64, nb * 32, WIN + (size_t)l * PROJ * D, D, nb * 32, scr, lane); continue; }
        r -= IT_IN;
        if (r < IT_OUT) { const int kb = r / 32, nb = r % 32; transpose_item(INP(I_WOUT) + (size_t)l * D * D, D, kb * 64, nb * 32, WOUT + (size_t)l * D * D, D, nb * 32, scr, lane); continue; }
        r -= IT_OUT;
        if (r < NE * 2 * IT_E) { const int e = r / (2 * IT_E), which = (r % (2 * IT_E)) / IT_E, q = r % IT_E; const size_t le = (size_t)l * NE + e;
            const int kb = q / 64, nb = q % 64, n0 = nb * 32;
            transpose_item(INP(which == 0 ? I_WG : I_WU) + le * D * FF, FF, kb * 64, n0, WGU + le * (2 * FF) * D, D, 256 * (n0 >> 7) + which * 128 + (n0 & 127), scr, lane); continue; }
        r -= NE * 2 * IT_E;
        { const int e = r / IT_E, q = r % IT_E; const size_t le = (size_t)l * NE + e; const int kb = q / 32, nb = q % 32;
            transpose_item(INP(I_WDN) + le * FF * D, D, kb * 64, nb * 32, WD + le * D * FF, FF, nb * 32, scr, lane); }
    }
}
constexpr int CV_P = 26444, CV_Q = CV_P + 12000;
template <int L>
__device__ __forceinline__ void layer_body(unsigned char* lds, LAS unsigned char* ldsl, LAS unsigned long long* ptab, const XcdBarrier& bar, const int lo, const int hi, const int G, const int bx, const int NGW) {
    constexpr int l = L, pb = 2 + 9 * L; constexpr bool lastl = (L == DEPTH - 1);
        _Pragma("unroll 1") for (int rep = 0; rep < REPS(2); ++rep) {
        if (INL(0)) {
            PIN_WS();
            pg8::Gemm g{HA, WIN + (size_t)l * PROJ * D, RT, PROJ, D}; pg8::StaticOrder S; S.init(RT, PROJ, G, bx);
            EpiInProj E{QB, KB, VB, UB, GVB, ROPEC, ROPES};
            pg8::gemm_phase<EpiInProj, pg8::StaticOrder>(ldsl, g, S, E);
            if (G == 256 && bx >= 80) { PIN_IDS2(); convert_range(ptab, ws, ldsl, l, CV_P, CV_Q, (bx - 80) * NWAVES + wave, (G - 80) * NWAVES, wave, lane); }
        }
        SEAM(pb + 0); }
        _Pragma("unroll 1") for (int rep = 0; rep < REPS(3); ++rep) {
        if (INL(1)) {
            PIN_IDS();
            const float lam = LAMV[l], osc = 1.0f - kLamInit[l];
            const float* subg = INP(I_SUBG) + l * 128;
            constexpr int NU_LAT = NB * 4 * 16, NU_CTX = NB * 4, NU_SGU = NB * 34;
            const int vcu = (G % 8 == 0) ? (bx % 8) * (G / 8) + bx / 8 : bx;
            unsigned* qA = (unsigned*)(ws + WS_CTL + CTL_QUEUE + (l * 2 + 0) * 64); unsigned* qB = (unsigned*)(ws + WS_CTL + CTL_QUEUE + (l * 2 + 1) * 64);
            volatile LAS unsigned* qslot = (volatile LAS unsigned*)(ldsl + LDS_MISC + 16);
            bool dyn = false;
            for (int u = vcu;;) {
                if (!dyn && u >= NU_LAT) dyn = true;
                if (dyn) { if (lastl) break;
                    const int it = queue_pull(qA, qslot, tid); if (it >= NU_CTX) break; u = NU_LAT + it; }
                {
                    int b, h; long rq0; int nk;
                    if (u < NU_LAT) { b = u >> 6; h = (u >> 4) & 3; rq0 = (long)b * RPB + CTXL + (u & 15) * 256; nk = RPB; }
                    else { const int v2 = u - NU_LAT; b = v2 >> 2; h = v2 & 3; rq0 = (long)b * RPB; nk = CTXL; }
#ifndef NO_ATT
                    att::attn_unit(QB, KB, VB, OS, CAT, subg, lam, osc, h, rq0, (long)b * RPB, nk, (char*)lds);
#endif
                }
                if (!dyn) u += G;
            }
            {
            int tid2 = threadIdx.x; asm volatile("" : "+v"(tid2)); const int lane = tid2 & 63, wave = __builtin_amdgcn_readfirstlane(tid2 >> 6);
            constexpr int NHU = NU_SGU * 2;
            for (;;) { const int s = queue_pull(qB, qslot, tid2); if (s >= NHU) break;
                const int b = s / 68, rem = s % 68, ch = rem >> 1, hg = rem & 1;
                if (lastl && ch < 2) continue;
                {
#ifndef NO_SGU
                    const int hl2 = wave & 3, ph = wave >> 2, h = hg * 4 + hl2;
                    const size_t r0 = (size_t)b * RPB + ch * 128;
                    const int fr = lane & 15, fq = lane >> 4;
                    const bf16_t* Wh = SGUW + ((size_t)l * 8 + h) * 128 * 128;
                    const float* bs = INP(I_SGUB) + (l * 8 + h) * 128;
                    u32x4 uu[4][2]; bf16x8 afA[4], afB[4];
#pragma unroll
                    for (int i = 0; i < 4; ++i)
#pragma unroll
                        for (int gi = 0; gi < 2; ++gi) uu[i][gi] = *(const u32x4*)(UB + (r0 + (ph * 4 + i) * 16 + fr) * 512 + h * 64 + gi * 32 + fq * 8);
#pragma unroll
                    for (int ks = 0; ks < 4; ++ks) { afA[ks] = *(const bf16x8*)(Wh + (size_t)(ph * 64 + fr) * 128 + ks * 32 + fq * 8); afB[ks] = *(const bf16x8*)(Wh + (size_t)(ph * 64 + 16 + fr) * 128 + ks * 32 + fq * 8); }
                    {
                        const int hf = lane >> 5, l32 = lane & 31, hl = l32 >> 3, e8 = (l32 & 7) * 8;
                        const bf16_t* gsrc = GVB + (r0 + wave * 16 + hf * 8) * 512 + hg * 256 + l32 * 8;
                        const f32x4 ga = *(const f32x4*)(INP(I_SGUNG) + l * 512 + hg * 256 + l32 * 8), gb = *(const f32x4*)(INP(I_SGUNG) + l * 512 + hg * 256 + l32 * 8 + 4);
                        const float gg[8] = {ga.x, ga.y, ga.z, ga.w, gb.x, gb.y, gb.z, gb.w};
                        LAS bf16_t* gTh = (LAS bf16_t*)(ldsl + hl * 17424);
                        int slot[8];
#pragma unroll
                        for (int j = 0; j < 8; ++j) { const int e = e8 + j; slot[j] = ((e & 32) + 16 * ((e >> 2) & 1) + 4 * ((e & 31) >> 3) + (e & 3)) * 136; }
                        u32x4 raw[8];
#pragma unroll
                        for (int t = 0; t < 8; ++t) raw[t] = *(const u32x4*)(gsrc + t * 512);
#pragma unroll
                        for (int tb = 0; tb < 2; ++tb) {
                            float xn[4][8];
#pragma unroll
                            for (int t = 0; t < 4; ++t) {
                                float ssq = 0.f;
#pragma unroll
                                for (int k = 0; k < 4; ++k) { xn[t][2 * k] = bf2f(raw[tb * 4 + t][k] & 0xffffu); xn[t][2 * k + 1] = bf2f(raw[tb * 4 + t][k] >> 16); ssq += xn[t][2 * k] * xn[t][2 * k] + xn[t][2 * k + 1] * xn[t][2 * k + 1]; }
                                ssq += __shfl_xor(ssq, 1); ssq += __shfl_xor(ssq, 2); ssq += __shfl_xor(ssq, 4);
                                const float rs = __builtin_amdgcn_rsqf(ssq * (1.0f / 64.0f) + EPS);
#pragma unroll
                                for (int j = 0; j < 8; ++j) xn[t][j] = xn[t][j] * rs * gg[j];
                            }
                            const int q0 = wave * 16 + hf * 8 + tb * 4;
#pragma unroll
                            for (int j = 0; j < 8; ++j) { u32x2 w; w.x = pk2(xn[0][j], xn[1][j]); w.y = pk2(xn[2][j], xn[3][j]); *(LAS u32x2*)(gTh + slot[j] + q0) = w; }
                        }
                    }
                    __syncthreads();
                    {
                        LAS bf16_t* gT = (LAS bf16_t*)(ldsl + hl2 * 17424);
#pragma unroll
                        for (int i = 0; i < 4; ++i) {
                            const int p = (ph * 4 + i) * 16 + fr;
                            bf16x8 af[4];
#pragma unroll
                            for (int ks = 0; ks < 4; ++ks) af[ks] = (i & 1) ? afB[ks] : afA[ks];
                            if (i + 2 < 4) {
#pragma unroll
                                for (int ks = 0; ks < 4; ++ks) { const bf16x8 nv = *(const bf16x8*)(Wh + (size_t)(p + 32) * 128 + ks * 32 + fq * 8); if (i & 1) afB[ks] = nv; else afA[ks] = nv; } }
                            const float bsp = bs[p];
#pragma unroll
                            for (int gi = 0; gi < 2; ++gi) {
                                pg8::f32x4 a0 = (pg8::f32x4){0.f, 0.f, 0.f, 0.f}, a1 = (pg8::f32x4){0.f, 0.f, 0.f, 0.f};
#pragma unroll
                                for (int ks = 0; ks < 4; ++ks) {
                                    const bf16x8 b0 = *(const LAS bf16x8*)(gT + (gi * 32 + fr) * 136 + ks * 32 + fq * 8), b1 = *(const LAS bf16x8*)(gT + (gi * 32 + 16 + fr) * 136 + ks * 32 + fq * 8);
                                    a0 = __builtin_amdgcn_mfma_f32_16x16x32_bf16(b0, af[ks], a0, 0, 0, 0); a1 = __builtin_amdgcn_mfma_f32_16x16x32_bf16(b1, af[ks], a1, 0, 0, 0); }
                                const u32x4 ur = uu[i][gi];
                                u32x4 w;
                                w.x = pk2(bf2f(ur.x & 0xffffu) * (a0[0] + bsp), bf2f(ur.x >> 16) * (a0[1] + bsp)); w.y = pk2(bf2f(ur.y & 0xffffu) * (a0[2] + bsp), bf2f(ur.y >> 16) * (a0[3] + bsp));
                                w.z = pk2(bf2f(ur.z & 0xffffu) * (a1[0] + bsp), bf2f(ur.z >> 16) * (a1[1] + bsp)); w.w = pk2(bf2f(ur.w & 0xffffu) * (a1[2] + bsp), bf2f(ur.w >> 16) * (a1[3] + bsp));
                                *(u32x4*)(CAT + (r0 + p) * 1024 + 512 + h * 64 + gi * 32 + fq * 8) = w;
                            }
                            asm volatile("" ::: "memory");
                        }
                    }
                    LDS_WAIT(); asm volatile("" ::: "memory");
                    __syncthreads();
#endif
                }
            }
            }
        }
        SEAM(pb + 1); }
        _Pragma("unroll 1") for (int rep = 0; rep < REPS(4); ++rep) {
        if (INL(2)) {
            PIN_WS();
            pg8::Gemm g{CAT, WOUT + (size_t)l * D * D, RT, D, D}; pg8::GroupedOrder S; S.init(NB, lastl ? 16 : 17, 17, lastl ? 1 : 0, D / 256, 0, G, bx);
            EpiOutProj E{XR, modl, rep == 0 ? 1.0f : 0.0f};
            pg8::gemm_phase<EpiOutProj, pg8::GroupedOrder>(ldsl, g, S, E);
            if (G == 256 && bx >= 32) { PIN_IDS2(); convert_range(ptab, ws, ldsl, l, CV_Q, IT_L, (bx - 32) * NWAVES + wave, (G - 32) * NWAVES, wave, lane); }
        }
        SEAM(pb + 2); }
        _Pragma("unroll 1") for (int rep = 0; rep < REPS(5); ++rep) {
        if (INL(3)) {
            PIN_IDS();
            constexpr int WSTR = 1028;
            LAS float* wT = (LAS float*)ldsl;
            { const f32x4* wsrc = (const f32x4*)(INP(I_WR) + (size_t)l * 1024 * 16); f32x4 wv[8];
#pragma unroll
              for (int t = 0; t < 8; ++t) wv[t] = wsrc[tid + NTHR * t];
#pragma unroll
              for (int t = 0; t < 8; ++t) { const int i4 = tid + NTHR * t, k = i4 >> 2, e0 = (i4 & 3) * 4;
                  wT[(e0 + 0) * WSTR + k] = wv[t].x; wT[(e0 + 1) * WSTR + k] = wv[t].y; wT[(e0 + 2) * WSTR + k] = wv[t].z; wT[(e0 + 3) * WSTR + k] = wv[t].w; } }
            LAS float* modA = (LAS float*)(ldsl + 16 * WSTR * 4);
            LAS float* modS = modA + 9 * 1024;
            for (int i = tid; i < 9 * 256; i += NTHR) { const int c = i >> 8, k4 = i & 255;
                const float* mm = modl + (size_t)c * 6144; const f32x4 gg = ((const f32x4*)(INP(I_N2G) + l * D))[k4], ss = ((const f32x4*)(mm + 3 * D))[k4], cc = ((const f32x4*)(mm + 4 * D))[k4];
                *(LAS f32x4*)(modA + c * 1024 + k4 * 4) = gg * (1.0f + cc); *(LAS f32x4*)(modS + c * 1024 + k4 * 4) = ss; }
            __syncthreads();
            {
            constexpr int NG16 = RT / 16;
            const int r16 = lane & 15, kq = lane >> 4;
            const bool spread = (NGW == 2048);
#pragma unroll 1
            for (int pass = 0;; ++pass) {
                int grp;
                if (spread) { if (pass == 0) grp = gw; else if (pass == 1 && (gw & 15) == 0) grp = 2048 + (gw >> 4); else break; }
                else { grp = gw + pass * NGW; }
                if (grp >= NG16) break;
                const int row0 = grp * 16, b = row0 / RPB, j0 = row0 % RPB;
                if (lastl && j0 < CTXL) continue;
                const int mrow = (j0 < CTXL) ? 8 : b;
                const int row = row0 + r16;
                const u32x4* src = (const u32x4*)(XR + (size_t)row * D + 8 * kq);
                u32x4 raw[32];
#pragma unroll
                for (int t = 0; t < 32; ++t) raw[t] = src[4 * t];
                float ssq = 0.f;
#pragma unroll
                for (int t = 0; t < 32; ++t)
#pragma unroll
                    for (int c = 0; c < 4; ++c) { float lo_, hi_;
                        asm volatile("v_lshlrev_b32 %1, 16, %3\n\tv_and_b32 %2, 0xffff0000, %3\n\tv_fmac_f32 %0, %1, %1\n\tv_fmac_f32 %0, %2, %2" : "+v"(ssq), "=&v"(lo_), "=&v"(hi_) : "v"(raw[t][c])); }
                ssq = xrow16_sum(ssq);
                const float rstd = __builtin_amdgcn_rsqf(ssq * (1.0f / D) + EPS);
                const LAS float* Ac = modA + mrow * 1024 + 8 * kq; const LAS float* Sc = modS + mrow * 1024 + 8 * kq; const LAS float* Wc = wT + r16 * WSTR + 8 * kq;
                u32x4* dst = (u32x4*)(HA + (size_t)row * D + 8 * kq);
                pg8::f32x4 acc0 = (pg8::f32x4){0.f, 0.f, 0.f, 0.f}, acc1 = (pg8::f32x4){0.f, 0.f, 0.f, 0.f};
#pragma unroll
                for (int t = 0; t < 32; ++t) {
                    const f32x4 a0 = *(const LAS f32x4*)(Ac + 32 * t), a1 = *(const LAS f32x4*)(Ac + 32 * t + 4), s0 = *(const LAS f32x4*)(Sc + 32 * t), s1 = *(const LAS f32x4*)(Sc + 32 * t + 4);
                    const f32x4 w0 = *(const LAS f32x4*)(Wc + 32 * t), w1 = *(const LAS f32x4*)(Wc + 32 * t + 4);
                    const u32x4 rw = raw[t];
                    f32x4 h0 = (f32x4){bf2f(rw.x & 0xffffu), bf2f(rw.x >> 16), bf2f(rw.y & 0xffffu), bf2f(rw.y >> 16)}, h1 = (f32x4){bf2f(rw.z & 0xffffu), bf2f(rw.z >> 16), bf2f(rw.w & 0xffffu), bf2f(rw.w >> 16)};
                    h0 = (h0 * rstd) * a0 + s0; h1 = (h1 * rstd) * a1 + s1;
                    u32x4 o; o.x = pk2(h0.x, h0.y); o.y = pk2(h0.z, h0.w); o.z = pk2(h1.x, h1.y); o.w = pk2(h1.z, h1.w);
                    dst[4 * t] = o;
                    acc0 = __builtin_amdgcn_mfma_f32_16x16x4f32(w0.x, h0.x, acc0, 0, 0, 0); acc1 = __builtin_amdgcn_mfma_f32_16x16x4f32(w0.y, h0.y, acc1, 0, 0, 0);
                    acc0 = __builtin_amdgcn_mfma_f32_16x16x4f32(w0.z, h0.z, acc0, 0, 0, 0); acc1 = __builtin_amdgcn_mfma_f32_16x16x4f32(w0.w, h0.w, acc1, 0, 0, 0);
                    acc0 = __builtin_amdgcn_mfma_f32_16x16x4f32(w1.x, h1.x, acc0, 0, 0, 0); acc1 = __builtin_amdgcn_mfma_f32_16x16x4f32(w1.y, h1.y, acc1, 0, 0, 0);
                    acc0 = __builtin_amdgcn_mfma_f32_16x16x4f32(w1.z, h1.z, acc0, 0, 0, 0); acc1 = __builtin_amdgcn_mfma_f32_16x16x4f32(w1.w, h1.w, acc1, 0, 0, 0);
                    asm volatile("" ::: "memory");
                }
                const pg8::f32x4 lg = acc0 + acc1;
                float mx = fmaxf(fmaxf(lg[0], lg[1]), fmaxf(lg[2], lg[3])); mx = xrow16_max(mx);
                f32x4 ex; ex.x = expf(lg[0] - mx); ex.y = expf(lg[1] - mx); ex.z = expf(lg[2] - mx); ex.w = expf(lg[3] - mx);
                float sm = (ex.x + ex.y) + (ex.z + ex.w); sm = xrow16_sum(sm);
                const float inv = 1.0f / sm;
                *(f32x4*)(AFF + (size_t)row * 16 + 4 * kq) = ex * inv;
            }
            }
            __syncthreads();
        }
        SEAM(pb + 3); }
        _Pragma("unroll 1") for (int rep = 0; rep < REPS(6); ++rep) {
        if (INL(4)) {
            PIN_IDS();
            LAS unsigned* keys = (LAS unsigned*)ldsl;
            LAS unsigned* hist = keys + 4096;
            LAS unsigned* wtot = hist + 256;
            LAS unsigned* sel = wtot + 8;
            for (int gq = bx; gq < (lastl ? 128 : 256); gq += G) {
                const int stream = gq >> 7, b = (gq >> 4) & 7, e = gq & 15;
                const int n = stream ? CTXL : SEQ, cap = stream ? CAP_C : CAP_L;
                const int row0 = b * RPB + (stream ? 0 : CTXL), sbase = stream ? NB * CAP_L + b * CAP_C : b * CAP_L;
                { unsigned kv8[8];
#pragma unroll
                  for (int t = 0; t < 8; ++t) { const int i = tid + NTHR * t; kv8[t] = (i < n) ? __float_as_uint(AFF[(size_t)(row0 + i) * 16 + e]) : 0u; }
#pragma unroll
                  for (int t = 0; t < 8; ++t) { const int i = tid + NTHR * t; if (i < n) keys[i] = kv8[t]; } }
                unsigned prefix = 0u, mask = 0u, kk = (unsigned)cap;
                for (int pass = 0; pass < 4; ++pass) {
                    const int shift = 24 - 8 * pass;
                    if (tid < 256) hist[tid] = 0u;
                    __syncthreads();
                    for (int i = tid; i < n; i += NTHR) { const unsigned kv = keys[i]; if ((kv & mask) == prefix) __hip_atomic_fetch_add(&hist[(kv >> shift) & 255u], 1u, __ATOMIC_RELAXED, __HIP_MEMORY_SCOPE_WORKGROUP); }
                    __syncthreads();
                    if (wave == 0) {
                        const unsigned c0 = hist[4 * lane], c1 = hist[4 * lane + 1], c2 = hist[4 * lane + 2], c3 = hist[4 * lane + 3], tot = (c0 + c1) + (c2 + c3);
                        unsigned inc = tot;
#pragma unroll
                        for (int o = 1; o < 64; o <<= 1) { const unsigned t = __shfl_down(inc, o); if (lane + o < 64) inc += t; }
                        const unsigned excl = inc - tot;
                        if (excl < kk && excl + tot >= kk) { unsigned run = excl, dsel, knew;
                            if (run + c3 >= kk) { dsel = 4u * lane + 3u; knew = kk - run; }
                            else { run += c3; if (run + c2 >= kk) { dsel = 4u * lane + 2u; knew = kk - run; }
                                else { run += c2; if (run + c1 >= kk) { dsel = 4u * lane + 1u; knew = kk - run; } else { run += c1; dsel = 4u * lane; knew = kk - run; } } }
                            sel[0] = dsel; sel[1] = knew; } }
                    __syncthreads();
                    prefix |= sel[0] << shift; mask |= 0xFFu << shift; kk = sel[1];
                    __syncthreads();
                }
                const int chunk = (n >= NTHR) ? n / NTHR : 1, i0 = tid * chunk; const bool active = i0 < n;
                unsigned cg = 0u, ce = 0u;
                if (active) for (int i = 0; i < chunk; ++i) { const unsigned kv = keys[i0 + i]; cg += kv > prefix; ce += kv == prefix; }
                unsigned pk = cg | (ce << 16), incl = pk;
#pragma unroll
                for (int o = 1; o < 64; o <<= 1) { const unsigned t = __shfl_up(incl, o); if (lane >= o) incl += t; }
                if (lane == 63) wtot[wave] = incl;
                __syncthreads();
                unsigned wbase = 0u;
                for (int w = 0; w < wave; ++w) wbase += wtot[w];
                unsigned excl = wbase + incl - pk; unsigned ng = excl & 0xffffu, ne = excl >> 16;
                if (active) for (int i = 0; i < chunk; ++i) { const unsigned kv = keys[i0 + i]; const int row = row0 + i0 + i;
                    const bool isg = kv > prefix, ise = kv == prefix; const bool take = isg || (ise && ne < kk);
                    const unsigned slot = ng + (ne < kk ? ne : kk);
                    if (take) { RSRC[(size_t)e * ER + sbase + slot] = row; INV[(size_t)row * 16 + e] = sbase + (int)slot; } else INV[(size_t)row * 16 + e] = -1;
                    ng += isg; ne += ise; }
                __syncthreads();
            }
        }
        SEAM(pb + 4); }
        _Pragma("unroll 1") for (int rep = 0; rep < REPS(8); ++rep) {
        if (INL(6)) {
            PIN_WS();
            pg8::Gemm g{HA, WGU + (size_t)l * NE * 2 * FF * D, NE * ER, NE * 2 * FF, D}; pg8::GroupedOrder S; S.init(NE, lastl ? 16 : 17, 17, 0, 2 * FF / 256, 2 * FF / 256, G, bx);
            EpiGateUp E{HID};
            pg8::gemm_phase_gather<EpiGateUp, pg8::GroupedOrder, 17>(ldsl, g, S, E, RSRC, (LAS unsigned short*)(ldsl + pg8::STAGE_BYTES));
        }
        SEAM(pb + 6); }
        _Pragma("unroll 1") for (int rep = 0; rep < REPS(9); ++rep) {
        if (INL(7)) {
            PIN_WS();
            pg8::Gemm g{HID, WD + (size_t)l * NE * D * FF, NE * ER, NE * D, FF}; pg8::GroupedOrder S; S.init(NE, lastl ? 16 : 17, 17, 0, D / 256, D / 256, G, bx);
            EpiDown E{Y};
            pg8::gemm_phase<EpiDown, pg8::GroupedOrder>(ldsl, g, S, E);
            if (!lastl && G == 256 && bx >= 64) { PIN_IDS2(); convert_range(ptab, ws, ldsl, l + 1, 0, CV_P, (bx - 64) * NWAVES + wave, (G - 64) * NWAVES, wave, lane); }
        }
        SEAM(pb + 7); }
        _Pragma("unroll 1") for (int rep = 0; rep < REPS(10); ++rep) {
        if (INL(8)) {
            PIN_IDS();
            const float g2s = (rep == 0 || lastl) ? 1.0f : 0.0f;
            f32x4 mA[4], mSH[4], mG2[4]; int curm = -1;
#pragma unroll 1
            for (int wslot = gw; wslot < RT / 17; wslot += NGW) { const int wrow0 = wslot * 17;
#pragma unroll 1
            for (int it = 0; it < 9; ++it) {
                const int kL = (lane >> 4) & 1; const int idxL = it * 2 + kL; const int rowL = wrow0 + (idxL < 17 ? idxL : 16);
                int myinv = INV[(size_t)rowL * 16 + (lane & 15)]; const float myaff = AFF[(size_t)rowL * 16 + (lane & 15)];
                if (idxL >= 17 || (lastl && (rowL % RPB) < CTXL)) myinv = -1;
                f32x4 v[2][4];
#pragma unroll
                for (int k = 0; k < 2; ++k) { const int idx = it * 2 + k; const int row = wrow0 + (idx < 17 ? idx : 16); row_load_bf(XR + (size_t)row * D, lane, v[k]); }
                const unsigned long long sel = __ballot(myinv >= 0);
                u32x2 y0[2][4], y1[2][4]; float g0[2], g1[2]; unsigned rest[2];
#pragma unroll
                for (int k = 0; k < 2; ++k) {
                    unsigned mk = (unsigned)(sel >> (16 * k)) & 0xffffu; g0[k] = 0.f; g1[k] = 0.f;
#pragma unroll
                    for (int jj = 0; jj < 4; ++jj) { y0[k][jj] = (u32x2){0u, 0u}; y1[k][jj] = (u32x2){0u, 0u}; }
                    if (mk) { const int e = __builtin_ctz(mk); mk &= mk - 1; const int slot = __builtin_amdgcn_readlane(myinv, 16 * k + e); g0[k] = __builtin_bit_cast(float, __builtin_amdgcn_readlane(__builtin_bit_cast(int, myaff), 16 * k + e));
                        const u32x2* yp = (const u32x2*)(Y + ((size_t)e * ER + slot) * D) + lane;
#pragma unroll
                        for (int jj = 0; jj < 4; ++jj) y0[k][jj] = yp[64 * jj]; }
                    if (mk) { const int e = __builtin_ctz(mk); mk &= mk - 1; const int slot = __builtin_amdgcn_readlane(myinv, 16 * k + e); g1[k] = __builtin_bit_cast(float, __builtin_amdgcn_readlane(__builtin_bit_cast(int, myaff), 16 * k + e));
                        const u32x2* yp = (const u32x2*)(Y + ((size_t)e * ER + slot) * D) + lane;
#pragma unroll
                        for (int jj = 0; jj < 4; ++jj) y1[k][jj] = yp[64 * jj]; }
                    rest[k] = mk;
                }
#pragma unroll
                for (int k = 0; k < 2; ++k) {
                    const int idx = it * 2 + k; if (idx >= 17) continue; const int row = wrow0 + idx;
                    const int b = row / RPB, j = row % RPB; const bool isctx = j < CTXL;
                    if (lastl && isctx) continue;
                    const int mrow = isctx ? 8 : b;
                    if (mrow != curm) { curm = mrow; const float* m = modl + (size_t)mrow * 6144;
#pragma unroll
                        for (int jj = 0; jj < 4; ++jj) mG2[jj] = ((const f32x4*)(m + 5 * D))[lane + 64 * jj] * g2s;
                        if (!lastl) { const float* m2 = MOD + (size_t)(l + 1) * 9 * 6144 + (size_t)mrow * 6144; load_mod(INP(I_N1G) + (l + 1) * D, m2 + 0 * D, m2 + 1 * D, lane, mA, mSH); }
                        else {
#pragma unroll
                            for (int jj = 0; jj < 4; ++jj) mA[jj] = ((const f32x4*)INP(I_NFG))[lane + 64 * jj]; } }
                    f32x4 a[4];
#pragma unroll
                    for (int jj = 0; jj < 4; ++jj) {
                        a[jj].x = g0[k] * bf2f(y0[k][jj].x & 0xffffu) + g1[k] * bf2f(y1[k][jj].x & 0xffffu); a[jj].y = g0[k] * bf2f(y0[k][jj].x >> 16) + g1[k] * bf2f(y1[k][jj].x >> 16);
                        a[jj].z = g0[k] * bf2f(y0[k][jj].y & 0xffffu) + g1[k] * bf2f(y1[k][jj].y & 0xffffu); a[jj].w = g0[k] * bf2f(y0[k][jj].y >> 16) + g1[k] * bf2f(y1[k][jj].y >> 16); }
                    unsigned mk = rest[k];
#pragma unroll 1
                    while (mk) { const int e = __builtin_ctz(mk); mk &= mk - 1; const int slot = __builtin_amdgcn_readlane(myinv, 16 * k + e); const float ga = __builtin_bit_cast(float, __builtin_amdgcn_readlane(__builtin_bit_cast(int, myaff), 16 * k + e));
                        const u32x2* yp = (const u32x2*)(Y + ((size_t)e * ER + slot) * D) + lane;
#pragma unroll
                        for (int jj = 0; jj < 4; ++jj) { const u32x2 yy = yp[64 * jj];
                            a[jj].x += ga * bf2f(yy.x & 0xffffu); a[jj].y += ga * bf2f(yy.x >> 16); a[jj].z += ga * bf2f(yy.y & 0xffffu); a[jj].w += ga * bf2f(yy.y >> 16); } }
#pragma unroll
                    for (int jj = 0; jj < 4; ++jj) v[k][jj] = v[k][jj] + mG2[jj] * a[jj];
                    if (!lastl) {
                        row_store_bf(XR + (size_t)row * D, lane, v[k]);
                        norm_mod2(v[k], mA, mSH, HA + (size_t)row * D, lane);
                    } else {
                        const float rstd = row_rstd(v[k]);
                        float* orow = (float*)(GAS1 float*)lds_ptr(ptab, 23) + ((size_t)b * SEQ + (j - CTXL)) * D;
#pragma unroll
                        for (int jj = 0; jj < 4; ++jj) ((f32x4*)orow)[lane + 64 * jj] = (v[k][jj] * rstd) * mA[jj];
                    }
                }
            } }
        }
        if (!lastl) SEAM(pb + 8); }
    }

__global__ void __launch_bounds__(NTHR, 2) fwd(Args args) {
    extern __shared__ __attribute__((aligned(16))) unsigned char lds[];
    LAS unsigned char* ldsl = (LAS unsigned char*)lds;
    const int tid0 = threadIdx.x;
    const int G = gridDim.x, bx = blockIdx.x, NGW = G * NWAVES;
    LAS unsigned long long* ptab = (LAS unsigned long long*)(ldsl + LDS_MISC + 32);
    if (tid0 < 8) ((LAS unsigned*)(ldsl + LDS_MISC))[tid0] = 0u;
    if (tid0 < 25) ptab[tid0] = (tid0 < 23) ? (unsigned long long)args.in[tid0] : (tid0 == 23) ? (unsigned long long)args.out : (unsigned long long)args.ws;
    __syncthreads();
    XcdBarrier bar = xcd_barrier_post((unsigned*)(args.ws + WS_CTL), (volatile LAS unsigned*)(ldsl + LDS_MISC));
    const int lo = args.ph_lo, hi = args.ph_hi;

    _Pragma("unroll 1") for (int rep = 0; rep < REPS(0); ++rep) {
    if (IN(0)) {
            PIN_IDS();
        {
            LAS float* svec = (LAS float*)ldsl;
            LAS float* part = (LAS float*)(ldsl + 9 * 1024 * 4);
            bool have = false;
            for (int u = bx; u < DEPTH * 48; u += G) {
                if (!have) {
                    for (int i = tid; i < 9 * 1024; i += NTHR) { const int r = i >> 10, k = i & 1023; const float x = (r < 8) ? INP(I_C)[r * 1024 + k] : INP(I_CCTX)[k]; svec[i] = x / (1.0f + __expf(-x)); }
                    have = true; __syncthreads();
                }
                const int l = u / 48, j0 = (u % 48) * 128, c4 = tid & 31, kg = tid >> 5;
                const float* w = INP(I_WADA) + (size_t)l * 1024 * 6144 + j0 + 4 * c4;
                f32x4 a[9];
#pragma unroll
                for (int r = 0; r < 9; ++r) a[r] = (f32x4){0.f, 0.f, 0.f, 0.f};
#pragma unroll 2
                for (int k = kg * 64; k < kg * 64 + 64; k += 4) {
                    f32x4 wv[4];
#pragma unroll
                    for (int i = 0; i < 4; ++i) wv[i] = *(const f32x4*)(w + (size_t)(k + i) * 6144);
#pragma unroll
                    for (int r = 0; r < 9; ++r) { const f32x4 sv = *(const LAS f32x4*)(svec + r * 1024 + k);
                        a[r] = a[r] + wv[0] * sv.x + wv[1] * sv.y + wv[2] * sv.z + wv[3] * sv.w; } }
#pragma unroll
                for (int r = 0; r < 9; ++r) *(LAS f32x4*)(part + (kg * 9 + r) * 128 + 4 * c4) = a[r];
                __syncthreads();
                for (int i = tid; i < 9 * 128; i += NTHR) { const int r = i >> 7, c2 = i & 127; float sum = INP(I_BADA)[l * 6144 + j0 + c2];
#pragma unroll
                    for (int g = 0; g < 16; ++g) sum += part[(g * 9 + r) * 128 + c2];
                    MOD[((size_t)l * 9 + r) * 6144 + j0 + c2] = sum; }
                __syncthreads();
            }
            __syncthreads();
        }
        if (bx == G - 1) {
            for (int i = tid; i < 64 * 16; i += NTHR) { const int pos = i >> 4, f = i & 15; double s, c; sincos_d((double)pos * kFreq[f], s, c); ROPEC[i] = (float)c; ROPES[i] = (float)s; }
            if (wave < DEPTH) { const int l = wave;
                const float d1 = wave_sum(INP(I_LQ1)[l * 64 + lane] * INP(I_LK1)[l * 64 + lane]), d2 = wave_sum(INP(I_LQ2)[l * 64 + lane] * INP(I_LK2)[l * 64 + lane]);
                if (lane == 0) LAMV[l] = expf(d1) - expf(d2) + kLamInit[l]; }
        }
        for (int i = bx * NTHR + tid; i < DEPTH * 8 * 128 * 128 / 4; i += G * NTHR) { const f32x4 v = ((const f32x4*)INP(I_SGUW))[i]; u32x2 w; w.x = pk2(v.x, v.y); w.y = pk2(v.z, v.w); ((u32x2*)SGUW)[i] = w; }
        convert_range(ptab, ws, ldsl, 0, 0, G == 256 ? CV_P : IT_L, gw, NGW, wave, lane);
        if (G != 256) {
#pragma unroll 1
            for (int l2 = 1; l2 < DEPTH; ++l2) convert_range(ptab, ws, ldsl, l2, 0, IT_L, gw, NGW, wave, lane); }
    }
    SEAM(0); }
    if (IN(1)) {
            PIN_IDS();
        f32x4 mA[4], mSH[4]; int curm = -1;
#pragma unroll 1
        for (int wslot = gw; wslot < RT / 17; wslot += NGW) { const int wrow0 = wslot * 17;
#pragma unroll 1
        for (int it = 0; it < 5; ++it) {
            f32x4 v[4][4];
#pragma unroll
            for (int k = 0; k < 4; ++k) { const int idx = it * 4 + k; const int row = wrow0 + (idx < 17 ? idx : 16); const int b = row / RPB, j = row % RPB;
                const float* src = (j < CTXL) ? INP(I_CTX) + ((size_t)b * CTXL + j) * D : INP(I_X) + ((size_t)b * SEQ + (j - CTXL)) * D; row_load(src, lane, v[k]); }
#pragma unroll
            for (int k = 0; k < 4; ++k) { const int idx = it * 4 + k; if (idx >= 17) continue; const int row = wrow0 + idx; const int b = row / RPB, j = row % RPB;
                row_store_bf(XR + (size_t)row * D, lane, v[k]);
                const int mrow = (j < CTXL) ? 8 : b;
                if (mrow != curm) { curm = mrow; const float* m = MOD + (size_t)mrow * 6144; load_mod(INP(I_N1G), m + 0 * D, m + 1 * D, lane, mA, mSH); }
                norm_mod2(v[k], mA, mSH, HA + (size_t)row * D, lane); }
        } }
    }
    SEAM(1);

    layer_body<0>(lds, ldsl, ptab, bar, lo, hi, G, bx, NGW);
    layer_body<1>(lds, ldsl, ptab, bar, lo, hi, G, bx, NGW);
    layer_body<2>(lds, ldsl, ptab, bar, lo, hi, G, bx, NGW);
    layer_body<3>(lds, ldsl, ptab, bar, lo, hi, G, bx, NGW);
}

#ifndef MK_LAUNCHES_PER_PHASE
#define MK_LAUNCHES_PER_PHASE 0
#endif
extern "C" void kernel_launch(void* const* d_in, const int* in_sizes, int n_in, void* d_out, int out_size, void* d_ws, size_t ws_size, hipStream_t stream) {
    static int grid = 0;
    if (grid == 0) {
        if (n_in != 23 || out_size != NB * SEQ * D || ws_size < WS_END) { fprintf(stderr, "kernel_launch: unexpected shapes: n_in %d out %d ws %zu (need %zu)\n", n_in, out_size, ws_size, (size_t)WS_END); grid = -1; return; }
        int dev = 0, cus = 0, per_cu = 0;
        if (hipGetDevice(&dev) != hipSuccess || hipDeviceGetAttribute(&cus, hipDeviceAttributeMultiprocessorCount, dev) != hipSuccess) { grid = -1; return; }
        if (hipFuncSetAttribute((const void*)fwd, hipFuncAttributeMaxDynamicSharedMemorySize, LDS_BYTES) != hipSuccess) { fprintf(stderr, "kernel_launch: hipFuncSetAttribute failed\n"); grid = -1; return; }
        if (hipOccupancyMaxActiveBlocksPerMultiprocessor(&per_cu, (const void*)fwd, NTHR, LDS_BYTES) != hipSuccess || per_cu < 1) { fprintf(stderr, "kernel_launch: occupancy query says %d blocks per CU\n", per_cu); }
        (void)hipGetLastError();
        grid = cus;
        if (grid > 256) grid = 256;
    }
    if (grid < 0) return;
    (void)hipMemsetAsync((char*)d_ws + WS_CTL, 0, CTL_BYTES, stream);
    Args a{};
    for (int i = 0; i < 23; ++i) a.in[i] = (const float*)d_in[i];
    a.out = (float*)d_out; a.ws = (unsigned char*)d_ws;
    constexpr int NPH = 2 + 9 * DEPTH;
#if MK_LAUNCHES_PER_PHASE
    for (int p = 0; p < NPH; ++p) { a.ph_lo = p; a.ph_hi = p + 1; hipLaunchKernelGGL(fwd, dim3(grid), dim3(NTHR), LDS_BYTES, stream, a); }
#else
    a.ph_lo = 0; a.ph_hi = NPH;
    hipLaunchKernelGGL(fwd, dim3(grid), dim3(NTHR), LDS_BYTES, stream, a);
#endif
    const hipError_t le = hipPeekAtLastError();
    if (le != hipSuccess) fprintf(stderr, "kernel_launch: launch failed: %s\n", hipGetErrorName(le));
}
```

```cpp
#include <hip/hip_runtime.h>
#include <cstdio>
#include <cstdint>
namespace pg8 {
#define PG8_LAS __attribute__((address_space(3)))
typedef unsigned short bf16_t;
typedef short bf16x8 __attribute__((ext_vector_type(8)));
typedef float f32x4 __attribute__((ext_vector_type(4)));
typedef float f32x2 __attribute__((ext_vector_type(2)));
typedef unsigned u32x4 __attribute__((ext_vector_type(4)));
typedef unsigned u32x2 __attribute__((ext_vector_type(2)));
constexpr int BM = 256, BK = 64, HALF = 128, HTB = HALF * BK * 2  , STAGE_BYTES = 8 * HTB, NXCD = 8, WGM = 8;

__host__ __device__ __forceinline__ int lds_byte(int r, int c) { const int st = (r >> 4) * 2 + (c >> 5), rr = r & 15, cc = c & 31, ob = rr * 64 + cc * 2; return st * 1024 + (ob ^ (((ob >> 9) & 1) << 5)); }
__host__ __device__ __forceinline__ void stage_rc(int b, int& R, int& C) { const int st = b / 1024, sb = b % 1024, swz = sb ^ (((sb >> 9) & 1) << 5); R = (st >> 1) * 16 + swz / 64; C = (st & 1) * 32 + (swz % 64) / 2; }
__host__ __device__ __forceinline__ int perm32(int rho) { const int n = rho >> 4, i = rho & 15; return 8 * (i >> 2) + 4 * n + (i & 3); }

struct Unit { int pm, pn; };
struct Gemm { const bf16_t* A; const bf16_t* Bt; int M, N, K; };

struct StaticOrder {
    int nM, nN, nwg, G, c;
    __host__ __device__ void init(int M, int N, int G_, int c_) { nM = M / BM; nN = N / BM; nwg = nM * nN; G = G_; c = c_; }
    __host__ __device__ bool next(int i, Unit& u) const {
        const long L = (long)i * G + c; if (L >= nwg) return false;
        int wgid = (int)L; { const int q = nwg / NXCD, r = nwg % NXCD, xcd = wgid % NXCD, off = wgid / NXCD; wgid = (xcd < r ? xcd * (q + 1) : r * (q + 1) + (xcd - r) * q) + off; }
        const int nig = WGM * nN, gid = wgid / nig, fm = gid * WGM, gsz = (nM - fm) < WGM ? (nM - fm) : WGM;
        u.pm = fm + ((wgid % nig) % gsz); u.pn = (wgid % nig) / gsz; return true;
    }
    __device__ __forceinline__ void a_ready(const Unit&) const {}
    __device__ __forceinline__ void done(const Unit&) const {}
};
struct GroupedOrder {
    int TM, TN, TMS, MOFF, BGS, nunits, G, c;
    __host__ __device__ void init(int NG, int TM_, int TMS_, int MOFF_, int TN_, int BGS_, int G_, int c_) { TM = TM_; TN = TN_; TMS = TMS_; MOFF = MOFF_; BGS = BGS_; nunits = NG * TM_ * TN_; G = G_; c = c_; }
    __host__ __device__ bool next(int i, Unit& u) const {
        const long L = (long)i * G + c; if (L >= nunits) return false;
        int wgid = (int)L; { const int q = nunits / NXCD, r = nunits % NXCD, xcd = wgid % NXCD, off = wgid / NXCD; wgid = (xcd < r ? xcd * (q + 1) : r * (q + 1) + (xcd - r) * q) + off; }
        const int per = TM * TN, e = wgid / per, w = wgid % per;
        const int nig = WGM * TN, gid = w / nig, fm = gid * WGM, gsz = (TM - fm) < WGM ? (TM - fm) : WGM;
        u.pm = e * TMS + MOFF + fm + ((w % nig) % gsz); u.pn = e * BGS + (w % nig) / gsz; return true;
    }
    __device__ __forceinline__ void a_ready(const Unit&) const {}
    __device__ __forceinline__ void done(const Unit&) const {}
};

__device__ __forceinline__ unsigned cvt_pk_bf16(float lo, float hi) { unsigned r; asm volatile("v_cvt_pk_bf16_f32 %0, %1, %2" : "=v"(r) : "v"(lo), "v"(hi)); return r; }
__device__ __forceinline__ f32x2 gelu_pk(f32x2 v) {
    f32x2 d; d.x = __builtin_fmaf(__builtin_fabsf(v.x), 0.2316418882f, 1.0f); d.y = __builtin_fmaf(__builtin_fabsf(v.y), 0.2316418882f, 1.0f);
    f32x2 t; t.x = __builtin_amdgcn_rcpf(d.x); t.y = __builtin_amdgcn_rcpf(d.y);
    f32x2 q = t * 0.5307027145f + (-0.7265760135f); q = q * t + 0.7107068705f; q = q * t + (-0.142248368f); q = q * t + 0.127414796f; q = q * t;
    const f32x2 s = (v * v) * (-0.72134752044f);
    f32x2 e; e.x = __builtin_amdgcn_exp2f(s.x); e.y = __builtin_amdgcn_exp2f(s.y);
    const f32x2 c = q * e;
    float rx, ry; asm("v_max_f32 %0, 0, %1" : "=v"(rx) : "v"(v.x)); asm("v_max_f32 %0, 0, %1" : "=v"(ry) : "v"(v.y));
    f32x2 o; o.x = __builtin_fmaf(-__builtin_fabsf(v.x), c.x, rx); o.y = __builtin_fmaf(-__builtin_fabsf(v.y), c.y, ry); return o;
}
__device__ __forceinline__ f32x4 gelu4(f32x4 v) { const f32x2 a = gelu_pk((f32x2){v[0], v[1]}), b = gelu_pk((f32x2){v[2], v[3]}); return (f32x4){a.x, a.y, b.x, b.y}; }

template <class Epi, class Sched, bool ALIGN_EPI = true, bool SP2 = true>
__device__ __forceinline__ void gemm_phase(PG8_LAS unsigned char* lds, const Gemm g, const Sched& S, const Epi& E) {
    int tid = threadIdx.x; asm volatile("" : "+v"(tid));
    const int wid = __builtin_amdgcn_readfirstlane(tid >> 6), lane = tid & 63, wr = wid >> 2, wc = wid & 3, fr = lane & 15, fq = lane >> 4;
    const int K = g.K, nt = K / BK;
    unsigned voffA[2], voffB[2];
#pragma unroll
    for (int i = 0; i < 2; ++i) { int R, C; stage_rc(tid * 16 + i * 8192, R, C); const int Rb = Epi::PERM ? ((R & ~31) + perm32(R & 31)) : R;
        voffA[i] = (unsigned)(R * K + C) * 2u; voffB[i] = (unsigned)(Rb * K + C) * 2u; }
    const size_t kstep = (size_t)(BK * 2);
    const size_t hstep = (size_t)HALF * K * 2;
    const size_t tstep = 2 * hstep;
    const unsigned ldsw = (unsigned)wid * 1024u;
    const int aoff = lds_byte(wr * 64 + fr, fq * 8), boff = lds_byte(wc * 32 + fr, fq * 8);
#define PG8_SA(b, h) (((b) * 2 + (h)) * HTB)
#define PG8_SB(b, h) ((4 + (b) * 2 + (h)) * HTB)
#define PG8_STAGE(bufoff, gbase, voff) do { _Pragma("unroll") for (int _i = 0; _i < 2; ++_i) \
        __builtin_amdgcn_global_load_lds((const unsigned*)((const char*)(gbase) + (voff)[_i]), (PG8_LAS unsigned*)(lds + (bufoff) + ldsw + _i * 8192), 16, 0, 0); } while (0)
#define PG8_LDA(dst, b, h) do { _Pragma("unroll") for (int m = 0; m < 4; ++m) _Pragma("unroll") for (int k = 0; k < 2; ++k) dst[m][k] = *(const PG8_LAS bf16x8*)(lds + PG8_SA(b, h) + aoff + m * 2048 + k * 1024); } while (0)
#define PG8_LDB(dst, b, h) do { _Pragma("unroll") for (int n = 0; n < 2; ++n) _Pragma("unroll") for (int k = 0; k < 2; ++k) dst[n][k] = *(const PG8_LAS bf16x8*)(lds + PG8_SB(b, h) + boff + n * 2048 + k * 1024); } while (0)
#define PG8_MMA(ai, bj, At, Bt) do { __builtin_amdgcn_s_setprio(1); _Pragma("unroll") for (int m = 0; m < 4; ++m) _Pragma("unroll") for (int n = 0; n < 2; ++n) _Pragma("unroll") for (int k = 0; k < 2; ++k) \
        acc[ai][bj][m][n] = __builtin_amdgcn_mfma_f32_16x16x32_bf16(Bt[n][k], At[m][k], acc[ai][bj][m][n], 0, 0, 0); __builtin_amdgcn_s_setprio(0); } while (0)
#define PG8_WAIT_V(n) asm volatile("s_waitcnt vmcnt(" #n ")" ::: "memory")
#define PG8_WAIT_L(n) asm volatile("s_waitcnt lgkmcnt(" #n ")" ::: "memory")
#define PG8_BAR __builtin_amdgcn_s_barrier()
#define PG8_SCHED __builtin_amdgcn_sched_barrier(0)
    Unit cur, nxt; int ui = 0;
    if (!S.next(0, cur)) return;
    f32x4 acc[2][2][4][2];
#pragma unroll
    for (int a = 0; a < 2; ++a)
#pragma unroll
        for (int b = 0; b < 2; ++b)
#pragma unroll
            for (int m = 0; m < 4; ++m)
#pragma unroll
                for (int n = 0; n < 2; ++n) acc[a][b][m][n] = (f32x4){0.f, 0.f, 0.f, 0.f};
    bf16x8 At[4][2], B0[2][2], B1[2][2];
    const char* cA = (const char*)g.A + (size_t)cur.pm * tstep; const char* cB = (const char*)g.Bt + (size_t)cur.pn * tstep;
    S.a_ready(cur);
    if constexpr (SP2) {
        PG8_STAGE(PG8_SB(0, 0), cB, voffB); PG8_STAGE(PG8_SB(0, 1), cB + hstep, voffB); PG8_STAGE(PG8_SA(0, 0), cA, voffA); PG8_STAGE(PG8_SA(0, 1), cA + hstep, voffA);
        if (wr == 1) PG8_BAR;
        PG8_WAIT_V(2); PG8_BAR;
        PG8_STAGE(PG8_SB(1, 0), cB + kstep, voffB); PG8_STAGE(PG8_SA(1, 0), cA + kstep, voffA); PG8_STAGE(PG8_SB(1, 1), cB + hstep + kstep, voffB);
        PG8_WAIT_V(6); PG8_BAR;
    } else {
        PG8_STAGE(PG8_SB(0, 0), cB, voffB); PG8_STAGE(PG8_SA(0, 0), cA, voffA); PG8_STAGE(PG8_SB(0, 1), cB + hstep, voffB); PG8_STAGE(PG8_SA(0, 1), cA + hstep, voffA);
        if (wr == 1) PG8_BAR;
        PG8_WAIT_V(4); PG8_BAR;
        PG8_STAGE(PG8_SB(1, 0), cB + kstep, voffB); PG8_STAGE(PG8_SA(1, 0), cA + kstep, voffA); PG8_STAGE(PG8_SB(1, 1), cB + hstep + kstep, voffB);
        PG8_WAIT_V(6); PG8_BAR;
    }
    for (;;) {
        const bool has_next = S.next(ui + 1, nxt);
        const char* nA = has_next ? (const char*)g.A + (size_t)nxt.pm * tstep : cA; const char* nB = has_next ? (const char*)g.Bt + (size_t)nxt.pn * tstep : cB;
        for (int t = 0; t < nt; t += 2) {
            const bool last = (t == nt - 2);
            const char* a1 = cA + (size_t)(t + 1) * kstep;
            const char* a2 = last ? nA : cA + (size_t)(t + 2) * kstep; const char* b2 = last ? nB : cB + (size_t)(t + 2) * kstep;
            const char* a3 = a2 + kstep; const char* b3 = b2 + kstep;
            if (last && has_next) S.a_ready(nxt);
            if constexpr (SP2) {
            PG8_LDB(B0, 0, 0); PG8_LDB(B1, 0, 1); PG8_SCHED; PG8_LDA(At, 0, 0); PG8_STAGE(PG8_SA(1, 1), a1 + hstep, voffA);
            PG8_WAIT_V(8); PG8_WAIT_L(0); PG8_BAR; PG8_MMA(0, 0, At, B0); PG8_MMA(0, 1, At, B1); PG8_BAR; PG8_SCHED;
            PG8_LDA(At, 0, 1); PG8_STAGE(PG8_SB(0, 0), b2, voffB); PG8_STAGE(PG8_SB(0, 1), b2 + hstep, voffB); PG8_STAGE(PG8_SA(0, 0), a2, voffA);
            PG8_WAIT_V(8); PG8_WAIT_L(0); PG8_BAR; PG8_MMA(1, 0, At, B0); PG8_MMA(1, 1, At, B1); PG8_BAR; PG8_SCHED;
            PG8_LDB(B0, 1, 0); PG8_LDB(B1, 1, 1); PG8_SCHED; PG8_LDA(At, 1, 0); PG8_STAGE(PG8_SA(0, 1), a2 + hstep, voffA);
            PG8_WAIT_V(8); PG8_WAIT_L(0); PG8_BAR; PG8_MMA(0, 0, At, B0); PG8_MMA(0, 1, At, B1); PG8_BAR; PG8_SCHED;
            PG8_LDA(At, 1, 1); PG8_STAGE(PG8_SB(1, 0), b3, voffB); PG8_STAGE(PG8_SB(1, 1), b3 + hstep, voffB); PG8_STAGE(PG8_SA(1, 0), a3, voffA);
            PG8_WAIT_V(8); PG8_WAIT_L(0); PG8_BAR; PG8_MMA(1, 0, At, B0); PG8_MMA(1, 1, At, B1); PG8_BAR; PG8_SCHED;
            } else {
            PG8_LDB(B0, 0, 0); PG8_SCHED; PG8_LDA(At, 0, 0); PG8_STAGE(PG8_SA(1, 1), a1 + hstep, voffA);
            PG8_WAIT_L(8); PG8_BAR; PG8_WAIT_L(0); PG8_MMA(0, 0, At, B0); PG8_BAR; PG8_SCHED;
            PG8_LDB(B1, 0, 1); PG8_STAGE(PG8_SB(0, 0), b2, voffB);
            PG8_BAR; PG8_WAIT_L(0); PG8_MMA(0, 1, At, B1); PG8_BAR;
            PG8_LDA(At, 0, 1); PG8_STAGE(PG8_SA(0, 0), a2, voffA);
            PG8_BAR; PG8_WAIT_L(0); PG8_MMA(1, 0, At, B0); PG8_BAR; PG8_SCHED;
            PG8_STAGE(PG8_SB(0, 1), b2 + hstep, voffB);
            PG8_WAIT_V(6); PG8_BAR; PG8_MMA(1, 1, At, B1); PG8_BAR;
            PG8_LDB(B0, 1, 0); PG8_SCHED; PG8_LDA(At, 1, 0); PG8_STAGE(PG8_SA(0, 1), a2 + hstep, voffA);
            PG8_WAIT_L(8); PG8_BAR; PG8_WAIT_L(0); PG8_MMA(0, 0, At, B0); PG8_BAR; PG8_SCHED;
            PG8_LDB(B1, 1, 1); PG8_STAGE(PG8_SB(1, 0), b3, voffB);
            PG8_BAR; PG8_WAIT_L(0); PG8_MMA(0, 1, At, B1); PG8_BAR;
            PG8_LDA(At, 1, 1); PG8_STAGE(PG8_SA(1, 0), a3, voffA);
            PG8_BAR; PG8_WAIT_L(0); PG8_MMA(1, 0, At, B0); PG8_BAR; PG8_SCHED;
            PG8_STAGE(PG8_SB(1, 1), b3 + hstep, voffB);
            PG8_WAIT_V(6); PG8_BAR; PG8_MMA(1, 1, At, B1); PG8_BAR;
                    }
        }
        if constexpr (ALIGN_EPI) { if (wr == 0) PG8_BAR; }
        E(acc, cur, wr, wc, fr, fq); S.done(cur);
#ifdef INPROJ_EPI2
        if constexpr (Epi::TWICE) { asm volatile("" ::: "memory"); E(acc, cur, wr, wc, fr, fq); }
#endif
        if (!has_next) break;
#pragma unroll
        for (int a = 0; a < 2; ++a)
#pragma unroll
            for (int b = 0; b < 2; ++b)
#pragma unroll
                for (int m = 0; m < 4; ++m)
#pragma unroll
                    for (int n = 0; n < 2; ++n) acc[a][b][m][n] = (f32x4){0.f, 0.f, 0.f, 0.f};
        cur = nxt; cA = nA; cB = nB; ++ui;
        if constexpr (ALIGN_EPI) { if (wr == 1) PG8_BAR; }
    }
    PG8_WAIT_V(0);
    if constexpr (!ALIGN_EPI) { if (wr == 0) PG8_BAR; }
    PG8_BAR;
#undef PG8_SA
#undef PG8_SB
#undef PG8_STAGE
#undef PG8_LDA
#undef PG8_LDB
#undef PG8_MMA
#undef PG8_WAIT_V
#undef PG8_WAIT_L
#undef PG8_BAR
#undef PG8_SCHED
}

template <class Epi, class Sched, int MAXU>
__device__ __forceinline__ void gemm_phase_gather(PG8_LAS unsigned char* lds, const Gemm g, const Sched& S, const Epi& E, const int* __restrict__ rowsrc, PG8_LAS unsigned short* gtab) {
    int tid = threadIdx.x; asm volatile("" : "+v"(tid));
    const int wid = __builtin_amdgcn_readfirstlane(tid >> 6), lane = tid & 63, wr = wid >> 2, wc = wid & 3, fr = lane & 15, fq = lane >> 4;
    const int K = g.K, nt = K / BK;
    Unit cur, nxt; int ui = 0;
    if (!S.next(0, cur)) return;
    { int idx[MAXU];
#pragma unroll
      for (int i = 0; i < MAXU; ++i) { Unit u; const bool have = S.next(i, u); idx[i] = (have && tid < 256) ? rowsrc[u.pm * 256 + tid] : 0; }
#pragma unroll
      for (int i = 0; i < MAXU; ++i) { if (tid < 256) gtab[i * 256 + tid] = (unsigned short)idx[i]; }
      asm volatile("s_waitcnt vmcnt(0) lgkmcnt(0)" ::: "memory"); __builtin_amdgcn_s_barrier(); asm volatile("" ::: "memory"); }
    unsigned voffB[2]; int RA[2], CA[2];
#pragma unroll
    for (int i = 0; i < 2; ++i) { int R, C; stage_rc(tid * 16 + i * 8192, R, C); const int Rb = Epi::PERM ? ((R & ~31) + perm32(R & 31)) : R;
        RA[i] = R; CA[i] = C * 2; voffB[i] = (unsigned)(Rb * K + C) * 2u; }
    const size_t kstep = (size_t)(BK * 2);
    const size_t hstep = (size_t)HALF * K * 2;
    const size_t tstep = 2 * hstep;
    const unsigned ldsw = (unsigned)wid * 1024u;
    const int aoff = lds_byte(wr * 64 + fr, fq * 8), boff = lds_byte(wc * 32 + fr, fq * 8);
    const unsigned rowb = (unsigned)K * 2u;
#define PG8_SA(b, h) (((b) * 2 + (h)) * HTB)
#define PG8_SB(b, h) ((4 + (b) * 2 + (h)) * HTB)
#define PG8_STAGE(bufoff, gbase, voff) do { _Pragma("unroll") for (int _i = 0; _i < 2; ++_i) \
        __builtin_amdgcn_global_load_lds((const unsigned*)((const char*)(gbase) + (voff)[_i]), (PG8_LAS unsigned*)(lds + (bufoff) + ldsw + _i * 8192), 16, 0, 0); } while (0)
#define PG8_LDA(dst, b, h) do { _Pragma("unroll") for (int m = 0; m < 4; ++m) _Pragma("unroll") for (int k = 0; k < 2; ++k) dst[m][k] = *(const PG8_LAS bf16x8*)(lds + PG8_SA(b, h) + aoff + m * 2048 + k * 1024); } while (0)
#define PG8_LDB(dst, b, h) do { _Pragma("unroll") for (int n = 0; n < 2; ++n) _Pragma("unroll") for (int k = 0; k < 2; ++k) dst[n][k] = *(const PG8_LAS bf16x8*)(lds + PG8_SB(b, h) + boff + n * 2048 + k * 1024); } while (0)
#define PG8_MMA(ai, bj, At, Bt) do { __builtin_amdgcn_s_setprio(1); _Pragma("unroll") for (int m = 0; m < 4; ++m) _Pragma("unroll") for (int n = 0; n < 2; ++n) _Pragma("unroll") for (int k = 0; k < 2; ++k) \
        acc[ai][bj][m][n] = __builtin_amdgcn_mfma_f32_16x16x32_bf16(Bt[n][k], At[m][k], acc[ai][bj][m][n], 0, 0, 0); __builtin_amdgcn_s_setprio(0); } while (0)
#define PG8_WAIT_V(n) asm volatile("s_waitcnt vmcnt(" #n ")" ::: "memory")
#define PG8_WAIT_L(n) asm volatile("s_waitcnt lgkmcnt(" #n ")" ::: "memory")
#define PG8_BAR __builtin_amdgcn_s_barrier()
#define PG8_SCHED __builtin_amdgcn_sched_barrier(0)
#define PG8_GOFF(dst, ORD) do { _Pragma("unroll") for (int _h = 0; _h < 2; ++_h) _Pragma("unroll") for (int _i = 0; _i < 2; ++_i) \
        dst[_h][_i] = (unsigned)gtab[(ORD) * 256 + _h * HALF + RA[_i]] * rowb + (unsigned)CA[_i]; } while (0)
    f32x4 acc[2][2][4][2];
#pragma unroll
    for (int a = 0; a < 2; ++a)
#pragma unroll
        for (int b = 0; b < 2; ++b)
#pragma unroll
            for (int m = 0; m < 4; ++m)
#pragma unroll
                for (int n = 0; n < 2; ++n) acc[a][b][m][n] = (f32x4){0.f, 0.f, 0.f, 0.f};
    bf16x8 At[4][2], B0[2][2], B1[2][2];
    unsigned vAc[2][2], vAn[2][2];
    PG8_GOFF(vAc, 0);
#pragma unroll
    for (int h = 0; h < 2; ++h)
#pragma unroll
        for (int i = 0; i < 2; ++i) vAn[h][i] = vAc[h][i];
    const char* gA = (const char*)g.A;
    const char* cB = (const char*)g.Bt + (size_t)cur.pn * tstep;
    PG8_STAGE(PG8_SB(0, 0), cB, voffB); PG8_STAGE(PG8_SB(0, 1), cB + hstep, voffB); PG8_STAGE(PG8_SA(0, 0), gA, vAc[0]); PG8_STAGE(PG8_SA(0, 1), gA, vAc[1]);
    if (wr == 1) PG8_BAR;
    PG8_WAIT_V(2); PG8_BAR;
    PG8_STAGE(PG8_SB(1, 0), cB + kstep, voffB); PG8_STAGE(PG8_SA(1, 0), gA + kstep, vAc[0]); PG8_STAGE(PG8_SB(1, 1), cB + hstep + kstep, voffB);
    PG8_WAIT_V(6); PG8_BAR;
    for (;;) {
        const bool has_next = S.next(ui + 1, nxt);
        const char* nB = has_next ? (const char*)g.Bt + (size_t)nxt.pn * tstep : cB;
        for (int t = 0; t < nt; t += 2) {
            const bool last = (t == nt - 2);
            if (last) { if (has_next) { PG8_GOFF(vAn, ui + 1); } }
            const char* ka1 = gA + (size_t)(t + 1) * kstep;
            const char* ka2 = last ? gA : gA + (size_t)(t + 2) * kstep; const char* b2 = last ? nB : cB + (size_t)(t + 2) * kstep;
            const char* ka3 = ka2 + kstep; const char* b3 = b2 + kstep;
            unsigned x2[2][2];
#pragma unroll
            for (int h = 0; h < 2; ++h)
#pragma unroll
                for (int i = 0; i < 2; ++i) x2[h][i] = last ? vAn[h][i] : vAc[h][i];
            PG8_LDB(B0, 0, 0); PG8_LDB(B1, 0, 1); PG8_SCHED; PG8_LDA(At, 0, 0); PG8_STAGE(PG8_SA(1, 1), ka1, vAc[1]);
            PG8_WAIT_V(8); PG8_WAIT_L(0); PG8_BAR; PG8_MMA(0, 0, At, B0); PG8_MMA(0, 1, At, B1); PG8_BAR; PG8_SCHED;
            PG8_LDA(At, 0, 1); PG8_STAGE(PG8_SB(0, 0), b2, voffB); PG8_STAGE(PG8_SB(0, 1), b2 + hstep, voffB); PG8_STAGE(PG8_SA(0, 0), ka2, x2[0]);
            PG8_WAIT_V(8); PG8_WAIT_L(0); PG8_BAR; PG8_MMA(1, 0, At, B0); PG8_MMA(1, 1, At, B1); PG8_BAR; PG8_SCHED;
            PG8_LDB(B0, 1, 0); PG8_LDB(B1, 1, 1); PG8_SCHED; PG8_LDA(At, 1, 0); PG8_STAGE(PG8_SA(0, 1), ka2, x2[1]);
            PG8_WAIT_V(8); PG8_WAIT_L(0); PG8_BAR; PG8_MMA(0, 0, At, B0); PG8_MMA(0, 1, At, B1); PG8_BAR; PG8_SCHED;
            PG8_LDA(At, 1, 1); PG8_STAGE(PG8_SB(1, 0), b3, voffB); PG8_STAGE(PG8_SB(1, 1), b3 + hstep, voffB); PG8_STAGE(PG8_SA(1, 0), ka3, x2[0]);
            PG8_WAIT_V(8); PG8_WAIT_L(0); PG8_BAR; PG8_MMA(1, 0, At, B0); PG8_MMA(1, 1, At, B1); PG8_BAR; PG8_SCHED;
        }
        if (wr == 0) PG8_BAR;
        E(acc, cur, wr, wc, fr, fq); S.done(cur);
        if (!has_next) break;
#pragma unroll
        for (int a = 0; a < 2; ++a)
#pragma unroll
            for (int b = 0; b < 2; ++b)
#pragma unroll
                for (int m = 0; m < 4; ++m)
#pragma unroll
                    for (int n = 0; n < 2; ++n) acc[a][b][m][n] = (f32x4){0.f, 0.f, 0.f, 0.f};
        cur = nxt; cB = nB; ++ui;
#pragma unroll
        for (int h = 0; h < 2; ++h)
#pragma unroll
            for (int i = 0; i < 2; ++i) vAc[h][i] = vAn[h][i];
        if (wr == 1) PG8_BAR;
    }
    PG8_WAIT_V(0);
    PG8_BAR;
#undef PG8_GOFF
#undef PG8_SA
#undef PG8_SB
#undef PG8_STAGE
#undef PG8_LDA
#undef PG8_LDB
#undef PG8_MMA
#undef PG8_WAIT_V
#undef PG8_WAIT_L
#undef PG8_BAR
#undef PG8_SCHED
}
}
#define XB_TMO      128
#define XB_XCNT(j)  (256  + 64 * (j))
#define XB_XSUB(j)  (1280 + 64 * (j))
#define XB_XGEN(j)  (2304 + 64 * (j))
#define XB_TOP      3328
#define XB_TOPGEN   3392
#define XCD_BAR_WORDS 3456
#define XB_SPIN_CAP (1u << 22)
#define LAS __attribute__((address_space(3)))

__device__ __forceinline__ unsigned xb_ld(unsigned* p)              { return __hip_atomic_load(p, __ATOMIC_RELAXED, __HIP_MEMORY_SCOPE_AGENT); }
__device__ __forceinline__ unsigned xb_add(unsigned* p, unsigned v) { return __hip_atomic_fetch_add(p, v, __ATOMIC_RELAXED, __HIP_MEMORY_SCOPE_AGENT); }
__device__ __forceinline__ unsigned xb_xcc_id() { return (unsigned)__builtin_amdgcn_s_getreg((3 << 11) | 20) & 0xFu; }
#define XB_SPIN(cond, bar) do { unsigned _sp = 0; while (cond) { __builtin_amdgcn_s_sleep(1); \
    if ((++_sp & 255u) == 0u) { if (xb_ld(&(bar)[XB_TMO])) break; if (_sp > XB_SPIN_CAP) { atomicAdd(&(bar)[XB_TMO], 1u); break; } } } } while (0)

struct XcdBarrier {
    unsigned* bar; unsigned x;
    volatile LAS unsigned* st;
};
__device__ __forceinline__ XcdBarrier xcd_barrier_post(unsigned* bar, volatile LAS unsigned* st) {
    XcdBarrier b; b.bar = bar; b.x = xb_xcc_id(); b.st = st;
    if (threadIdx.x == 0) (void)xb_add(&bar[XB_XCNT(b.x)], 1u);
    return b;
}
__device__ __forceinline__ void xcd_barrier_complete(unsigned* bar, unsigned x, unsigned& nloc, unsigned& nx) {
    const unsigned G = gridDim.x * gridDim.y * gridDim.z;
    unsigned sum, cnt, mine, sp = 0u;
    for (;;) {
        sum = 0u; cnt = 0u; mine = 0u;
#pragma unroll
        for (unsigned j = 0; j < 16; ++j) { const unsigned c = xb_ld(&bar[XB_XCNT(j)]); sum += c; cnt += (c > 0u) ? 1u : 0u; mine = (j == x) ? c : mine; }
        if (sum == G) break;
        __builtin_amdgcn_s_sleep(1);
        if ((++sp & 255u) == 0u) { if (xb_ld(&bar[XB_TMO])) break; if (sp > XB_SPIN_CAP) { atomicAdd(&bar[XB_TMO], 1u); break; } }
    }
    nloc = mine > 0u ? mine : 1u; nx = cnt > 0u ? cnt : 1u;
}
__device__ __forceinline__ void xcd_barrier(const XcdBarrier& b) {
    asm volatile("s_waitcnt vmcnt(0)" ::: "memory");
    __syncthreads();
    if (threadIdx.x == 0) {
        unsigned* bar = b.bar;
        __builtin_amdgcn_s_waitcnt(0);
        unsigned nloc = b.st[0], nx = b.st[1];
        if (nloc == 0u) { xcd_barrier_complete(bar, b.x, nloc, nx); b.st[0] = nloc; b.st[1] = nx; }
        const unsigned old = xb_add(&bar[XB_XSUB(b.x)], 1u);
        const unsigned gen = old / nloc;
        if (old + 1u == (gen + 1u) * nloc) {
            __builtin_amdgcn_fence(__ATOMIC_RELEASE, "agent");
            asm volatile("s_waitcnt vmcnt(0)" ::: "memory");
            const unsigned og = xb_add(&bar[XB_TOP], 1u);
            const unsigned tg = og / nx;
            if (og + 1u == (tg + 1u) * nx) xb_add(&bar[XB_TOPGEN], 1u);
            else XB_SPIN(xb_ld(&bar[XB_TOPGEN]) == tg, bar);
            __builtin_amdgcn_fence(__ATOMIC_ACQUIRE, "agent");
            xb_add(&bar[XB_XGEN(b.x)], 1u);
            asm volatile("s_waitcnt vmcnt(0)" ::: "memory");
        } else {
            XB_SPIN(xb_ld(&bar[XB_XGEN(b.x)]) == gen, bar);
            __builtin_amdgcn_fence(__ATOMIC_ACQUIRE, "agent");
            asm volatile("s_waitcnt vmcnt(0)" ::: "memory");
        }
    }
    __syncthreads();
}
namespace att {
typedef unsigned short bf16_t;
using bf16x8 = __attribute__((ext_vector_type(8))) short;
using s16x4  = __attribute__((ext_vector_type(4))) short;
using f32x16 = __attribute__((ext_vector_type(16))) float;
using u32x4  = __attribute__((ext_vector_type(4))) unsigned;
constexpr int NW = 8, QBLK = 32, KVBLK = 64;
constexpr int LDR = 512;
constexpr float THR = 8.f;
constexpr int SHM_V = KVBLK * 128 * 2, SHM_K = KVBLK * 64 * 2, NBUF = 3, WS_OFF = NBUF * (SHM_V + SHM_K), SHM_ATTN = WS_OFF + NW * 64 * 4;
#define KSWZ(row, colB) ((row) * 128 + ((colB) ^ ((((row) >> 1) & 7) << 4)))
#define SBAR() __builtin_amdgcn_sched_barrier(0)
__device__ __forceinline__ int crow(int r, int hi) { return (r & 3) + 8 * (r >> 2) + 4 * hi; }
__device__ __forceinline__ unsigned cvtpk(float lo, float hi) { unsigned r; asm volatile("v_cvt_pk_bf16_f32 %0, %1, %2" : "=v"(r) : "v"(lo), "v"(hi)); return r; }

template <int CTRL> __device__ __forceinline__ float adpp(float x) { return __builtin_bit_cast(float, __builtin_amdgcn_mov_dpp(__builtin_bit_cast(int, x), CTRL, 0xf, 0xf, true)); }
__device__ __forceinline__ void partialSM(f32x16& p0, f32x16& p1, float& m_reg, float& mn, float& alpha) {
  constexpr float C = 1.4426950408889634f;
  float pmax = p0[0];
#pragma unroll
  for (int r = 1; r < 16; ++r) pmax = fmaxf(pmax, p0[r]);
#pragma unroll
  for (int r = 0; r < 16; ++r) pmax = fmaxf(pmax, p1[r]);
  { auto rr = __builtin_amdgcn_permlane32_swap(__float_as_uint(pmax), __float_as_uint(pmax), false, false);
    pmax = fmaxf(__uint_as_float(rr[0]), __uint_as_float(rr[1])); }
  if (__builtin_expect(__all(pmax - m_reg <= THR), 1)) { mn = m_reg; alpha = 1.f; }
  else { mn = fmaxf(m_reg, pmax); alpha = __builtin_amdgcn_exp2f((m_reg - mn) * C); m_reg = mn; }
  float mnC = -mn * C;
#pragma unroll
  for (int r = 0; r < 16; ++r) p0[r] = fmaf(p0[r], C, mnC);
#pragma unroll
  for (int r = 0; r < 16; ++r) p1[r] = fmaf(p1[r], C, mnC);
#pragma unroll
  for (int r = 0; r < 16; ++r) p0[r] = __builtin_amdgcn_exp2f(p0[r]);
}
__device__ __forceinline__ float psm_max0(const f32x16& p0) {
  float pmax = p0[0];
#pragma unroll
  for (int r = 1; r < 16; ++r) pmax = fmaxf(pmax, p0[r]);
  return pmax;
}
__device__ __forceinline__ void psm_max1(const f32x16& p1, float pmax, float& m_reg, float& mn, float& alpha) {
  constexpr float C = 1.4426950408889634f;
#pragma unroll
  for (int r = 0; r < 16; ++r) pmax = fmaxf(pmax, p1[r]);
  { auto rr = __builtin_amdgcn_permlane32_swap(__float_as_uint(pmax), __float_as_uint(pmax), false, false);
    pmax = fmaxf(__uint_as_float(rr[0]), __uint_as_float(rr[1])); }
  if (__builtin_expect(__all(pmax - m_reg <= THR), 1)) { mn = m_reg; alpha = 1.f; }
  else { mn = fmaxf(m_reg, pmax); alpha = __builtin_amdgcn_exp2f((m_reg - mn) * C); m_reg = mn; }
}
__device__ __forceinline__ void psm_scale(f32x16& p0, f32x16& p1, float mn) {
  constexpr float C = 1.4426950408889634f; const float mnC = -mn * C;
#pragma unroll
  for (int r = 0; r < 16; ++r) p0[r] = fmaf(p0[r], C, mnC);
#pragma unroll
  for (int r = 0; r < 16; ++r) p1[r] = fmaf(p1[r], C, mnC);
}
__device__ __forceinline__ void psm_exp0(f32x16& p0) {
#pragma unroll
  for (int r = 0; r < 16; ++r) p0[r] = __builtin_amdgcn_exp2f(p0[r]);
}
__device__ __forceinline__ void finishSM(f32x16& p0, f32x16& p1, float alpha, float& l_reg, bf16x8& pa0, bf16x8& pa1, bf16x8& pa2, bf16x8& pa3) {
#pragma unroll
  for (int r = 0; r < 16; ++r) p1[r] = __builtin_amdgcn_exp2f(p1[r]);
  float ps = 0;
#pragma unroll
  for (int r = 0; r < 16; ++r) ps += p0[r];
#pragma unroll
  for (int r = 0; r < 16; ++r) ps += p1[r];
  { auto rr = __builtin_amdgcn_permlane32_swap(__float_as_uint(ps), __float_as_uint(ps), false, false);
    ps = __uint_as_float(rr[0]) + __uint_as_float(rr[1]); }
  l_reg = l_reg * alpha + ps;
#define PK4(P, BASE, OUT) do { unsigned a0 = cvtpk(P[BASE + 0], P[BASE + 1]), a1 = cvtpk(P[BASE + 2], P[BASE + 3]);   \
    unsigned b0 = cvtpk(P[BASE + 4], P[BASE + 5]), b1 = cvtpk(P[BASE + 6], P[BASE + 7]);                              \
    auto r0 = __builtin_amdgcn_permlane32_swap(a0, b0, false, false); auto r1 = __builtin_amdgcn_permlane32_swap(a1, b1, false, false); \
    u32x4 w = {r0[0], r1[0], r0[1], r1[1]}; OUT = *reinterpret_cast<bf16x8*>(&w); } while (0)
  PK4(p0, 0, pa0); PK4(p0, 8, pa1); PK4(p1, 0, pa2); PK4(p1, 8, pa3);
#undef PK4
}
__device__ __forceinline__ void qkt(f32x16& p0, f32x16& p1, const char* Ks, const bf16x8 (&qr)[4], int r32, int hi) {
  p0 = f32x16{}; p1 = f32x16{};
#pragma unroll
  for (int d0 = 0; d0 < 4; ++d0) { const int cb = (d0 * 16 + hi * 8) * 2;
    bf16x8 b0 = *reinterpret_cast<const bf16x8*>(Ks + KSWZ(r32, cb));
    bf16x8 b1 = *reinterpret_cast<const bf16x8*>(Ks + KSWZ(32 + r32, cb));
    p0 = __builtin_amdgcn_mfma_f32_32x32x16_bf16(b0, qr[d0], p0, 0, 0, 0);
    p1 = __builtin_amdgcn_mfma_f32_32x32x16_bf16(b1, qr[d0], p1, 0, 0, 0); }
}
__device__ __forceinline__ int v_st(int k, int c) { const int kk = (k & ~0xC) | ((k & 4) << 1) | ((k & 8) >> 1); return ((kk >> 3) * 4 + (c >> 5)) * 512 + ((kk & 7) * 32 + (c & 31)) * 2; }
__device__ __forceinline__ int v_rd_base(int lane) { return ((lane & 3) << 3) | (((lane >> 2) & 3) << 6) | (((lane >> 4) & 1) << 5) | (((lane >> 5) & 1) << 8); }
constexpr int v_rd_off(int d0, int ks, int half) { return d0 * 512 + ks * 4096 + half * 2048; }
template <int OFF> __device__ __forceinline__ s16x4 tr_read(int vb) {
  s16x4 r; asm volatile("ds_read_b64_tr_b16 %0, %1 offset:%2" : "=&v"(r) : "v"(vb), "i"(OFF) : "memory"); return r;
}
template <int D0> __device__ __forceinline__ void pv_one(f32x16& od, int vb, bf16x8 pa0, bf16x8 pa1, bf16x8 pa2, bf16x8 pa3) {
  const s16x4 l0 = tr_read<v_rd_off(D0, 0, 0)>(vb), h0 = tr_read<v_rd_off(D0, 0, 1)>(vb), l1 = tr_read<v_rd_off(D0, 1, 0)>(vb), h1 = tr_read<v_rd_off(D0, 1, 1)>(vb);
  const s16x4 l2 = tr_read<v_rd_off(D0, 2, 0)>(vb), h2 = tr_read<v_rd_off(D0, 2, 1)>(vb), l3 = tr_read<v_rd_off(D0, 3, 0)>(vb), h3 = tr_read<v_rd_off(D0, 3, 1)>(vb);
  asm volatile("s_waitcnt lgkmcnt(0)" ::: "memory"); SBAR();
#define PK(L, H) (bf16x8){L[0], L[1], L[2], L[3], H[0], H[1], H[2], H[3]}
  od = __builtin_amdgcn_mfma_f32_32x32x16_bf16(pa0, PK(l0, h0), od, 0, 0, 0);
  od = __builtin_amdgcn_mfma_f32_32x32x16_bf16(pa1, PK(l1, h1), od, 0, 0, 0);
  od = __builtin_amdgcn_mfma_f32_32x32x16_bf16(pa2, PK(l2, h2), od, 0, 0, 0);
  od = __builtin_amdgcn_mfma_f32_32x32x16_bf16(pa3, PK(l3, h3), od, 0, 0, 0);
#undef PK
}
__device__ __forceinline__ void pv_d0(f32x16 (&o)[4], int vb, bf16x8 pa0, bf16x8 pa1, bf16x8 pa2, bf16x8 pa3) {
  pv_one<0>(o[0], vb, pa0, pa1, pa2, pa3); pv_one<1>(o[1], vb, pa0, pa1, pa2, pa3); pv_one<2>(o[2], vb, pa0, pa1, pa2, pa3); pv_one<3>(o[3], vb, pa0, pa1, pa2, pa3);
}

__device__ __forceinline__ void pv_psm(f32x16 (&o)[4], int vb, bf16x8 pa0, bf16x8 pa1, bf16x8 pa2, bf16x8 pa3, f32x16& p0, f32x16& p1, float& m_reg, float& mn, float& alpha) {
  pv_one<0>(o[0], vb, pa0, pa1, pa2, pa3); const float pm0 = psm_max0(p0);
  pv_one<1>(o[1], vb, pa0, pa1, pa2, pa3); psm_max1(p1, pm0, m_reg, mn, alpha);
  pv_one<2>(o[2], vb, pa0, pa1, pa2, pa3); psm_scale(p0, p1, mn);
  pv_one<3>(o[3], vb, pa0, pa1, pa2, pa3); psm_exp0(p0);
}

__device__ __forceinline__ void attn_pass(const bf16_t* __restrict__ Qb, const bf16_t* __restrict__ Kh, const bf16_t* __restrict__ Vh, int seq, char* lds, f32x16 (&o)[4], float& l_out) {
  int tid = threadIdx.x; asm volatile("" : "+v"(tid));
  const int wid = tid >> 6, lane = tid & 63, r32 = lane & 31, hi = lane >> 5;
  char* V_lds = lds; char* K_lds = lds + NBUF * SHM_V;
  float* ws = (float*)(lds + WS_OFF) + wid * 64; float* al_l = ws + 32;
  float m_reg = -1e30f, l_reg = 0; bf16x8 qr[4];
#pragma unroll
  for (int d = 0; d < 4; ++d) o[d] = f32x16{};
  const bf16_t* Qw = Qb + (long)(wid * QBLK + r32) * LDR + hi * 8;
#pragma unroll
  for (int d0 = 0; d0 < 4; ++d0) qr[d0] = *reinterpret_cast<const bf16x8*>(Qw + d0 * 16);
  const int sr = tid >> 4, sc = (tid & 15) * 8, vst0 = v_st(sr, sc), vst1 = v_st(32 + sr, sc);
  const int kr = tid >> 3, kc = (tid & 7) * 8, kst = KSWZ(kr, kc * 2);
  const int vb0 = (int)(uintptr_t)V_lds + v_rd_base(lane);
  struct { bf16x8 vs0, vs1, ks0; } sr_[2];
#define SLOAD(i, k0) do { sr_[i].vs0 = *reinterpret_cast<const bf16x8*>(&Vh[(long)((k0) + sr) * LDR + sc]); sr_[i].vs1 = *reinterpret_cast<const bf16x8*>(&Vh[(long)((k0) + 32 + sr) * LDR + sc]); \
    sr_[i].ks0 = *reinterpret_cast<const bf16x8*>(&Kh[(long)((k0) + kr) * LDR + kc]); } while (0)
#define SWRITE(b, i) do { *(bf16x8*)(V_lds + (b) * SHM_V + vst0) = sr_[i].vs0; *(bf16x8*)(V_lds + (b) * SHM_V + vst1) = sr_[i].vs1; \
    *(bf16x8*)(K_lds + (b) * SHM_K + kst) = sr_[i].ks0; } while (0)
#define SWAIT() asm volatile("s_waitcnt vmcnt(3)" ::: "memory")
#define RESC(a) do { if (__any((a) < 1.f)) { if (hi == 0) al_l[r32] = (a); asm volatile("s_waitcnt lgkmcnt(0)" ::: "memory"); \
    _Pragma("unroll") for (int d = 0; d < 4; ++d) _Pragma("unroll") for (int r = 0; r < 16; ++r) o[d][r] *= al_l[crow(r, hi)]; } } while (0)
#define ROT() do { const int t_ = bprev; bprev = bcur; bcur = bnext; bnext = t_; } while (0)
  f32x16 pA0, pA1, pB0, pB1; float mnA, mnB, alA, alB; bf16x8 pa0, pa1, pa2, pa3; const int NT = seq / KVBLK;
  constexpr int SE = 0, SO = 1;
  SLOAD(SE, 0); asm volatile("s_waitcnt vmcnt(0)" ::: "memory"); SWRITE(0, SE);
  SLOAD(SO, KVBLK); if (2 < NT) SLOAD(SE, 2 * KVBLK);
  __syncthreads();
  qkt(pA0, pA1, K_lds, qr, r32, hi); partialSM(pA0, pA1, m_reg, mnA, alA);
  SWAIT(); SWRITE(1, SO);
  int bprev = 0, bcur = 1, bnext = 2;
  for (int j = 1; j + 1 < NT; j += 2) {
    __syncthreads();
    SBAR(); qkt(pB0, pB1, K_lds + bcur * SHM_K, qr, r32, hi);
#ifdef ATT_X1
    asm volatile("" : "+v"(pB0), "+v"(pB1)); qkt(pB0, pB1, K_lds + bcur * SHM_K, qr, r32, hi);
#endif
    finishSM(pA0, pA1, alA, l_reg, pa0, pa1, pa2, pa3); SBAR();
#ifdef ATT_X2
    { bf16x8 z = {0,0,0,0,0,0,0,0}; asm volatile("" : "+v"(z)); pv_d0(o, vb0 + bprev * (int)SHM_V, z, z, z, z); }
#endif
    SLOAD(SO, (j + 2) * KVBLK); SBAR();
    pv_psm(o, vb0 + bprev * (int)SHM_V, pa0, pa1, pa2, pa3, pB0, pB1, m_reg, mnB, alB);
    SWAIT(); SWRITE(bnext, SE);
    RESC(alB); ROT();
    __syncthreads();
    SBAR(); qkt(pA0, pA1, K_lds + bcur * SHM_K, qr, r32, hi);
#ifdef ATT_X1
    asm volatile("" : "+v"(pA0), "+v"(pA1)); qkt(pA0, pA1, K_lds + bcur * SHM_K, qr, r32, hi);
#endif
    finishSM(pB0, pB1, alB, l_reg, pa0, pa1, pa2, pa3); SBAR();
#ifdef ATT_X2
    { bf16x8 z = {0,0,0,0,0,0,0,0}; asm volatile("" : "+v"(z)); pv_d0(o, vb0 + bprev * (int)SHM_V, z, z, z, z); }
#endif
    SLOAD(SE, (j + 3 < NT ? j + 3 : NT - 1) * KVBLK); SBAR();
    pv_psm(o, vb0 + bprev * (int)SHM_V, pa0, pa1, pa2, pa3, pA0, pA1, m_reg, mnA, alA);
    SWAIT(); SWRITE(bnext, SO);
    RESC(alA); ROT();
  }
  __syncthreads();
  SBAR(); qkt(pB0, pB1, K_lds + bcur * SHM_K, qr, r32, hi);
  finishSM(pA0, pA1, alA, l_reg, pa0, pa1, pa2, pa3); SBAR();
  pv_psm(o, vb0 + bprev * (int)SHM_V, pa0, pa1, pa2, pa3, pB0, pB1, m_reg, mnB, alB);
  RESC(alB);
  finishSM(pB0, pB1, alB, l_reg, pa0, pa1, pa2, pa3); SBAR();
  pv_d0(o, vb0 + bcur * (int)SHM_V, pa0, pa1, pa2, pa3);
  l_out = l_reg;
#undef SLOAD
#undef SWRITE
#undef SWAIT
#undef RESC
#undef ROT
}

__device__ __forceinline__ void attn_unit(const bf16_t* QB, const bf16_t* KB, const bf16_t* VB, float* OS, bf16_t* CAT, const float* subg, float lam, float outscale,
                                          int h, long row_q0, long row_k0, int nkeys, char* lds) {
  int tid = threadIdx.x; asm volatile("" : "+v"(tid));
  const int wid = tid >> 6, lane = tid & 63, r32 = lane & 31, hi = lane >> 5;
  float* li_l = (float*)(lds + WS_OFF) + wid * 64;
  float* OSu = OS + row_q0 * 512 + h * 128;
  bf16_t* CATu = CAT + row_q0 * 1024 + h * 128;
  {
    f32x16 o[4]; float l_reg;
    attn_pass(QB + row_q0 * LDR + h * 64, KB + row_k0 * LDR + h * 64, VB + row_k0 * LDR + h * 128, nkeys, lds, o, l_reg);
    if (hi == 0) li_l[r32] = l_reg;
    asm volatile("s_waitcnt lgkmcnt(0)" ::: "memory");
    int ob = (wid * QBLK + 4 * hi) * 512 + r32; asm volatile("" : "+v"(ob));
#pragma unroll
    for (int r = 0; r < 16; ++r) { const int oo = ob + ((r & 3) + 8 * (r >> 2)) * 512; const float rl = __builtin_amdgcn_rcpf(li_l[crow(r, hi)]);
#pragma unroll
      for (int d0 = 0; d0 < 4; ++d0) OSu[oo + d0 * 32] = o[d0][r] * rl; }
    asm volatile("s_waitcnt vmcnt(0)" ::: "memory");
    __syncthreads();
  }
  {
    f32x16 o[4]; float l_reg;
    attn_pass(QB + row_q0 * LDR + 256 + h * 64, KB + row_k0 * LDR + 256 + h * 64, VB + row_k0 * LDR + h * 128, nkeys, lds, o, l_reg);
    if (hi == 0) li_l[r32] = l_reg;
    asm volatile("s_waitcnt lgkmcnt(0)" ::: "memory");
    float ss[16];
    int ob = (wid * QBLK + 4 * hi) * 512 + r32; asm volatile("" : "+v"(ob));
#pragma unroll
    for (int r = 0; r < 16; ++r) { const int oo = ob + ((r & 3) + 8 * (r >> 2)) * 512; float s = 0.f; const float rl = lam * __builtin_amdgcn_rcpf(li_l[crow(r, hi)]);
#pragma unroll
      for (int d0 = 0; d0 < 4; ++d0) { const float v = OSu[oo + d0 * 32] - o[d0][r] * rl; o[d0][r] = v; s += v * v; }
      s += adpp<0xB1>(s); s += adpp<0x4E>(s); s += adpp<0x141>(s); s += adpp<0x128>(s);
      { auto s2 = __builtin_amdgcn_permlane16_swap(__float_as_uint(s), __float_as_uint(s), false, false); s = __uint_as_float(s2[0]) + __uint_as_float(s2[1]); }
      ss[r] = __builtin_amdgcn_rsqf(s * (1.0f / 128.0f) + 1e-6f) * outscale;
      if ((r & 7) == 7) asm volatile("" ::: "memory"); }
    float gs[4];
#pragma unroll
    for (int d0 = 0; d0 < 4; ++d0) gs[d0] = subg[d0 * 32 + r32];
    int cbo = (wid * QBLK + 4 * hi) * 1024 + r32; asm volatile("" : "+v"(cbo));
#pragma unroll
    for (int r = 0; r < 16; ++r) { const int co = cbo + ((r & 3) + 8 * (r >> 2)) * 1024;
#pragma unroll
      for (int d0 = 0; d0 < 4; ++d0) CATu[co + d0 * 32] = (bf16_t)(cvtpk(o[d0][r] * ss[r] * gs[d0], 0.f) & 0xffffu); }
    asm volatile("s_waitcnt vmcnt(0)" ::: "memory");
    __syncthreads();
  }
}
#undef KSWZ
#undef SBAR
}
typedef unsigned short bf16_t;
typedef float f32x4 __attribute__((ext_vector_type(4)));
typedef float f32x2 __attribute__((ext_vector_type(2)));
typedef unsigned u32x4 __attribute__((ext_vector_type(4)));
typedef unsigned u32x2 __attribute__((ext_vector_type(2)));
typedef short bf16x8 __attribute__((ext_vector_type(8)));

constexpr int D = 1024, NB = 8, SEQ = 4096, DEPTH = 4, CTXL = 256;
constexpr int RPB = CTXL + SEQ;
constexpr int RT = NB * RPB;
constexpr int PROJ = 2560, NE = 16, FF = 2048;
constexpr int CAP_L = 512, CAP_C = 32;
constexpr int ER = NB * CAP_L + NB * CAP_C;
constexpr int NWAVES = 8, NTHR = 512;
constexpr float EPS = 1e-6f;

constexpr size_t al256(size_t x) { return (x + 255) / 256 * 256; }
constexpr size_t WS_CTL   = 0;
constexpr size_t CTL_BYTES = 1u << 16;
constexpr size_t WS_MOD   = WS_CTL + CTL_BYTES;
constexpr size_t WS_ROPEC = al256(WS_MOD + (size_t)DEPTH * 9 * 6 * D * 4);
constexpr size_t WS_ROPES = WS_ROPEC + 64 * 16 * 4;
constexpr size_t WS_LAM   = WS_ROPES + 64 * 16 * 4;
constexpr size_t WS_SGUW  = al256(WS_LAM + 256);
constexpr size_t WS_XR    = al256(WS_SGUW + (size_t)DEPTH * 8 * 128 * 128 * 2);
constexpr size_t WS_HA    = al256(WS_XR + (size_t)RT * D * 4);
constexpr size_t WS_QB    = al256(WS_HA + (size_t)RT * D * 2);
constexpr size_t WS_KB    = al256(WS_QB + (size_t)RT * 512 * 2);
constexpr size_t WS_VB    = al256(WS_KB + (size_t)RT * 512 * 2);
constexpr size_t WS_UB    = al256(WS_VB + (size_t)RT * 512 * 2);
constexpr size_t WS_GVB   = al256(WS_UB + (size_t)RT * 512 * 2);
constexpr size_t WS_CAT   = al256(WS_GVB + (size_t)RT * 512 * 2);
constexpr size_t WS_OS    = al256(WS_CAT + (size_t)RT * D * 2);
constexpr size_t WS_AFF   = al256(WS_OS + (size_t)RT * 512 * 4);
constexpr size_t WS_INV   = al256(WS_AFF + (size_t)RT * 16 * 4);
constexpr size_t WS_RSRC  = al256(WS_INV + (size_t)RT * 16 * 4);
constexpr size_t WS_XS    = al256(WS_RSRC + (size_t)NE * ER * 4);
constexpr size_t WS_HID   = al256(WS_XS + (size_t)NE * ER * D * 2);
constexpr size_t WS_Y     = al256(WS_HID + (size_t)NE * ER * FF * 2);
constexpr size_t WS_WIN   = al256(WS_Y + (size_t)NE * ER * D * 2);
constexpr size_t WS_WOUT  = al256(WS_WIN + (size_t)DEPTH * PROJ * D * 2);
constexpr size_t WS_WGU   = al256(WS_WOUT + (size_t)DEPTH * D * D * 2);
constexpr size_t WS_WD    = al256(WS_WGU + (size_t)DEPTH * NE * 2 * FF * D * 2);
constexpr size_t WS_END   = al256(WS_WD + (size_t)DEPTH * NE * D * FF * 2);

constexpr int LDS_MISC = 147456 - 256;
constexpr int LDS_BYTES = 147456;

__device__ __forceinline__ unsigned f2bf(float f) { unsigned u = __builtin_bit_cast(unsigned, f); return (u + 0x7fffu + ((u >> 16) & 1u)) >> 16; }
__device__ __forceinline__ unsigned pk2(float lo, float hi) { return pg8::cvt_pk_bf16(lo, hi); }
__device__ __forceinline__ float bf2f(unsigned h) { return __builtin_bit_cast(float, h << 16); }
template <int CTRL> __device__ __forceinline__ float dpp(float x) { return __builtin_bit_cast(float, __builtin_amdgcn_mov_dpp(__builtin_bit_cast(int, x), CTRL, 0xf, 0xf, true)); }
constexpr int DPP_XOR1 = 0xB1, DPP_XOR2 = 0x4E, DPP_HMIR = 0x141, DPP_XOR8 = 0x128;
__device__ __forceinline__ float xrow16_sum(float x) {
    auto s = __builtin_amdgcn_permlane16_swap(__float_as_uint(x), __float_as_uint(x), false, false); x = __uint_as_float(s[0]) + __uint_as_float(s[1]);
    auto t = __builtin_amdgcn_permlane32_swap(__float_as_uint(x), __float_as_uint(x), false, false); return __uint_as_float(t[0]) + __uint_as_float(t[1]);
}
__device__ __forceinline__ float xrow16_max(float x) {
    auto s = __builtin_amdgcn_permlane16_swap(__float_as_uint(x), __float_as_uint(x), false, false); x = fmaxf(__uint_as_float(s[0]), __uint_as_float(s[1]));
    auto t = __builtin_amdgcn_permlane32_swap(__float_as_uint(x), __float_as_uint(x), false, false); return fmaxf(__uint_as_float(t[0]), __uint_as_float(t[1]));
}
__device__ __forceinline__ float wave_sum(float v) {
    v += dpp<DPP_XOR1>(v); v += dpp<DPP_XOR2>(v); v += dpp<DPP_HMIR>(v); v += dpp<DPP_XOR8>(v);
    return xrow16_sum(v);
}
#define LDS_WAIT() asm volatile("s_waitcnt lgkmcnt(0)" ::: "memory")

__constant__ double kFreq[16] = {1.0, 0.56234132519034908, 0.31622776601683794, 0.17782794100389228,
                                 0.1, 0.056234132519034908, 0.031622776601683794, 0.017782794100389228,
                                 0.01, 0.0056234132519034908, 0.0031622776601683794, 0.0017782794100389228,
                                 0.001, 0.00056234132519034908, 0.00031622776601683794, 0.00017782794100389228};
__constant__ float kLamInit[4] = {0.2f, 0.35550906759096926f, 0.47071301834358416f, 0.5560582041556405f};

__device__ __forceinline__ void sincos_d(double a, double& s, double& c) {
    const double TWO_OVER_PI = 0.63661977236758134308, PIO2_HI = 1.57079632679489655800e+00, PIO2_LO = 6.12323399573676603587e-17;
    const double kf = __builtin_rint(a * TWO_OVER_PI); const int k = (int)kf;
    const double r = (a - kf * PIO2_HI) - kf * PIO2_LO, r2 = r * r;
    double sp = -1.0 / 1307674368000.0; sp = sp * r2 + 1.0 / 6227020800.0; sp = sp * r2 - 1.0 / 39916800.0; sp = sp * r2 + 1.0 / 362880.0; sp = sp * r2 - 1.0 / 5040.0; sp = sp * r2 + 1.0 / 120.0; sp = sp * r2 - 1.0 / 6.0; sp = sp * r2 + 1.0;
    const double sr = sp * r;
    double cp = 1.0 / 20922789888000.0; cp = cp * r2 - 1.0 / 87178291200.0; cp = cp * r2 + 1.0 / 479001600.0; cp = cp * r2 - 1.0 / 3628800.0; cp = cp * r2 + 1.0 / 40320.0; cp = cp * r2 - 1.0 / 720.0; cp = cp * r2 + 1.0 / 24.0; cp = cp * r2 - 0.5; cp = cp * r2 + 1.0;
    const int q = k & 3;
    s = (q == 0) ? sr : (q == 1) ? cp : (q == 2) ? -sr : -cp;
    c = (q == 0) ? cp : (q == 1) ? -sr : (q == 2) ? -cp : sr;
}


__device__ __forceinline__ unsigned long long lds_ptr(LAS unsigned long long* tab, int i) {
    const unsigned long long v = tab[i];
    const unsigned lo = __builtin_amdgcn_readfirstlane((unsigned)v), hi = __builtin_amdgcn_readfirstlane((unsigned)(v >> 32));
    return ((unsigned long long)hi << 32) | lo;
}
struct Args { const float* in[23]; float* out; unsigned char* ws; int ph_lo, ph_hi; };
enum { I_X = 0, I_C, I_CTX, I_CCTX, I_WADA, I_BADA, I_N1G, I_N2G, I_WIN, I_WOUT, I_LQ1, I_LK1, I_LQ2, I_LK2, I_SUBG, I_SGUNG, I_SGUW, I_SGUB, I_WR, I_WG, I_WU, I_WDN, I_NFG };

__device__ __forceinline__ void transpose_item(const float* __restrict__ W, int N, int k0, int n0, bf16_t* __restrict__ WT, int K, int drow0, LAS float* scr, int lane) {
    float t[32];
#pragma unroll
    for (int i = 0; i < 32; ++i) { const int kk = 2 * i + (lane >> 5); t[i] = __builtin_nontemporal_load(&W[(size_t)(k0 + kk) * N + n0 + (lane & 31)]); }
#pragma unroll
    for (int i = 0; i < 32; ++i) { const int kk = 2 * i + (lane >> 5); scr[kk * 33 + (lane & 31)] = t[i]; }
    LDS_WAIT(); asm volatile("" ::: "memory");
    const int c = lane & 7;
#pragma unroll
    for (int j = 0; j < 4; ++j) { const int n = (lane >> 3) + 8 * j; const LAS float* s = scr + (8 * c) * 33 + n;
        u32x4 o; o.x = pk2(s[0 * 33], s[1 * 33]); o.y = pk2(s[2 * 33], s[3 * 33]); o.z = pk2(s[4 * 33], s[5 * 33]); o.w = pk2(s[6 * 33], s[7 * 33]);
        __builtin_nontemporal_store(o, (u32x4*)(WT + (size_t)(drow0 + n) * K + k0 + 8 * c)); }
    LDS_WAIT(); asm volatile("" ::: "memory");
}

__device__ __forceinline__ void row_load(const float* p, int lane, f32x4 (&v)[4]) {
    const f32x4* xr = (const f32x4*)p + lane;
#pragma unroll
    for (int j = 0; j < 4; ++j) v[j] = xr[64 * j];
}
__device__ __forceinline__ void row_store(float* p, int lane, const f32x4 (&v)[4]) {
    f32x4* xr = (f32x4*)p + lane;
#pragma unroll
    for (int j = 0; j < 4; ++j) xr[64 * j] = v[j];
}
__device__ __forceinline__ void row_load_bf(const bf16_t* p, int lane, f32x4 (&v)[4]) {
    const u32x2* xr = (const u32x2*)p + lane; u32x2 t[4];
#pragma unroll
    for (int j = 0; j < 4; ++j) t[j] = xr[64 * j];
#pragma unroll
    for (int j = 0; j < 4; ++j) v[j] = (f32x4){bf2f(t[j].x & 0xffffu), bf2f(t[j].x >> 16), bf2f(t[j].y & 0xffffu), bf2f(t[j].y >> 16)};
}
__device__ __forceinline__ void row_store_bf(bf16_t* p, int lane, const f32x4 (&v)[4]) {
    u32x2* xr = (u32x2*)p + lane;
#pragma unroll
    for (int j = 0; j < 4; ++j) { u32x2 w; w.x = pk2(v[j].x, v[j].y); w.y = pk2(v[j].z, v[j].w); xr[64 * j] = w; }
}
__device__ __forceinline__ float row_rstd(const f32x4 (&v)[4]) {
    float s = 0.f;
#pragma unroll
    for (int j = 0; j < 4; ++j) s += (v[j].x * v[j].x + v[j].y * v[j].y) + (v[j].z * v[j].z + v[j].w * v[j].w);
    return __builtin_amdgcn_rsqf(wave_sum(s) * (1.0f / D) + EPS);
}
__device__ __forceinline__ void norm_mod(f32x4 (&v)[4], const float* g, const float* sh, const float* sc, bf16_t* orow, int lane) {
    const float rstd = row_rstd(v);
    unsigned long long* o8 = (unsigned long long*)orow + lane;
#pragma unroll
    for (int j = 0; j < 4; ++j) {
        const f32x4 gg = ((const f32x4*)g)[lane + 64 * j], ss = ((const f32x4*)sh)[lane + 64 * j], cc = ((const f32x4*)sc)[lane + 64 * j];
        v[j] = (v[j] * rstd) * gg * (1.0f + cc) + ss;
        o8[64 * j] = (unsigned long long)pk2(v[j].x, v[j].y) | ((unsigned long long)pk2(v[j].z, v[j].w) << 32);
    }
}


__device__ __forceinline__ void load_mod(const float* g, const float* sh, const float* sc, int lane, f32x4 (&A)[4], f32x4 (&SH)[4]) {
#pragma unroll
    for (int j = 0; j < 4; ++j) { const f32x4 gg = ((const f32x4*)g)[lane + 64 * j], cc = ((const f32x4*)sc)[lane + 64 * j]; A[j] = gg * (1.0f + cc); SH[j] = ((const f32x4*)sh)[lane + 64 * j]; }
}
__device__ __forceinline__ void norm_mod2(f32x4 (&v)[4], const f32x4 (&A)[4], const f32x4 (&SH)[4], bf16_t* orow, int lane) {
    const float rstd = row_rstd(v);
    unsigned long long* o8 = (unsigned long long*)orow + lane;
#pragma unroll
    for (int j = 0; j < 4; ++j) { v[j] = (v[j] * rstd) * A[j] + SH[j];
        o8[64 * j] = (unsigned long long)pk2(v[j].x, v[j].y) | ((unsigned long long)pk2(v[j].z, v[j].w) << 32); }
}

__device__ __forceinline__ void norm_mod_lds(f32x4 (&v)[4], const LAS float* A, const LAS float* SH, bf16_t* orow, int lane) {
    const float rstd = row_rstd(v);
    unsigned long long* o8 = (unsigned long long*)orow + lane;
#pragma unroll
    for (int j = 0; j < 4; ++j) { v[j] = (v[j] * rstd) * *(const LAS f32x4*)(A + (lane + 64 * j) * 4) + *(const LAS f32x4*)(SH + (lane + 64 * j) * 4);
        o8[64 * j] = (unsigned long long)pk2(v[j].x, v[j].y) | ((unsigned long long)pk2(v[j].z, v[j].w) << 32); }
}

__device__ __forceinline__ float reduce16(const float (&p)[16], int lane) {
    float q8[8], q4[4], q2[2];
#pragma unroll
    for (int i = 0; i < 8; ++i) { auto rr = __builtin_amdgcn_permlane32_swap(__float_as_uint(p[i]), __float_as_uint(p[i + 8]), false, false); q8[i] = __uint_as_float(rr[0]) + __uint_as_float(rr[1]); }
    { const bool up = (lane & 16) != 0;
#pragma unroll
      for (int i = 0; i < 4; ++i) { const float snd = up ? q8[i] : q8[i + 4], kp = up ? q8[i + 4] : q8[i]; q4[i] = kp + __shfl_xor(snd, 16); } }
    { const bool up = (lane & 8) != 0;
#pragma unroll
      for (int i = 0; i < 2; ++i) { const float snd = up ? q4[i] : q4[i + 2], kp = up ? q4[i + 2] : q4[i]; q2[i] = kp + dpp<DPP_XOR8>(snd); } }
    float r;
    { const bool up = (lane & 4) != 0; const float snd = up ? q2[0] : q2[1], kp = up ? q2[1] : q2[0]; r = kp + dpp<DPP_HMIR>(snd); }
    r += dpp<DPP_XOR2>(r); r += dpp<DPP_XOR1>(r);
    return r;
}
__device__ __forceinline__ int lane_expert(int lane) { return ((lane >> 5) & 1) * 8 + ((lane >> 4) & 1) * 4 + ((lane >> 3) & 1) * 2 + ((lane >> 2) & 1); }

struct EpiInProj {
    static constexpr bool PERM = false, TWICE = true;
    bf16_t *Q, *Kb, *V, *U, *GV; const float *ropeC, *ropeS;
    __device__ __forceinline__ void operator()(const pg8::f32x4 (&acc)[2][2][4][2], const pg8::Unit& u, int wr, int wc, int fr_, int fq_) const {
        int fr = fr_, fq = fq_; asm volatile("" : "+v"(fr), "+v"(fq));
        const int type = u.pn >> 1;
        bf16_t* base = type == 0 ? Q : type == 1 ? Kb : type == 2 ? V : type == 3 ? U : GV;
        const int col0 = (u.pn & 1) * 256 + wc * 32 + 4 * fq;
        const int row0 = u.pm * 256 + wr * 64 + fr;
        const bool lat = (u.pm % 17) != 0;
        const float qs = (type == 0) ? 0.125f : 1.0f;
        if (type <= 1) {
            f32x4 csT[4], snT[4];
            const bool colax = (wc & 1) != 0;
#pragma unroll
            for (int t = 0; t < 4; ++t) { csT[t] = (f32x4){1.f, 1.f, 1.f, 1.f}; snT[t] = (f32x4){0.f, 0.f, 0.f, 0.f}; }
            if (lat) {
                if (colax) {
#pragma unroll
                    for (int m = 0; m < 4; ++m) { const int pos = m * 16 + fr; csT[m] = *(const f32x4*)(ropeC + pos * 16 + 4 * fq); snT[m] = *(const f32x4*)(ropeS + pos * 16 + 4 * fq); }
                } else {
#pragma unroll
                    for (int ai = 0; ai < 2; ++ai) { const int pos = (((row0 + ai * 128) % RPB) - CTXL) >> 6; csT[ai] = *(const f32x4*)(ropeC + pos * 16 + 4 * fq); snT[ai] = *(const f32x4*)(ropeS + pos * 16 + 4 * fq); }
                }
            }
            asm volatile("" ::: "memory");
#pragma unroll
            for (int ai = 0; ai < 2; ++ai)
#pragma unroll
                for (int m = 0; m < 4; ++m) {
                    const int row = row0 + ai * 128 + m * 16;
                    const f32x4 cs = colax ? csT[m] : csT[ai], sn = colax ? snT[m] : snT[ai];
                    bf16_t* rowp = base + (size_t)row * 512 + col0;
#pragma unroll
                    for (int bj = 0; bj < 2; ++bj) {
                        const f32x4 t0 = acc[ai][bj][m][0], t1 = acc[ai][bj][m][1];
                        const f32x4 o0 = (t0 * cs - t1 * sn) * qs, o1 = (t1 * cs + t0 * sn) * qs;
                        u32x2 w0, w1; w0.x = pk2(o0[0], o0[1]); w0.y = pk2(o0[2], o0[3]); w1.x = pk2(o1[0], o1[1]); w1.y = pk2(o1[2], o1[3]);
                        *(u32x2*)(rowp + bj * 128) = w0; *(u32x2*)(rowp + bj * 128 + 16) = w1;
                    }
                }
        } else if (type == 2) {
#pragma unroll
            for (int ai = 0; ai < 2; ++ai)
#pragma unroll
                for (int m = 0; m < 4; ++m) {
                    bf16_t* rowp = base + (size_t)(row0 + ai * 128 + m * 16) * 512 + col0;
#pragma unroll
                    for (int bj = 0; bj < 2; ++bj)
#pragma unroll
                        for (int n = 0; n < 2; ++n) {
                            const f32x4 v = acc[ai][bj][m][n];
                            u32x2 w; w.x = pk2(v[0], v[1]); w.y = pk2(v[2], v[3]);
                            *(u32x2*)(rowp + bj * 128 + n * 16) = w;
                        }
                }
        } else {
#pragma unroll
            for (int ai = 0; ai < 2; ++ai)
#pragma unroll
                for (int m = 0; m < 4; ++m) {
                    bf16_t* rowp = base + (size_t)(row0 + ai * 128 + m * 16) * 512 + col0;
                    u32x2 w[2][2];
#pragma unroll
                    for (int bj = 0; bj < 2; ++bj)
#pragma unroll
                        for (int n = 0; n < 2; ++n) {
                            f32x4 v = acc[ai][bj][m][n];
#ifdef GELU_X2
                            { f32x4 t_ = pg8::gelu4(v * 1.0001f); asm volatile("" :: "v"(t_)); }
#endif
                            v = pg8::gelu4(v);
                            w[bj][n].x = pk2(v[0], v[1]); w[bj][n].y = pk2(v[2], v[3]);
                        }
#pragma unroll
                    for (int bj = 0; bj < 2; ++bj)
#pragma unroll
                        for (int n = 0; n < 2; ++n) *(u32x2*)(rowp + bj * 128 + n * 16) = w[bj][n];
                }
        }
    }
};
struct EpiOutProj {
    static constexpr bool PERM = true, TWICE = false;
    bf16_t* XR; const float* modl; float scale;
    __device__ __forceinline__ void operator()(const pg8::f32x4 (&acc)[2][2][4][2], const pg8::Unit& u, int wr, int wc, int fr_, int fq_) const {
        int fr = fr_, fq = fq_; asm volatile("" : "+v"(fr), "+v"(fq));
        const int b = u.pm / 17; const int mrow = (u.pm % 17) == 0 ? 8 : b;
        const int col0 = u.pn * 256 + wc * 32 + 8 * fq, row0 = u.pm * 256 + wr * 64 + fr;
        const float* gp = modl + (size_t)mrow * 6144 + 2 * D + col0;
        f32x4 gv[2][2];
#pragma unroll
        for (int bj = 0; bj < 2; ++bj)
#pragma unroll
            for (int n = 0; n < 2; ++n) gv[bj][n] = *(const f32x4*)(gp + bj * 128 + n * 4);
#pragma unroll
        for (int ai = 0; ai < 2; ++ai) {
            u32x4 xv[4][2];
#pragma unroll
            for (int m = 0; m < 4; ++m)
#pragma unroll
                for (int bj = 0; bj < 2; ++bj) xv[m][bj] = *(const u32x4*)(XR + (size_t)(row0 + ai * 128 + m * 16) * D + col0 + bj * 128);
            asm volatile("" ::: "memory");
#pragma unroll
            for (int m = 0; m < 4; ++m)
#pragma unroll
                for (int bj = 0; bj < 2; ++bj) {
                    const u32x4 x = xv[m][bj];
                    const f32x4 x0 = (f32x4){bf2f(x.x & 0xffffu), bf2f(x.x >> 16), bf2f(x.y & 0xffffu), bf2f(x.y >> 16)}, x1 = (f32x4){bf2f(x.z & 0xffffu), bf2f(x.z >> 16), bf2f(x.w & 0xffffu), bf2f(x.w >> 16)};
                    const f32x4 o0 = x0 + gv[bj][0] * acc[ai][bj][m][0], o1 = x1 + gv[bj][1] * acc[ai][bj][m][1];
                    u32x4 w; w.x = pk2(o0.x, o0.y); w.y = pk2(o0.z, o0.w); w.z = pk2(o1.x, o1.y); w.w = pk2(o1.z, o1.w);
                    *(u32x4*)(XR + (size_t)(row0 + ai * 128 + m * 16) * D + col0 + bj * 128) = w;
                }
            asm volatile("" ::: "memory");
        }
    }
};
struct EpiGateUp {
    static constexpr bool PERM = true;
    bf16_t* HID;
    __device__ __forceinline__ void operator()(const pg8::f32x4 (&acc)[2][2][4][2], const pg8::Unit& u, int wr, int wc, int fr_, int fq_) const {
        int fr = fr_, fq = fq_; asm volatile("" : "+v"(fr), "+v"(fq));
        const int j = u.pn & 15; const int col0 = j * 128 + wc * 32 + 8 * fq, row0 = u.pm * 256 + wr * 64 + fr;
#pragma unroll
        for (int ai = 0; ai < 2; ++ai)
#pragma unroll
            for (int m = 0; m < 4; ++m) {
                float hv[8];
#pragma unroll
                for (int n = 0; n < 2; ++n)
#pragma unroll
                    for (int i = 0; i < 4; ++i) { const float gt = acc[ai][0][m][n][i], up = acc[ai][1][m][n][i];
                        hv[n * 4 + i] = gt * __builtin_amdgcn_rcpf(1.0f + __expf(-gt)) * up; }
                u32x4 w; w.x = pk2(hv[0], hv[1]); w.y = pk2(hv[2], hv[3]); w.z = pk2(hv[4], hv[5]); w.w = pk2(hv[6], hv[7]);
                *(u32x4*)(HID + (size_t)(row0 + ai * 128 + m * 16) * FF + col0) = w;
            }
    }
};
struct EpiDown {
    static constexpr bool PERM = true, TWICE = false;
    bf16_t* Y;
    __device__ __forceinline__ void operator()(const pg8::f32x4 (&acc)[2][2][4][2], const pg8::Unit& u, int wr, int wc, int fr_, int fq_) const {
        int fr = fr_, fq = fq_; asm volatile("" : "+v"(fr), "+v"(fq));
        const int col0 = (u.pn & 3) * 256 + wc * 32 + 8 * fq, row0 = u.pm * 256 + wr * 64 + fr;
#pragma unroll
        for (int ai = 0; ai < 2; ++ai)
#pragma unroll
            for (int m = 0; m < 4; ++m) { bf16_t* rowp = Y + (size_t)(row0 + ai * 128 + m * 16) * D + col0;
#pragma unroll
                for (int bj = 0; bj < 2; ++bj) { const f32x4 v0 = acc[ai][bj][m][0], v1 = acc[ai][bj][m][1];
                    u32x4 w; w.x = pk2(v0[0], v0[1]); w.y = pk2(v0[2], v0[3]); w.z = pk2(v1[0], v1[1]); w.w = pk2(v1[2], v1[3]);
                    *(u32x4*)(rowp + bj * 128) = w; } }
    }
};

#define GAS1 __attribute__((address_space(1)))
#define INP(i) ((const float*)(GAS1 const float*)lds_ptr(ptab, (i)))
#define MOD   ((float*)(ws + WS_MOD))
#define ROPEC ((float*)(ws + WS_ROPEC))
#define ROPES ((float*)(ws + WS_ROPES))
#define LAMV  ((float*)(ws + WS_LAM))
#define SGUW  ((bf16_t*)(ws + WS_SGUW))
#define XR    ((bf16_t*)(ws + WS_XR))
#define HA    ((bf16_t*)(ws + WS_HA))
#define QB    ((bf16_t*)(ws + WS_QB))
#define KB    ((bf16_t*)(ws + WS_KB))
#define VB    ((bf16_t*)(ws + WS_VB))
#define UB    ((bf16_t*)(ws + WS_UB))
#define GVB   ((bf16_t*)(ws + WS_GVB))
#define CAT   ((bf16_t*)(ws + WS_CAT))
#define OS    ((float*)(ws + WS_OS))
#define AFF   ((float*)(ws + WS_AFF))
#define INV   ((int*)(ws + WS_INV))
#define RSRC  ((int*)(ws + WS_RSRC))
#define XS    ((bf16_t*)(ws + WS_XS))
#define HID   ((bf16_t*)(ws + WS_HID))
#define Y     ((bf16_t*)(ws + WS_Y))
#define WIN   ((bf16_t*)(ws + WS_WIN))
#define WOUT  ((bf16_t*)(ws + WS_WOUT))
#define WGU   ((bf16_t*)(ws + WS_WGU))
#define WD    ((bf16_t*)(ws + WS_WD))
#define modl  (MOD + (size_t)l * 9 * 6144)
#define PIN_WS() unsigned char* const ws = (unsigned char*)(GAS1 unsigned char*)lds_ptr(ptab, 24)
#define PIN_IDS2() int tid = threadIdx.x; asm volatile("" : "+v"(tid)); const int lane = tid & 63, wave = __builtin_amdgcn_readfirstlane(tid >> 6)
#define PIN_IDS() int tid = threadIdx.x; asm volatile("" : "+v"(tid)); const int lane = tid & 63, wave = __builtin_amdgcn_readfirstlane(tid >> 6), gw = bx * NWAVES + wave; (void)lane; (void)gw; PIN_WS()
#ifndef PH_MASK
#define PH_MASK 0x7ff
#endif
#define INR(k) (lo <= (k) && (k) < hi)
#define IN(k) (((PH_MASK >> (k)) & 1) && INR(k))
#define INL(c) (((PH_MASK >> (2 + (c))) & 1) && INR(pb + (c)))
#ifndef PH_DUP
#define PH_DUP 0
#endif
#define REPS(c) (((PH_DUP >> (c)) & 1) ? 2 : 1)
#define SEAM(k) do { if (INR(k) && INR((k) + 1)) xcd_barrier(bar); } while (0)

constexpr size_t CTL_QUEUE = 16384;
__device__ __forceinline__ int queue_pull(unsigned* ctr, volatile LAS unsigned* slot, int tid) {
    __syncthreads();
    if (tid == 0) *slot = __hip_atomic_fetch_add(ctr, 1u, __ATOMIC_RELAXED, __HIP_MEMORY_SCOPE_AGENT);
    __syncthreads();
    return __builtin_amdgcn_readfirstlane((int)*slot);
}
constexpr int IT_IN = 16 * 80, IT_OUT = 16 * 32, IT_E = 1024, IT_L = IT_IN + IT_OUT + NE * 3 * IT_E;
__device__ __forceinline__ void convert_range(LAS unsigned long long* ptab, unsigned char* ws, LAS unsigned char* ldsl, int l, int it0, int it1, int rank, int nranks, int wave, int lane) {
    LAS float* scr = (LAS float*)(ldsl + 65536 + wave * 8704);
#pragma unroll 1
    for (int it = it0 + rank; it < it1; it += nranks) {
        int r = it;
        if (r < IT_IN) { const int kb = r / 80, nb = r % 80; transpose_item(INP(I_WIN) + (size_t)l * D * PROJ, PROJ, kb * 64, nb * 32, WIN + (size_t)l * PROJ * D, D, nb * 32, scr, lane); continue; }
        r -= IT_IN;
        if (r < IT_OUT) { const int kb = r / 32, nb = r % 32; transpose_item(INP(I_WOUT) + (size_t)l * D * D, D, kb * 64, nb * 32, WOUT + (size_t)l * D * D, D, nb * 32, scr, lane); continue; }
        r -= IT_OUT;
        if (r < NE * 2 * IT_E) { const int e = r / (2 * IT_E), which = (r % (2 * IT_E)) / IT_E, q = r % IT_E; const size_t le = (size_t)l * NE + e;
            const int kb = q / 64, nb = q % 64, n0 = nb * 32;
            transpose_item(INP(which == 0 ? I_WG : I_WU) + le * D * FF, FF, kb * 64, n0, WGU + le * (2 * FF) * D, D, 256 * (n0 >> 7) + which * 128 + (n0 & 127), scr, lane); continue; }
        r -= NE * 2 * IT_E;
        { const int e = r / IT_E, q = r % IT_E; const size_t le = (size_t)l * NE + e; const int kb = q / 32, nb = q % 32;
            transpose_item(INP(I_WDN) + le * FF * D, D, kb * 64, nb * 32, WD + le * D * FF, FF, nb * 32, scr, lane); }
    }
}
constexpr int CV_P = 26444, CV_Q = CV_P + 12000;
template <int L>
__device__ __forceinline__ void layer_body(unsigned char* lds, LAS unsigned char* ldsl, LAS unsigned long long* ptab, const XcdBarrier& bar, const int lo, const int hi, const int G, const int bx, const int NGW) {
    constexpr int l = L, pb = 2 + 9 * L; constexpr bool lastl = (L == DEPTH - 1);
        _Pragma("unroll 1") for (int rep = 0; rep < REPS(2); ++rep) {
        if (INL(0)) {
            PIN_WS();
            pg8::Gemm g{HA, WIN + (size_t)l * PROJ * D, RT, PROJ, D}; pg8::StaticOrder S; S.init(RT, PROJ, G, bx);
            EpiInProj E{QB, KB, VB, UB, GVB, ROPEC, ROPES};
            pg8::gemm_phase<EpiInProj, pg8::StaticOrder>(ldsl, g, S, E);
            if (G == 256 && bx >= 80) { PIN_IDS2(); convert_range(ptab, ws, ldsl, l, CV_P, CV_Q, (bx - 80) * NWAVES + wave, (G - 80) * NWAVES, wave, lane); }
        }
        SEAM(pb + 0); }
        _Pragma("unroll 1") for (int rep = 0; rep < REPS(3); ++rep) {
        if (INL(1)) {
            PIN_IDS();
            const float lam = LAMV[l], osc = 1.0f - kLamInit[l];
            const float* subg = INP(I_SUBG) + l * 128;
            constexpr int NU_LAT = NB * 4 * 16, NU_CTX = NB * 4, NU_SGU = NB * 34;
            const int vcu = (G % 8 == 0) ? (bx % 8) * (G / 8) + bx / 8 : bx;
            unsigned* qA = (unsigned*)(ws + WS_CTL + CTL_QUEUE + (l * 2 + 0) * 64); unsigned* qB = (unsigned*)(ws + WS_CTL + CTL_QUEUE + (l * 2 + 1) * 64);
            volatile LAS unsigned* qslot = (volatile LAS unsigned*)(ldsl + LDS_MISC + 16);
            bool dyn = false;
            for (int u = vcu;;) {
                if (!dyn && u >= NU_LAT) dyn = true;
                if (dyn) { if (lastl) break;
                    const int it = queue_pull(qA, qslot, tid); if (it >= NU_CTX) break; u = NU_LAT + it; }
                {
                    int b, h; long rq0; int nk;
                    if (u < NU_LAT) { b = u >> 6; h = (u >> 4) & 3; rq0 = (long)b * RPB + CTXL + (u & 15) * 256; nk = RPB; }
                    else { const int v2 = u - NU_LAT; b = v2 >> 2; h = v2 & 3; rq0 = (long)b * RPB; nk = CTXL; }
#ifndef NO_ATT
                    att::attn_unit(QB, KB, VB, OS, CAT, subg, lam, osc, h, rq0, (long)b * RPB, nk, (char*)lds);
#endif
                }
                if (!dyn) u += G;
            }
            {
            int tid2 = threadIdx.x; asm volatile("" : "+v"(tid2)); const int lane = tid2 & 63, wave = __builtin_amdgcn_readfirstlane(tid2 >> 6);
            constexpr int NHU = NU_SGU * 2;
            for (;;) { const int s = queue_pull(qB, qslot, tid2); if (s >= NHU) break;
                const int b = s / 68, rem = s % 68, ch = rem >> 1, hg = rem & 1;
                if (lastl && ch < 2) continue;
                {
#ifndef NO_SGU
                    const int hl2 = wave & 3, ph = wave >> 2, h = hg * 4 + hl2;
                    const size_t r0 = (size_t)b * RPB + ch * 128;
                    const int fr = lane & 15, fq = lane >> 4;
                    const bf16_t* Wh = SGUW + ((size_t)l * 8 + h) * 128 * 128;
                    const float* bs = INP(I_SGUB) + (l * 8 + h) * 128;
                    u32x4 uu[4][2]; bf16x8 afA[4], afB[4];
#pragma unroll
                    for (int i = 0; i < 4; ++i)
#pragma unroll
                        for (int gi = 0; gi < 2; ++gi) uu[i][gi] = *(const u32x4*)(UB + (r0 + (ph * 4 + i) * 16 + fr) * 512 + h * 64 + gi * 32 + fq * 8);
#pragma unroll
                    for (int ks = 0; ks < 4; ++ks) { afA[ks] = *(const bf16x8*)(Wh + (size_t)(ph * 64 + fr) * 128 + ks * 32 + fq * 8); afB[ks] = *(const bf16x8*)(Wh + (size_t)(ph * 64 + 16 + fr) * 128 + ks * 32 + fq * 8); }
                    {
                        const int hf = lane >> 5, l32 = lane & 31, hl = l32 >> 3, e8 = (l32 & 7) * 8;
                        const bf16_t* gsrc = GVB + (r0 + wave * 16 + hf * 8) * 512 + hg * 256 + l32 * 8;
                        const f32x4 ga = *(const f32x4*)(INP(I_SGUNG) + l * 512 + hg * 256 + l32 * 8), gb = *(const f32x4*)(INP(I_SGUNG) + l * 512 + hg * 256 + l32 * 8 + 4);
                        const float gg[8] = {ga.x, ga.y, ga.z, ga.w, gb.x, gb.y, gb.z, gb.w};
                        LAS bf16_t* gTh = (LAS bf16_t*)(ldsl + hl * 17424);
                        int slot[8];
#pragma unroll
                        for (int j = 0; j < 8; ++j) { const int e = e8 + j; slot[j] = ((e & 32) + 16 * ((e >> 2) & 1) + 4 * ((e & 31) >> 3) + (e & 3)) * 136; }
                        u32x4 raw[8];
#pragma unroll
                        for (int t = 0; t < 8; ++t) raw[t] = *(const u32x4*)(gsrc + t * 512);
#pragma unroll
                        for (int tb = 0; tb < 2; ++tb) {
                            float xn[4][8];
#pragma unroll
                            for (int t = 0; t < 4; ++t) {
                                float ssq = 0.f;
#pragma unroll
                                for (int k = 0; k < 4; ++k) { xn[t][2 * k] = bf2f(raw[tb * 4 + t][k] & 0xffffu); xn[t][2 * k + 1] = bf2f(raw[tb * 4 + t][k] >> 16); ssq += xn[t][2 * k] * xn[t][2 * k] + xn[t][2 * k + 1] * xn[t][2 * k + 1]; }
                                ssq += __shfl_xor(ssq, 1); ssq += __shfl_xor(ssq, 2); ssq += __shfl_xor(ssq, 4);
                                const float rs = __builtin_amdgcn_rsqf(ssq * (1.0f / 64.0f) + EPS);
#pragma unroll
                                for (int j = 0; j < 8; ++j) xn[t][j] = xn[t][j] * rs * gg[j];
                            }
                            const int q0 = wave * 16 + hf * 8 + tb * 4;
#pragma unroll
                            for (int j = 0; j < 8; ++j) { u32x2 w; w.x = pk2(xn[0][j], xn[1][j]); w.y = pk2(xn[2][j], xn[3][j]); *(LAS u32x2*)(gTh + slot[j] + q0) = w; }
                        }
                    }
                    __syncthreads();
                    {
                        LAS bf16_t* gT = (LAS bf16_t*)(ldsl + hl2 * 17424);
#pragma unroll
                        for (int i = 0; i < 4; ++i) {
                            const int p = (ph * 4 + i) * 16 + fr;
                            bf16x8 af[4];
#pragma unroll
                            for (int ks = 0; ks < 4; ++ks) af[ks] = (i & 1) ? afB[ks] : afA[ks];
                            if (i + 2 < 4) {
#pragma unroll
                                for (int ks = 0; ks < 4; ++ks) { const bf16x8 nv = *(const bf16x8*)(Wh + (size_t)(p + 32) * 128 + ks * 32 + fq * 8); if (i & 1) afB[ks] = nv; else afA[ks] = nv; } }
                            const float bsp = bs[p];
#pragma unroll
                            for (int gi = 0; gi < 2; ++gi) {
                                pg8::f32x4 a0 = (pg8::f32x4){0.f, 0.f, 0.f, 0.f}, a1 = (pg8::f32x4){0.f, 0.f, 0.f, 0.f};
#pragma unroll
                                for (int ks = 0; ks < 4; ++ks) {
                                    const bf16x8 b0 = *(const LAS bf16x8*)(gT + (gi * 32 + fr) * 136 + ks * 32 + fq * 8), b1 = *(const LAS bf16x8*)(gT + (gi * 32 + 16 + fr) * 136 + ks * 32 + fq * 8);
                                    a0 = __builtin_amdgcn_mfma_f32_16x16x32_bf16(b0, af[ks], a0, 0, 0, 0); a1 = __builtin_amdgcn_mfma_f32_16x16x32_bf16(b1, af[ks], a1, 0, 0, 0); }
                                const u32x4 ur = uu[i][gi];
                                u32x4 w;
                                w.x = pk2(bf2f(ur.x & 0xffffu) * (a0[0] + bsp), bf2f(ur.x >> 16) * (a0[1] + bsp)); w.y = pk2(bf2f(ur.y & 0xffffu) * (a0[2] + bsp), bf2f(ur.y >> 16) * (a0[3] + bsp));
                                w.z = pk2(bf2f(ur.z & 0xffffu) * (a1[0] + bsp), bf2f(ur.z >> 16) * (a1[1] + bsp)); w.w = pk2(bf2f(ur.w & 0xffffu) * (a1[2] + bsp), bf2f(ur.w >> 16) * (a1[3] + bsp));
                                *(u32x4*)(CAT + (r0 + p) * 1024 + 512 + h * 64 + gi * 32 + fq * 8) = w;
                            }
                            asm volatile("" ::: "memory");
                        }
                    }
                    LDS_WAIT(); asm volatile("" ::: "memory");
                    __syncthreads();
#endif
                }
            }
            }
        }
        SEAM(pb + 1); }
        _Pragma("unroll 1") for (int rep = 0; rep < REPS(4); ++rep) {
        if (INL(2)) {
            PIN_WS();
            pg8::Gemm g{CAT, WOUT + (size_t)l * D * D, RT, D, D}; pg8::GroupedOrder S; S.init(NB, lastl ? 16 : 17, 17, lastl ? 1 : 0, D / 256, 0, G, bx);
            EpiOutProj E{XR, modl, rep == 0 ? 1.0f : 0.0f};
            pg8::gemm_phase<EpiOutProj, pg8::GroupedOrder>(ldsl, g, S, E);
            if (G == 256 && bx >= 32) { PIN_IDS2(); convert_range(ptab, ws, ldsl, l, CV_Q, IT_L, (bx - 32) * NWAVES + wave, (G - 32) * NWAVES, wave, lane); }
        }
        SEAM(pb + 2); }
        _Pragma("unroll 1") for (int rep = 0; rep < REPS(5); ++rep) {
        if (INL(3)) {
            PIN_IDS();
            constexpr int WSTR = 1028;
            LAS float* wT = (LAS float*)ldsl;
            { const f32x4* wsrc = (const f32x4*)(INP(I_WR) + (size_t)l * 1024 * 16); f32x4 wv[8];
#pragma unroll
              for (int t = 0; t < 8; ++t) wv[t] = wsrc[tid + NTHR * t];
#pragma unroll
              for (int t = 0; t < 8; ++t) { const int i4 = tid + NTHR * t, k = i4 >> 2, e0 = (i4 & 3) * 4;
                  wT[(e0 + 0) * WSTR + k] = wv[t].x; wT[(e0 + 1) * WSTR + k] = wv[t].y; wT[(e0 + 2) * WSTR + k] = wv[t].z; wT[(e0 + 3) * WSTR + k] = wv[t].w; } }
            LAS float* modA = (LAS float*)(ldsl + 16 * WSTR * 4);
            LAS float* modS = modA + 9 * 1024;
            for (int i = tid; i < 9 * 256; i += NTHR) { const int c = i >> 8, k4 = i & 255;
                const float* mm = modl + (size_t)c * 6144; const f32x4 gg = ((const f32x4*)(INP(I_N2G) + l * D))[k4], ss = ((const f32x4*)(mm + 3 * D))[k4], cc = ((const f32x4*)(mm + 4 * D))[k4];
                *(LAS f32x4*)(modA + c * 1024 + k4 * 4) = gg * (1.0f + cc); *(LAS f32x4*)(modS + c * 1024 + k4 * 4) = ss; }
            __syncthreads();
            {
            constexpr int NG16 = RT / 16;
            const int r16 = lane & 15, kq = lane >> 4;
            const bool spread = (NGW == 2048);
#pragma unroll 1
            for (int pass = 0;; ++pass) {
                int grp;
                if (spread) { if (pass == 0) grp = gw; else if (pass == 1 && (gw & 15) == 0) grp = 2048 + (gw >> 4); else break; }
                else { grp = gw + pass * NGW; }
                if (grp >= NG16) break;
                const int row0 = grp * 16, b = row0 / RPB, j0 = row0 % RPB;
                if (lastl && j0 < CTXL) continue;
                const int mrow = (j0 < CTXL) ? 8 : b;
                const int row = row0 + r16;
                const u32x4* src = (const u32x4*)(XR + (size_t)row * D + 8 * kq);
                u32x4 raw[32];
#pragma unroll
                for (int t = 0; t < 32; ++t) raw[t] = src[4 * t];
                float ssq = 0.f;
#pragma unroll
                for (int t = 0; t < 32; ++t)
#pragma unroll
                    for (int c = 0; c < 4; ++c) { float lo_, hi_;
                        asm volatile("v_lshlrev_b32 %1, 16, %3\n\tv_and_b32 %2, 0xffff0000, %3\n\tv_fmac_f32 %0, %1, %1\n\tv_fmac_f32 %0, %2, %2" : "+v"(ssq), "=&v"(lo_), "=&v"(hi_) : "v"(raw[t][c])); }
                ssq = xrow16_sum(ssq);
                const float rstd = __builtin_amdgcn_rsqf(ssq * (1.0f / D) + EPS);
                const LAS float* Ac = modA + mrow * 1024 + 8 * kq; const LAS float* Sc = modS + mrow * 1024 + 8 * kq; const LAS float* Wc = wT + r16 * WSTR + 8 * kq;
                u32x4* dst = (u32x4*)(HA + (size_t)row * D + 8 * kq);
                pg8::f32x4 acc0 = (pg8::f32x4){0.f, 0.f, 0.f, 0.f}, acc1 = (pg8::f32x4){0.f, 0.f, 0.f, 0.f};
#pragma unroll
                for (int t = 0; t < 32; ++t) {
                    const f32x4 a0 = *(const LAS f32x4*)(Ac + 32 * t), a1 = *(const LAS f32x4*)(Ac + 32 * t + 4), s0 = *(const LAS f32x4*)(Sc + 32 * t), s1 = *(const LAS f32x4*)(Sc + 32 * t + 4);
                    const f32x4 w0 = *(const LAS f32x4*)(Wc + 32 * t), w1 = *(const LAS f32x4*)(Wc + 32 * t + 4);
                    const u32x4 rw = raw[t];
                    f32x4 h0 = (f32x4){bf2f(rw.x & 0xffffu), bf2f(rw.x >> 16), bf2f(rw.y & 0xffffu), bf2f(rw.y >> 16)}, h1 = (f32x4){bf2f(rw.z & 0xffffu), bf2f(rw.z >> 16), bf2f(rw.w & 0xffffu), bf2f(rw.w >> 16)};
                    h0 = (h0 * rstd) * a0 + s0; h1 = (h1 * rstd) * a1 + s1;
                    u32x4 o; o.x = pk2(h0.x, h0.y); o.y = pk2(h0.z, h0.w); o.z = pk2(h1.x, h1.y); o.w = pk2(h1.z, h1.w);
                    dst[4 * t] = o;
                    acc0 = __builtin_amdgcn_mfma_f32_16x16x4f32(w0.x, h0.x, acc0, 0, 0, 0); acc1 = __builtin_amdgcn_mfma_f32_16x16x4f32(w0.y, h0.y, acc1, 0, 0, 0);
                    acc0 = __builtin_amdgcn_mfma_f32_16x16x4f32(w0.z, h0.z, acc0, 0, 0, 0); acc1 = __builtin_amdgcn_mfma_f32_16x16x4f32(w0.w, h0.w, acc1, 0, 0, 0);
                    acc0 = __builtin_amdgcn_mfma_f32_16x16x4f32(w1.x, h1.x, acc0, 0, 0, 0); acc1 = __builtin_amdgcn_mfma_f32_16x16x4f32(w1.y, h1.y, acc1, 0, 0, 0);
                    acc0 = __builtin_amdgcn_mfma_f32_16x16x4f32(w1.z, h1.z, acc0, 0, 0, 0); acc1 = __builtin_amdgcn_mfma_f32_16x16x4f32(w1.w, h1.w, acc1, 0, 0, 0);
                    asm volatile("" ::: "memory");
                }
                const pg8::f32x4 lg = acc0 + acc1;
                float mx = fmaxf(fmaxf(lg[0], lg[1]), fmaxf(lg[2], lg[3])); mx = xrow16_max(mx);
                f32x4 ex; ex.x = expf(lg[0] - mx); ex.y = expf(lg[1] - mx); ex.z = expf(lg[2] - mx); ex.w = expf(lg[3] - mx);
                float sm = (ex.x + ex.y) + (ex.z + ex.w); sm = xrow16_sum(sm);
                const float inv = 1.0f / sm;
                *(f32x4*)(AFF + (size_t)row * 16 + 4 * kq) = ex * inv;
            }
            }
            __syncthreads();
        }
        SEAM(pb + 3); }
        _Pragma("unroll 1") for (int rep = 0; rep < REPS(6); ++rep) {
        if (INL(4)) {
            PIN_IDS();
            LAS unsigned* keys = (LAS unsigned*)ldsl;
            LAS unsigned* hist = keys + 4096;
            LAS unsigned* wtot = hist + 256;
            LAS unsigned* sel = wtot + 8;
            for (int gq = bx; gq < (lastl ? 128 : 256); gq += G) {
                const int stream = gq >> 7, b = (gq >> 4) & 7, e = gq & 15;
                const int n = stream ? CTXL : SEQ, cap = stream ? CAP_C : CAP_L;
                const int row0 = b * RPB + (stream ? 0 : CTXL), sbase = stream ? NB * CAP_L + b * CAP_C : b * CAP_L;
                { unsigned kv8[8];
#pragma unroll
                  for (int t = 0; t < 8; ++t) { const int i = tid + NTHR * t; kv8[t] = (i < n) ? __float_as_uint(AFF[(size_t)(row0 + i) * 16 + e]) : 0u; }
#pragma unroll
                  for (int t = 0; t < 8; ++t) { const int i = tid + NTHR * t; if (i < n) keys[i] = kv8[t]; } }
                unsigned prefix = 0u, mask = 0u, kk = (unsigned)cap;
                for (int pass = 0; pass < 4; ++pass) {
                    const int shift = 24 - 8 * pass;
                    if (tid < 256) hist[tid] = 0u;
                    __syncthreads();
                    for (int i = tid; i < n; i += NTHR) { const unsigned kv = keys[i]; if ((kv & mask) == prefix) __hip_atomic_fetch_add(&hist[(kv >> shift) & 255u], 1u, __ATOMIC_RELAXED, __HIP_MEMORY_SCOPE_WORKGROUP); }
                    __syncthreads();
                    if (wave == 0) {
                        const unsigned c0 = hist[4 * lane], c1 = hist[4 * lane + 1], c2 = hist[4 * lane + 2], c3 = hist[4 * lane + 3], tot = (c0 + c1) + (c2 + c3);
                        unsigned inc = tot;
#pragma unroll
                        for (int o = 1; o < 64; o <<= 1) { const unsigned t = __shfl_down(inc, o); if (lane + o < 64) inc += t; }
                        const unsigned excl = inc - tot;
                        if (excl < kk && excl + tot >= kk) { unsigned run = excl, dsel, knew;
                            if (run + c3 >= kk) { dsel = 4u * lane + 3u; knew = kk - run; }
                            else { run += c3; if (run + c2 >= kk) { dsel = 4u * lane + 2u; knew = kk - run; }
                                else { run += c2; if (run + c1 >= kk) { dsel = 4u * lane + 1u; knew = kk - run; } else { run += c1; dsel = 4u * lane; knew = kk - run; } } }
                            sel[0] = dsel; sel[1] = knew; } }
                    __syncthreads();
                    prefix |= sel[0] << shift; mask |= 0xFFu << shift; kk = sel[1];
                    __syncthreads();
                }
                const int chunk = (n >= NTHR) ? n / NTHR : 1, i0 = tid * chunk; const bool active = i0 < n;
                unsigned cg = 0u, ce = 0u;
                if (active) for (int i = 0; i < chunk; ++i) { const unsigned kv = keys[i0 + i]; cg += kv > prefix; ce += kv == prefix; }
                unsigned pk = cg | (ce << 16), incl = pk;
#pragma unroll
                for (int o = 1; o < 64; o <<= 1) { const unsigned t = __shfl_up(incl, o); if (lane >= o) incl += t; }
                if (lane == 63) wtot[wave] = incl;
                __syncthreads();
                unsigned wbase = 0u;
                for (int w = 0; w < wave; ++w) wbase += wtot[w];
                unsigned excl = wbase + incl - pk; unsigned ng = excl & 0xffffu, ne = excl >> 16;
                if (active) for (int i = 0; i < chunk; ++i) { const unsigned kv = keys[i0 + i]; const int row = row0 + i0 + i;
                    const bool isg = kv > prefix, ise = kv == prefix; const bool take = isg || (ise && ne < kk);
                    const unsigned slot = ng + (ne < kk ? ne : kk);
                    if (take) { RSRC[(size_t)e * ER + sbase + slot] = row; INV[(size_t)row * 16 + e] = sbase + (int)slot; } else INV[(size_t)row * 16 + e] = -1;
                    ng += isg; ne += ise; }
                __syncthreads();
            }
        }
        SEAM(pb + 4); }
        _Pragma("unroll 1") for (int rep = 0; rep < REPS(8); ++rep) {
        if (INL(6)) {
            PIN_WS();
            pg8::Gemm g{HA, WGU + (size_t)l * NE * 2 * FF * D, NE * ER, NE * 2 * FF, D}; pg8::GroupedOrder S; S.init(NE, lastl ? 16 : 17, 17, 0, 2 * FF / 256, 2 * FF / 256, G, bx);
            EpiGateUp E{HID};
            pg8::gemm_phase_gather<EpiGateUp, pg8::GroupedOrder, 17>(ldsl, g, S, E, RSRC, (LAS unsigned short*)(ldsl + pg8::STAGE_BYTES));
        }
        SEAM(pb + 6); }
        _Pragma("unroll 1") for (int rep = 0; rep < REPS(9); ++rep) {
        if (INL(7)) {
            PIN_WS();
            pg8::Gemm g{HID, WD + (size_t)l * NE * D * FF, NE * ER, NE * D, FF}; pg8::GroupedOrder S; S.init(NE, lastl ? 16 : 17, 17, 0, D / 256, D / 256, G, bx);
            EpiDown E{Y};
            pg8::gemm_phase<EpiDown, pg8::GroupedOrder>(ldsl, g, S, E);
            if (!lastl && G == 256 && bx >= 64) { PIN_IDS2(); convert_range(ptab, ws, ldsl, l + 1, 0, CV_P, (bx - 64) * NWAVES + wave, (G - 64) * NWAVES, wave, lane); }
        }
        SEAM(pb + 7); }
        _Pragma("unroll 1") for (int rep = 0; rep < REPS(10); ++rep) {
        if (INL(8)) {
            PIN_IDS();
            const float g2s = (rep == 0 || lastl) ? 1.0f : 0.0f;
            f32x4 mA[4], mSH[4], mG2[4]; int curm = -1;
#pragma unroll 1
            for (int wslot = gw; wslot < RT / 17; wslot += NGW) { const int wrow0 = wslot * 17;
#pragma unroll 1
            for (int it = 0; it < 9; ++it) {
                const int kL = (lane >> 4) & 1; const int idxL = it * 2 + kL; const int rowL = wrow0 + (idxL < 17 ? idxL : 16);
                int myinv = INV[(size_t)rowL * 16 + (lane & 15)]; const float myaff = AFF[(size_t)rowL * 16 + (lane & 15)];
                if (idxL >= 17 || (lastl && (rowL % RPB) < CTXL)) myinv = -1;
                f32x4 v[2][4];
#pragma unroll
                for (int k = 0; k < 2; ++k) { const int idx = it * 2 + k; const int row = wrow0 + (idx < 17 ? idx : 16); row_load_bf(XR + (size_t)row * D, lane, v[k]); }
                const unsigned long long sel = __ballot(myinv >= 0);
                u32x2 y0[2][4], y1[2][4]; float g0[2], g1[2]; unsigned rest[2];
#pragma unroll
                for (int k = 0; k < 2; ++k) {
                    unsigned mk = (unsigned)(sel >> (16 * k)) & 0xffffu; g0[k] = 0.f; g1[k] = 0.f;
#pragma unroll
                    for (int jj = 0; jj < 4; ++jj) { y0[k][jj] = (u32x2){0u, 0u}; y1[k][jj] = (u32x2){0u, 0u}; }
                    if (mk) { const int e = __builtin_ctz(mk); mk &= mk - 1; const int slot = __builtin_amdgcn_readlane(myinv, 16 * k + e); g0[k] = __builtin_bit_cast(float, __builtin_amdgcn_readlane(__builtin_bit_cast(int, myaff), 16 * k + e));
                        const u32x2* yp = (const u32x2*)(Y + ((size_t)e * ER + slot) * D) + lane;
#pragma unroll
                        for (int jj = 0; jj < 4; ++jj) y0[k][jj] = yp[64 * jj]; }
                    if (mk) { const int e = __builtin_ctz(mk); mk &= mk - 1; const int slot = __builtin_amdgcn_readlane(myinv, 16 * k + e); g1[k] = __builtin_bit_cast(float, __builtin_amdgcn_readlane(__builtin_bit_cast(int, myaff), 16 * k + e));
                        const u32x2* yp = (const u32x2*)(Y + ((size_t)e * ER + slot) * D) + lane;
#pragma unroll
                        for (int jj = 0; jj < 4; ++jj) y1[k][jj] = yp[64 * jj]; }
                    rest[k] = mk;
                }
#pragma unroll
                for (int k = 0; k < 2; ++k) {
                    const int idx = it * 2 + k; if (idx >= 17) continue; const int row = wrow0 + idx;
                    const int b = row / RPB, j = row % RPB; const bool isctx = j < CTXL;
                    if (lastl && isctx) continue;
                    const int mrow = isctx ? 8 : b;
                    if (mrow != curm) { curm = mrow; const float* m = modl + (size_t)mrow * 6144;
#pragma unroll
                        for (int jj = 0; jj < 4; ++jj) mG2[jj] = ((const f32x4*)(m + 5 * D))[lane + 64 * jj] * g2s;
                        if (!lastl) { const float* m2 = MOD + (size_t)(l + 1) * 9 * 6144 + (size_t)mrow * 6144; load_mod(INP(I_N1G) + (l + 1) * D, m2 + 0 * D, m2 + 1 * D, lane, mA, mSH); }
                        else {
#pragma unroll
                            for (int jj = 0; jj < 4; ++jj) mA[jj] = ((const f32x4*)INP(I_NFG))[lane + 64 * jj]; } }
                    f32x4 a[4];
#pragma unroll
                    for (int jj = 0; jj < 4; ++jj) {
                        a[jj].x = g0[k] * bf2f(y0[k][jj].x & 0xffffu) + g1[k] * bf2f(y1[k][jj].x & 0xffffu); a[jj].y = g0[k] * bf2f(y0[k][jj].x >> 16) + g1[k] * bf2f(y1[k][jj].x >> 16);
                        a[jj].z = g0[k] * bf2f(y0[k][jj].y & 0xffffu) + g1[k] * bf2f(y1[k][jj].y & 0xffffu); a[jj].w = g0[k] * bf2f(y0[k][jj].y >> 16) + g1[k] * bf2f(y1[k][jj].y >> 16); }
                    unsigned mk = rest[k];
#pragma unroll 1
                    while (mk) { const int e = __builtin_ctz(mk); mk &= mk - 1; const int slot = __builtin_amdgcn_readlane(myinv, 16 * k + e); const float ga = __builtin_bit_cast(float, __builtin_amdgcn_readlane(__builtin_bit_cast(int, myaff), 16 * k + e));
                        const u32x2* yp = (const u32x2*)(Y + ((size_t)e * ER + slot) * D) + lane;
#pragma unroll
                        for (int jj = 0; jj < 4; ++jj) { const u32x2 yy = yp[64 * jj];
                            a[jj].x += ga * bf2f(yy.x & 0xffffu); a[jj].y += ga * bf2f(yy.x >> 16); a[jj].z += ga * bf2f(yy.y & 0xffffu); a[jj].w += ga * bf2f(yy.y >> 16); } }
#pragma unroll
                    for (int jj = 0; jj < 4; ++jj) v[k][jj] = v[k][jj] + mG2[jj] * a[jj];
                    if (!lastl) {
                        row_store_bf(XR + (size_t)row * D, lane, v[k]);
                        norm_mod2(v[k], mA, mSH, HA + (size_t)row * D, lane);
                    } else {
                        const float rstd = row_rstd(v[k]);
                        float* orow = (float*)(GAS1 float*)lds_ptr(ptab, 23) + ((size_t)b * SEQ + (j - CTXL)) * D;
#pragma unroll
                        for (int jj = 0; jj < 4; ++jj) ((f32x4*)orow)[lane + 64 * jj] = (v[k][jj] * rstd) * mA[jj];
                    }
                }
            } }
        }
        if (!lastl) SEAM(pb + 8); }
    }

__global__ void __launch_bounds__(NTHR, 2) fwd(Args args) {
    extern __shared__ __attribute__((aligned(16))) unsigned char lds[];
    LAS unsigned char* ldsl = (LAS unsigned char*)lds;
    const int tid0 = threadIdx.x;
    const int G = gridDim.x, bx = blockIdx.x, NGW = G * NWAVES;
    LAS unsigned long long* ptab = (LAS unsigned long long*)(ldsl + LDS_MISC + 32);
    if (tid0 < 8) ((LAS unsigned*)(ldsl + LDS_MISC))[tid0] = 0u;
    if (tid0 < 25) ptab[tid0] = (tid0 < 23) ? (unsigned long long)args.in[tid0] : (tid0 == 23) ? (unsigned long long)args.out : (unsigned long long)args.ws;
    __syncthreads();
    XcdBarrier bar = xcd_barrier_post((unsigned*)(args.ws + WS_CTL), (volatile LAS unsigned*)(ldsl + LDS_MISC));
    const int lo = args.ph_lo, hi = args.ph_hi;

    _Pragma("unroll 1") for (int rep = 0; rep < REPS(0); ++rep) {
    if (IN(0)) {
            PIN_IDS();
        {
            LAS float* svec = (LAS float*)ldsl;
            LAS float* part = (LAS float*)(ldsl + 9 * 1024 * 4);
            bool have = false;
            for (int u = bx; u < DEPTH * 48; u += G) {
                if (!have) {
                    for (int i = tid; i < 9 * 1024; i += NTHR) { const int r = i >> 10, k = i & 1023; const float x = (r < 8) ? INP(I_C)[r * 1024 + k] : INP(I_CCTX)[k]; svec[i] = x / (1.0f + __expf(-x)); }
                    have = true; __syncthreads();
                }
                const int l = u / 48, j0 = (u % 48) * 128, c4 = tid & 31, kg = tid >> 5;
                const float* w = INP(I_WADA) + (size_t)l * 1024 * 6144 + j0 + 4 * c4;
                f32x4 a[9];
#pragma unroll
                for (int r = 0; r < 9; ++r) a[r] = (f32x4){0.f, 0.f, 0.f, 0.f};
#pragma unroll 2
                for (int k = kg * 64; k < kg * 64 + 64; k += 4) {
                    f32x4 wv[4];
#pragma unroll
                    for (int i = 0; i < 4; ++i) wv[i] = *(const f32x4*)(w + (size_t)(k + i) * 6144);
#pragma unroll
                    for (int r = 0; r < 9; ++r) { const f32x4 sv = *(const LAS f32x4*)(svec + r * 1024 + k);
                        a[r] = a[r] + wv[0] * sv.x + wv[1] * sv.y + wv[2] * sv.z + wv[3] * sv.w; } }
#pragma unroll
                for (int r = 0; r < 9; ++r) *(LAS f32x4*)(part + (kg * 9 + r) * 128 + 4 * c4) = a[r];
                __syncthreads();
                for (int i = tid; i < 9 * 128; i += NTHR) { const int r = i >> 7, c2 = i & 127; float sum = INP(I_BADA)[l * 6144 + j0 + c2];
#pragma unroll
                    for (int g = 0; g < 16; ++g) sum += part[(g * 9 + r) * 128 + c2];
                    MOD[((size_t)l * 9 + r) * 6144 + j0 + c2] = sum; }
                __syncthreads();
            }
            __syncthreads();
        }
        if (bx == G - 1) {
            for (int i = tid; i < 64 * 16; i += NTHR) { const int pos = i >> 4, f = i & 15; double s, c; sincos_d((double)pos * kFreq[f], s, c); ROPEC[i] = (float)c; ROPES[i] = (float)s; }
            if (wave < DEPTH) { const int l = wave;
                const float d1 = wave_sum(INP(I_LQ1)[l * 64 + lane] * INP(I_LK1)[l * 64 + lane]), d2 = wave_sum(INP(I_LQ2)[l * 64 + lane] * INP(I_LK2)[l * 64 + lane]);
                if (lane == 0) LAMV[l] = expf(d1) - expf(d2) + kLamInit[l]; }
        }
        for (int i = bx * NTHR + tid; i < DEPTH * 8 * 128 * 128 / 4; i += G * NTHR) { const f32x4 v = ((const f32x4*)INP(I_SGUW))[i]; u32x2 w; w.x = pk2(v.x, v.y); w.y = pk2(v.z, v.w); ((u32x2*)SGUW)[i] = w; }
        convert_range(ptab, ws, ldsl, 0, 0, G == 256 ? CV_P : IT_L, gw, NGW, wave, lane);
        if (G != 256) {
#pragma unroll 1
            for (int l2 = 1; l2 < DEPTH; ++l2) convert_range(ptab, ws, ldsl, l2, 0, IT_L, gw, NGW, wave, lane); }
    }
    SEAM(0); }
    if (IN(1)) {
            PIN_IDS();
        f32x4 mA[4], mSH[4]; int curm = -1;
#pragma unroll 1
        for (int wslot = gw; wslot < RT / 17; wslot += NGW) { const int wrow0 = wslot * 17;
#pragma unroll 1
        for (int it = 0; it < 5; ++it) {
            f32x4 v[4][4];
#pragma unroll
            for (int k = 0; k < 4; ++k) { const int idx = it * 4 + k; const int row = wrow0 + (idx < 17 ? idx : 16); const int b = row / RPB, j = row % RPB;
                const float* src = (j < CTXL) ? INP(I_CTX) + ((size_t)b * CTXL + j) * D : INP(I_X) + ((size_t)b * SEQ + (j - CTXL)) * D; row_load(src, lane, v[k]); }
#pragma unroll
            for (int k = 0; k < 4; ++k) { const int idx = it * 4 + k; if (idx >= 17) continue; const int row = wrow0 + idx; const int b = row / RPB, j = row % RPB;
                row_store_bf(XR + (size_t)row * D, lane, v[k]);
                const int mrow = (j < CTXL) ? 8 : b;
                if (mrow != curm) { curm = mrow; const float* m = MOD + (size_t)mrow * 6144; load_mod(INP(I_N1G), m + 0 * D, m + 1 * D, lane, mA, mSH); }
                norm_mod2(v[k], mA, mSH, HA + (size_t)row * D, lane); }
        } }
    }
    SEAM(1);

    layer_body<0>(lds, ldsl, ptab, bar, lo, hi, G, bx, NGW);
    layer_body<1>(lds, ldsl, ptab, bar, lo, hi, G, bx, NGW);
    layer_body<2>(lds, ldsl, ptab, bar, lo, hi, G, bx, NGW);
    layer_body<3>(lds, ldsl, ptab, bar, lo, hi, G, bx, NGW);
}

#ifndef MK_LAUNCHES_PER_PHASE
#define MK_LAUNCHES_PER_PHASE 0
#endif
extern "C" void kernel_launch(void* const* d_in, const int* in_sizes, int n_in, void* d_out, int out_size, void* d_ws, size_t ws_size, hipStream_t stream) {
    static int grid = 0;
    if (grid == 0) {
        if (n_in != 23 || out_size != NB * SEQ * D || ws_size < WS_END) { fprintf(stderr, "kernel_launch: unexpected shapes: n_in %d out %d ws %zu (need %zu)\n", n_in, out_size, ws_size, (size_t)WS_END); grid = -1; return; }
        int dev = 0, cus = 0, per_cu = 0;
        if (hipGetDevice(&dev) != hipSuccess || hipDeviceGetAttribute(&cus, hipDeviceAttributeMultiprocessorCount, dev) != hipSuccess) { grid = -1; return; }
        if (hipFuncSetAttribute((const void*)fwd, hipFuncAttributeMaxDynamicSharedMemorySize, LDS_BYTES) != hipSuccess) { fprintf(stderr, "kernel_launch: hipFuncSetAttribute failed\n"); grid = -1; return; }
        if (hipOccupancyMaxActiveBlocksPerMultiprocessor(&per_cu, (const void*)fwd, NTHR, LDS_BYTES) != hipSuccess || per_cu < 1) { fprintf(stderr, "kernel_launch: occupancy query says %d blocks per CU\n", per_cu); }
        (void)hipGetLastError();
        grid = cus;
        if (grid > 256) grid = 256;
    }
    if (grid < 0) return;
    (void)hipMemsetAsync((char*)d_ws + WS_CTL, 0, CTL_BYTES, stream);
    Args a{};
    for (int i = 0; i < 23; ++i) a.in[i] = (const float*)d_in[i];
    a.out = (float*)d_out; a.ws = (unsigned char*)d_ws;
    constexpr int NPH = 2 + 9 * DEPTH;
#if MK_LAUNCHES_PER_PHASE
    for (int p = 0; p < NPH; ++p) { a.ph_lo = p; a.ph_hi = p + 1; hipLaunchKernelGGL(fwd, dim3(grid), dim3(NTHR), LDS_BYTES, stream, a); }
#else
    a.ph_lo = 0; a.ph_hi = NPH;
    hipLaunchKernelGGL(fwd, dim3(grid), dim3(NTHR), LDS_BYTES, stream, a);
#endif
    const hipError_t le = hipPeekAtLastError();
    if (le != hipSuccess) fprintf(stderr, "kernel_launch: launch failed: %s\n", hipGetErrorName(le));
}
```
